# Optimizing an MI355X kernel written in HIP

```python
import math
import jax, jax.numpy as jnp
from jax import lax
import numpy as np

D_MODEL = 1024
BATCH = 8
SEQ = 8192
DEPTH = 2

N_META = 16
BLOCK = 128
MIX_WIDTH = D_MODEL
N_RET_HEADS = 4
RET_DIM = MIX_WIDTH // 2 // N_RET_HEADS
N_DIFF_HEADS = 4
DIFF_V_DIM = MIX_WIDTH // 2 // N_DIFF_HEADS
DIFF_QK_DIM = DIFF_V_DIM // 2
N_SB_HEADS = 8
SB_DIM = MIX_WIDTH // N_SB_HEADS
D_FF = ((8 * D_MODEL // 3 + 127) // 128) * 128
CONV_WIDTH = 3
EPS = 1e-6
MASK_VALUE = -1e30
N_EVEN = (DEPTH + 1) // 2
N_ODD = DEPTH // 2
RET_W = N_RET_HEADS * RET_DIM
DIFF_QK_W = N_DIFF_HEADS * 2 * DIFF_QK_DIM
DIFF_V_W = N_DIFF_HEADS * DIFF_V_DIM
AB_IN = 4 * RET_W + 2 * DIFF_QK_W + DIFF_V_W
C_IN = 3 * N_SB_HEADS * SB_DIM

kernel_name = "hybrid_retention_diffattn_stickbreaking_convffn"


def rmsnorm(x, g):
    xf = x.astype(jnp.float32)
    y = xf * lax.rsqrt(jnp.mean(xf * xf, axis=-1, keepdims=True) + EPS)
    return y.astype(x.dtype) * g


def head_rmsnorm(x, g):
    xf = x.astype(jnp.float32)
    y = xf * lax.rsqrt(jnp.mean(xf * xf, axis=-1, keepdims=True) + EPS)
    return y.astype(x.dtype) * g.reshape(x.shape[-2:])


def head_groupnorm(x, g):
    xf = x.astype(jnp.float32)
    mu = jnp.mean(xf, axis=-1, keepdims=True)
    xc = xf - mu
    y = xc * lax.rsqrt(jnp.mean(xc * xc, axis=-1, keepdims=True) + EPS)
    return y.astype(x.dtype) * g.reshape(x.shape[-2:])


def to_blocks(t):
    b, p, h, d = t.shape
    return t.reshape(b, p // BLOCK, BLOCK, h, d).transpose(1, 0, 3, 2, 4)


def from_blocks(t):
    n, b, h, c, d = t.shape
    return t.transpose(1, 0, 3, 2, 4).reshape(b, n * c, h, d)


def retention(q, k, v, valid):
    b, p, h, dk = q.shape
    dv = v.shape[-1]
    k = jnp.where(valid[None, :, None, None], k * dk ** -0.5, 0)
    v = jnp.where(valid[None, :, None, None], v, 0)
    qc, kc, vc = to_blocks(q), to_blocks(k), to_blocks(v)
    log_g = jnp.log1p(-(2.0 ** (-5.0 - jnp.arange(h, dtype=jnp.float32))))
    j = jnp.arange(BLOCK, dtype=jnp.float32)
    rel = j[:, None] - j[None, :]
    decay = jnp.where(rel >= 0, jnp.exp(log_g[:, None, None] * jnp.maximum(rel, 0.0)), 0.0).astype(q.dtype)
    q_decay = jnp.exp(log_g[:, None] * (j + 1.0))[:, :, None].astype(q.dtype)
    k_decay = jnp.exp(log_g[:, None] * (BLOCK - 1.0 - j))[:, :, None].astype(q.dtype)
    chunk_decay = jnp.exp(log_g * BLOCK)[:, None, None].astype(q.dtype)
    scores = jnp.einsum('nbhqd,nbhkd->nbhqk', qc, kc) * decay
    inner = jnp.einsum('nbhqk,nbhke->nbhqe', scores, vc)
    kv = jnp.einsum('nbhkd,nbhke->nbhde', kc * k_decay, vc)

    def step(state, kv_n):
        return chunk_decay * state + kv_n, state

    _, prev = lax.scan(step, jnp.zeros((b, h, dk, dv), kv.dtype), kv)
    cross = jnp.einsum('nbhqd,nbhde->nbhqe', qc * q_decay, prev)
    return from_blocks(inner + cross)


def diff_attention(q1, q2, k1, k2, v, lam, valid):
    b, p, h, d = q1.shape
    n = p // BLOCK
    scale = d ** -0.5
    slopes = 2.0 ** (-8.0 * (jnp.arange(h, dtype=jnp.float32) + 1.0) / h)
    k1t, k2t, vt = (t.transpose(0, 2, 1, 3) for t in (k1, k2, v))
    key_pos = jnp.arange(p)

    def block(args):
        i, qb1, qb2 = args
        qpos = i * BLOCK + jnp.arange(BLOCK)
        dist = qpos[:, None] - key_pos[None, :]
        mask = (dist >= 0) & valid[None, :]
        bias = -slopes[:, None, None] * dist.astype(jnp.float32)

        def probs(qb, kt):
            s = jnp.einsum('bhqd,bhkd->bhqk', qb, kt).astype(jnp.float32) * scale + bias
            return jax.nn.softmax(jnp.where(mask, s, MASK_VALUE), axis=-1)

        a = probs(qb1, k1t) - lam * probs(qb2, k2t)
        return jnp.einsum('bhqk,bhke->bhqe', a.astype(vt.dtype), vt)

    out = lax.map(block, (jnp.arange(n), to_blocks(q1), to_blocks(q2)))
    return from_blocks(out)


def stick_breaking(q, k, v, valid):
    b, p, h, d = q.shape
    n = p // BLOCK
    scale = d ** -0.5
    kt, vt = k.transpose(0, 2, 1, 3), v.transpose(0, 2, 1, 3)
    key_pos = jnp.arange(p)

    def block(args):
        i, qb = args
        qpos = i * BLOCK + jnp.arange(BLOCK)
        mask = (qpos[:, None] > key_pos[None, :]) & valid[None, :]
        z = jnp.einsum('bhqd,bhkd->bhqk', qb, kt).astype(jnp.float32) * scale
        log_1m = jnp.where(mask, -jax.nn.softplus(z), 0.0)
        later = lax.cumsum(log_1m, axis=3, reverse=True) - log_1m
        w = jnp.where(mask, jnp.exp(jax.nn.log_sigmoid(z) + later), 0.0)
        return jnp.einsum('bhqk,bhke->bhqe', w.astype(vt.dtype), vt)

    out = lax.map(block, (jnp.arange(n), to_blocks(q)))
    return from_blocks(out)


def conv_ffn(h, w_up, w_conv, b_conv, w_down, valid):
    p = h.shape[1]
    gate, val = jnp.split(h @ w_up, 2, axis=-1)
    gate = jnp.where(valid[None, :, None], gate, 0)
    gp = jnp.pad(gate, ((0, 0), (CONV_WIDTH - 1, 0), (0, 0)))
    conv = b_conv + sum(gp[:, tap:tap + p] * w_conv[tap] for tap in range(CONV_WIDTH))
    return (jax.nn.silu(conv) * val) @ w_down


def mixer_ab(h, w_in, ret_norm, diff_norm, lam_q1, lam_k1, lam_q2, lam_k2, w_out, lambda_init, valid):
    b, p, _ = h.shape
    proj = h @ w_in
    cuts = [RET_W, 2 * RET_W, 3 * RET_W, 4 * RET_W, 4 * RET_W + DIFF_QK_W, 4 * RET_W + 2 * DIFF_QK_W]
    rq, rk, rv, rg, dq, dk, dv = jnp.split(proj, cuts, axis=-1)
    ret = retention(rq.reshape(b, p, N_RET_HEADS, RET_DIM), rk.reshape(b, p, N_RET_HEADS, RET_DIM),
                    rv.reshape(b, p, N_RET_HEADS, RET_DIM), valid)
    ret = head_groupnorm(ret, ret_norm).reshape(b, p, RET_W) * jax.nn.silu(rg)
    dq = dq.reshape(b, p, N_DIFF_HEADS, 2, DIFF_QK_DIM)
    dk = dk.reshape(b, p, N_DIFF_HEADS, 2, DIFF_QK_DIM)
    f32 = jnp.float32
    lam = (jnp.exp(jnp.sum(lam_q1.astype(f32) * lam_k1.astype(f32)))
           - jnp.exp(jnp.sum(lam_q2.astype(f32) * lam_k2.astype(f32))) + lambda_init)
    dif = diff_attention(dq[..., 0, :], dq[..., 1, :], dk[..., 0, :], dk[..., 1, :],
                         dv.reshape(b, p, N_DIFF_HEADS, DIFF_V_DIM), lam, valid)
    dif = (head_rmsnorm(dif, diff_norm) * (1.0 - lambda_init)).reshape(b, p, DIFF_V_W)
    return jnp.concatenate([ret, dif], axis=-1) @ w_out


def mixer_c(h, w_in, w_out, valid):
    b, p, _ = h.shape
    q, k, v = jnp.split(h @ w_in, 3, axis=-1)
    shp = (b, p, N_SB_HEADS, SB_DIM)
    o = stick_breaking(q.reshape(shp), k.reshape(shp), v.reshape(shp), valid)
    return o.reshape(b, p, MIX_WIDTH) @ w_out


def setup_inputs(seed: int = 0) -> dict:
    key = jax.random.key(seed)
    ks = jax.random.split(key, 20)

    def nrm(k, shape, scale):
        return jax.random.normal(k, shape, jnp.float32) * scale

    return {
        "x": nrm(ks[0], (BATCH, SEQ, D_MODEL), 1.0),
        "meta_tokens": nrm(ks[1], (N_META, D_MODEL), 1.0),
        "mix_norm": 1.0 + nrm(ks[2], (DEPTH, D_MODEL), 0.02),
        "ffn_norm": 1.0 + nrm(ks[3], (DEPTH, D_MODEL), 0.02),
        "ffn_up": nrm(ks[4], (DEPTH, D_MODEL, 2 * D_FF), D_MODEL ** -0.5),
        "ffn_conv": nrm(ks[5], (DEPTH, CONV_WIDTH, D_FF), CONV_WIDTH ** -0.5),
        "ffn_conv_b": nrm(ks[6], (DEPTH, D_FF), 0.01),
        "ffn_down": nrm(ks[7], (DEPTH, D_FF, D_MODEL), D_FF ** -0.5),
        "ab_w_in": nrm(ks[8], (N_EVEN, D_MODEL, AB_IN), D_MODEL ** -0.5),
        "ab_ret_norm": 1.0 + nrm(ks[9], (N_EVEN, RET_W), 0.02),
        "ab_diff_norm": 1.0 + nrm(ks[10], (N_EVEN, DIFF_V_W), 0.02),
        "ab_lam_q1": nrm(ks[11], (N_EVEN, DIFF_QK_DIM), 0.1),
        "ab_lam_k1": nrm(ks[12], (N_EVEN, DIFF_QK_DIM), 0.1),
        "ab_lam_q2": nrm(ks[13], (N_EVEN, DIFF_QK_DIM), 0.1),
        "ab_lam_k2": nrm(ks[14], (N_EVEN, DIFF_QK_DIM), 0.1),
        "ab_w_out": nrm(ks[15], (N_EVEN, MIX_WIDTH, D_MODEL), MIX_WIDTH ** -0.5),
        "c_w_in": nrm(ks[16], (N_ODD, D_MODEL, C_IN), D_MODEL ** -0.5),
        "c_w_out": nrm(ks[17], (N_ODD, MIX_WIDTH, D_MODEL), MIX_WIDTH ** -0.5),
        "final_norm": 1.0 + nrm(ks[18], (D_MODEL,), 0.02),
    }


def reference(x, meta_tokens, mix_norm, ffn_norm, ffn_up, ffn_conv, ffn_conv_b, ffn_down,
              ab_w_in, ab_ret_norm, ab_diff_norm, ab_lam_q1, ab_lam_k1, ab_lam_q2, ab_lam_k2, ab_w_out,
              c_w_in, c_w_out, final_norm):
    b = x.shape[0]
    pad = jnp.zeros((b, BLOCK - N_META, D_MODEL), x.dtype)
    meta = jnp.broadcast_to(meta_tokens[None].astype(x.dtype), (b, N_META, D_MODEL))
    h = jnp.concatenate([pad, meta, x], axis=1)
    p = h.shape[1]
    valid = jnp.arange(p) >= (BLOCK - N_META)
    for i in range(DEPTH):
        y = rmsnorm(h, mix_norm[i])
        if i % 2 == 0:
            e = i // 2
            lambda_init = 0.8 - 0.6 * math.exp(-0.3 * i)
            h = h + mixer_ab(y, ab_w_in[e], ab_ret_norm[e], ab_diff_norm[e], ab_lam_q1[e], ab_lam_k1[e],
                             ab_lam_q2[e], ab_lam_k2[e], ab_w_out[e], lambda_init, valid)
        else:
            o = i // 2
            h = h + mixer_c(y, c_w_in[o], c_w_out[o], valid)
        h = h + conv_ffn(rmsnorm(h, ffn_norm[i]), ffn_up[i], ffn_conv[i], ffn_conv_b[i], ffn_down[i], valid)
    return rmsnorm(h, final_norm)[:, BLOCK:, :]
```

```cpp
#include <hip/hip_runtime.h>
#include <hip/hip_cooperative_groups.h>
#include <cstdio>
#include <cstdint>
namespace cg = cooperative_groups;

#define LAS __attribute__((address_space(3)))
#define DI __device__ __forceinline__
typedef unsigned short bf16_t;
typedef short bf16x8 __attribute__((ext_vector_type(8)));
typedef short s16x4 __attribute__((ext_vector_type(4)));
typedef float f32x2 __attribute__((ext_vector_type(2)));
typedef float f32x4 __attribute__((ext_vector_type(4)));
typedef float f32x16 __attribute__((ext_vector_type(16)));
typedef unsigned u32x2 __attribute__((ext_vector_type(2)));
typedef unsigned u32x4 __attribute__((ext_vector_type(4)));
typedef __bf16 bf16x2_t __attribute__((ext_vector_type(2)));

constexpr int BATCH = 8, SEQ = 8192, DM = 1024, BLK = 128, NMETA = 16;
constexpr int PP = SEQ + BLK;
constexpr int MROWS = BATCH * PP;
constexpr int NVALID0 = BLK - NMETA;
constexpr int DFF = 2816;
constexpr int AB_IN = 3584, C_IN = 3072;
constexpr float EPS = 1e-6f;
constexpr float LOG2E = 1.4426950408889634f;
constexpr int NTHREADS = 512;

constexpr size_t MiB = 1u << 20;
constexpr size_t WS_CTL = 0;
constexpr size_t WS_WIN0 = 1 * MiB, WS_WOUT0 = 8 * MiB, WS_WUP0 = 10 * MiB, WS_WDN0 = 21 * MiB;
constexpr size_t WS_WIN1 = 27 * MiB, WS_WOUT1 = 33 * MiB, WS_WUP1 = 35 * MiB, WS_WDN1 = 46 * MiB;
constexpr size_t WS_YPAD = 52 * MiB;
constexpr size_t WS_Y = WS_YPAD + 2 * 2048;
constexpr size_t WS_H = 184 * MiB;
constexpr size_t WS_BIG = 444 * MiB;
constexpr size_t WS_RSQ = 899 * MiB;
constexpr size_t WS_END = 901 * MiB;

struct Params {
    const float* x; const float* meta; const float* mix_norm; const float* ffn_norm;
    const float* ffn_up; const float* ffn_conv; const float* ffn_conv_b; const float* ffn_down;
    const float* ab_w_in; const float* ab_ret_norm; const float* ab_diff_norm;
    const float* lq1; const float* lk1; const float* lq2; const float* lk2; const float* ab_w_out;
    const float* c_w_in; const float* c_w_out; const float* final_norm;
    float* out; unsigned char* ws; int ph_lo, ph_hi;
};

DI unsigned cvtpk(float lo, float hi) { f32x2 v = {lo, hi}; bf16x2_t b = __builtin_convertvector(v, bf16x2_t); return __builtin_bit_cast(unsigned, b); }
DI float bf2f(unsigned short u) { return __uint_as_float(((unsigned)u) << 16); }
DI bf16x8 pack8(float a0, float a1, float a2, float a3, float a4, float a5, float a6, float a7) {
    u32x4 p; p.x = cvtpk(a0, a1); p.y = cvtpk(a2, a3); p.z = cvtpk(a4, a5); p.w = cvtpk(a6, a7); return __builtin_bit_cast(bf16x8, p);
}
#define MFMA32(a, b, c) __builtin_amdgcn_mfma_f32_32x32x16_bf16((a), (b), (c), 0, 0, 0)
DI float wave_sum(float v) {
#pragma unroll
    for (int o = 1; o < 64; o <<= 1) v += __shfl_xor(v, o);
    return v;
}
DI unsigned off_b(unsigned row, unsigned ch) { return 256u * row + 16u * (ch ^ (((row & 3u) << 2) | ((row >> 2) & 3u))); }
typedef short v4i16_t __attribute__((ext_vector_type(4)));
DI s16x4 trread(LAS const unsigned char* p) { return __builtin_bit_cast(s16x4, __builtin_amdgcn_ds_read_tr16_b64_v4i16((LAS v4i16_t*)p)); }
DI bf16x8 tr_nat(LAS const unsigned char* img, unsigned row16, unsigned c, unsigned lane) {
    const unsigned h = lane >> 5, blk = (lane >> 4) & 1, q = (lane & 15) >> 2, p = lane & 3;
    const s16x4 lo = trread(img + off_b(row16 + 8 * h + q, 4 * c + 2 * blk + (p >> 1)) + 8 * (p & 1));
    const s16x4 hi = trread(img + off_b(row16 + 8 * h + 4 + q, 4 * c + 2 * blk + (p >> 1)) + 8 * (p & 1));
    return __builtin_shufflevector(lo, hi, 0, 1, 2, 3, 4, 5, 6, 7);
}
DI bf16x8 tr_perm(LAS const unsigned char* img, unsigned row16, unsigned c, unsigned lane) {
    const unsigned h = lane >> 5, blk = (lane >> 4) & 1, q = (lane & 15) >> 2, p = lane & 3;
    const s16x4 lo = trread(img + off_b(row16 + 4 * h + q, 4 * c + 2 * blk + (p >> 1)) + 8 * (p & 1));
    const s16x4 hi = trread(img + off_b(row16 + 8 + 4 * h + q, 4 * c + 2 * blk + (p >> 1)) + 8 * (p & 1));
    return __builtin_shufflevector(lo, hi, 0, 1, 2, 3, 4, 5, 6, 7);
}
DI void tr_perm_offs(unsigned c, unsigned lane, unsigned& lo, unsigned& hi) {
    const unsigned h = lane >> 5, blk = (lane >> 4) & 1, q = (lane & 15) >> 2, p = lane & 3;
    lo = off_b(4 * h + q, 4 * c + 2 * blk + (p >> 1)) + 8 * (p & 1);
    hi = off_b(8 + 4 * h + q, 4 * c + 2 * blk + (p >> 1)) + 8 * (p & 1);
}
DI bf16x8 tr_at(LAS const unsigned char* img, unsigned lo, unsigned hi, unsigned byteoff) {
    const s16x4 a = trread(img + lo + byteoff), b = trread(img + hi + byteoff);
    return __builtin_shufflevector(a, b, 0, 1, 2, 3, 4, 5, 6, 7);
}
DI bf16x8 row_frag(LAS const unsigned char* img, unsigned row, unsigned ch) { return *(LAS const bf16x8*)(img + off_b(row, ch)); }
#define CROWC(i) (((i) & 3) + 8 * ((i) >> 2))

namespace pg8 {
constexpr int BM = 256, BK = 64, HALF = 128, HTB = HALF * BK * 2, STAGE_BYTES = 8 * HTB, NXCD = 8, WGM = 4;
DI int lds_byte(int r, int c) { const int st = (r >> 4) * 2 + (c >> 5), rr = r & 15, cc = c & 31, ob = rr * 64 + cc * 2; return st * 1024 + (ob ^ (((ob >> 9) & 1) << 5)); }
DI void stage_rc(int b, int& R, int& C) { const int st = b / 1024, sb = b % 1024, swz = sb ^ (((sb >> 9) & 1) << 5); R = (st >> 1) * 16 + swz / 64; C = (st & 1) * 32 + (swz % 64) / 2; }
DI int perm32(int rho) { const int n = rho >> 4, i = rho & 15; return 8 * (i >> 2) + 4 * n + (i & 3); }
struct Unit { int pm, pn; };
struct Gemm { const bf16_t* A; const bf16_t* Bt; int K; int a_rows; };
struct StaticOrder {
    int nM, nN, nwg, G, c;
    DI void init(int nM_, int nN_, int G_, int c_) { nM = nM_; nN = nN_; nwg = nM * nN; G = G_; c = c_; }
    DI bool next(int i, Unit& u) const {
        const long L = (long)i * G + c; if (L >= nwg) return false;
        int wgid = (int)L; { const int q = nwg / NXCD, r = nwg % NXCD, xcd = wgid % NXCD, off = wgid / NXCD; wgid = (xcd < r ? xcd * (q + 1) : r * (q + 1) + (xcd - r) * q) + off; }
        const int nig = WGM * nN, gid = wgid / nig, fm = gid * WGM, gsz = (nM - fm) < WGM ? (nM - fm) : WGM;
        u.pm = fm + ((wgid % nig) % gsz); u.pn = (wgid % nig) / gsz; return true;
    }
};

template <class Epi>
DI void gemm_phase(LAS unsigned char* lds, const Gemm g, const StaticOrder& S, const Epi& E) {
    const int tid = threadIdx.x, wid = __builtin_amdgcn_readfirstlane(tid >> 6), lane = tid & 63, wr = wid >> 2, wc = wid & 3, fr = lane & 15, fq = lane >> 4;
    const int K = g.K, nt = K / BK;
    unsigned voffA[2], voffB[2];
#pragma unroll
    for (int i = 0; i < 2; ++i) { int R, C; stage_rc(tid * 16 + i * 8192, R, C);
        const int Rb = Epi::BINTER ? (64 * (R >> 5) + perm32(R & 31)) : Epi::PERM ? ((R & ~31) + perm32(R & 31)) : R;
        voffA[i] = (unsigned)(R * K + C) * 2u; voffB[i] = (unsigned)(Rb * K + C) * 2u; }
    const size_t kstep = (size_t)(BK * 2);
    const size_t hstep = (size_t)HALF * K * 2;
    const size_t hstepB = Epi::BINTER ? (size_t)32 * K * 2 : hstep;
    const size_t tstepB = 2 * hstep;
    const size_t tstepA = (size_t)g.a_rows * K * 2;
    const unsigned ldsw = (unsigned)wid * 1024u;
    const int aoff = lds_byte(wr * 64 + fr, fq * 8), boff = lds_byte(wc * 32 + fr, fq * 8);
#define PG8_SA(b, h) (((b) * 2 + (h)) * HTB)
#define PG8_SB(b, h) ((4 + (b) * 2 + (h)) * HTB)
#define PG8_STAGE(bufoff, gbase, voff) do { _Pragma("unroll") for (int _i = 0; _i < 2; ++_i) \
        __builtin_amdgcn_global_load_lds((const unsigned*)((const char*)(gbase) + (voff)[_i]), (LAS unsigned*)(lds + (bufoff) + ldsw + _i * 8192), 16, 0, 0); } while (0)
#define PG8_LDA(dst, b, h) do { _Pragma("unroll") for (int m = 0; m < 4; ++m) _Pragma("unroll") for (int k = 0; k < 2; ++k) dst[m][k] = *(const LAS bf16x8*)(lds + PG8_SA(b, h) + aoff + m * 2048 + k * 1024); } while (0)
#define PG8_LDB(dst, b, h) do { _Pragma("unroll") for (int n = 0; n < 2; ++n) _Pragma("unroll") for (int k = 0; k < 2; ++k) dst[n][k] = *(const LAS bf16x8*)(lds + PG8_SB(b, h) + boff + n * 2048 + k * 1024); } while (0)
#define PG8_MMA(ai, bj, At, Bt) do { __builtin_amdgcn_s_setprio(1); _Pragma("unroll") for (int m = 0; m < 4; ++m) _Pragma("unroll") for (int n = 0; n < 2; ++n) _Pragma("unroll") for (int k = 0; k < 2; ++k) \
        acc[ai][bj][m][n] = __builtin_amdgcn_mfma_f32_16x16x32_bf16(Bt[n][k], At[m][k], acc[ai][bj][m][n], 0, 0, 0); __builtin_amdgcn_s_setprio(0); } while (0)
#define PG8_WAIT_V(n) asm volatile("s_waitcnt vmcnt(" #n ")" ::: "memory")
#define PG8_WAIT_L(n) asm volatile("s_waitcnt lgkmcnt(" #n ")" ::: "memory")
#define PG8_BAR __builtin_amdgcn_s_barrier()
#define PG8_SCHED __builtin_amdgcn_sched_barrier(0)
    Unit cur, nxt; int ui = 0;
    if (!S.next(0, cur)) return;
    f32x4 acc[2][2][4][2];
#pragma unroll
    for (int a = 0; a < 2; ++a)
#pragma unroll
        for (int b = 0; b < 2; ++b)
#pragma unroll
            for (int m = 0; m < 4; ++m)
#pragma unroll
                for (int n = 0; n < 2; ++n) acc[a][b][m][n] = (f32x4){0.f, 0.f, 0.f, 0.f};
    bf16x8 At[4][2], B0[2][2], B1[2][2];
    const char* cA = (const char*)g.A + (size_t)cur.pm * tstepA; const char* cB = (const char*)g.Bt + (size_t)cur.pn * tstepB;
    PG8_STAGE(PG8_SB(0, 0), cB, voffB); PG8_STAGE(PG8_SB(0, 1), cB + hstepB, voffB); PG8_STAGE(PG8_SA(0, 0), cA, voffA); PG8_STAGE(PG8_SA(0, 1), cA + hstep, voffA);
    if (wr == 1) PG8_BAR;
    PG8_WAIT_V(2); PG8_BAR;
    PG8_STAGE(PG8_SB(1, 0), cB + kstep, voffB); PG8_STAGE(PG8_SA(1, 0), cA + kstep, voffA); PG8_STAGE(PG8_SB(1, 1), cB + hstepB + kstep, voffB);
    PG8_WAIT_V(6); PG8_BAR;
    for (;;) {
        const bool has_next = S.next(ui + 1, nxt);
        const char* nA = has_next ? (const char*)g.A + (size_t)nxt.pm * tstepA : cA; const char* nB = has_next ? (const char*)g.Bt + (size_t)nxt.pn * tstepB : cB;
        for (int t = 0; t < nt; t += 2) {
            const bool last = (t == nt - 2);
            const char* a1 = cA + (size_t)(t + 1) * kstep;
            const char* a2 = last ? nA : cA + (size_t)(t + 2) * kstep; const char* b2 = last ? nB : cB + (size_t)(t + 2) * kstep;
            const char* a3 = a2 + kstep; const char* b3 = b2 + kstep;
            PG8_LDB(B0, 0, 0); PG8_LDB(B1, 0, 1); PG8_SCHED; PG8_LDA(At, 0, 0); PG8_STAGE(PG8_SA(1, 1), a1 + hstep, voffA);
            PG8_WAIT_V(8); PG8_WAIT_L(0); PG8_BAR; PG8_MMA(0, 0, At, B0); PG8_MMA(0, 1, At, B1); PG8_BAR; PG8_SCHED;
            PG8_LDA(At, 0, 1); PG8_STAGE(PG8_SB(0, 0), b2, voffB); PG8_STAGE(PG8_SB(0, 1), b2 + hstepB, voffB); PG8_STAGE(PG8_SA(0, 0), a2, voffA);
            PG8_WAIT_V(8); PG8_WAIT_L(0); PG8_BAR; PG8_MMA(1, 0, At, B0); PG8_MMA(1, 1, At, B1); PG8_BAR; PG8_SCHED;
            PG8_LDB(B0, 1, 0); PG8_LDB(B1, 1, 1); PG8_SCHED; PG8_LDA(At, 1, 0); PG8_STAGE(PG8_SA(0, 1), a2 + hstep, voffA);
            PG8_WAIT_V(8); PG8_WAIT_L(0); PG8_BAR; PG8_MMA(0, 0, At, B0); PG8_MMA(0, 1, At, B1); PG8_BAR; PG8_SCHED;
            PG8_LDA(At, 1, 1); PG8_STAGE(PG8_SB(1, 0), b3, voffB); PG8_STAGE(PG8_SB(1, 1), b3 + hstepB, voffB); PG8_STAGE(PG8_SA(1, 0), a3, voffA);
            PG8_WAIT_V(8); PG8_WAIT_L(0); PG8_BAR; PG8_MMA(1, 0, At, B0); PG8_MMA(1, 1, At, B1); PG8_BAR; PG8_SCHED;
        }
        if (wr == 0) PG8_BAR;
        E(acc, cur, wr, wc, fr, fq, lds);
        if (!has_next) break;
#pragma unroll
        for (int a = 0; a < 2; ++a)
#pragma unroll
            for (int b = 0; b < 2; ++b)
#pragma unroll
                for (int m = 0; m < 4; ++m)
#pragma unroll
                    for (int n = 0; n < 2; ++n) acc[a][b][m][n] = (f32x4){0.f, 0.f, 0.f, 0.f};
        cur = nxt; cA = nA; cB = nB; ++ui;
        if (wr == 1) PG8_BAR;
    }
    PG8_WAIT_V(0);
    PG8_BAR;
#undef PG8_SA
#undef PG8_SB
#undef PG8_STAGE
#undef PG8_LDA
#undef PG8_LDB
#undef PG8_MMA
#undef PG8_WAIT_V
#undef PG8_WAIT_L
#undef PG8_BAR
#undef PG8_SCHED
}
}

typedef f32x4 AccT[2][2][4][2];

template <int MODE> struct EpiProj {
    static constexpr bool PERM = true, BINTER = true;
    bf16_t* O; int ldc; const float* rsq; unsigned* kinf;
    DI void operator()(const AccT& acc, const pg8::Unit& u, int wr, int wc, int fr, int fq, LAS unsigned char*) const {
        const int row0 = u.pm * 256 + wr * 64 + fr;
        float rs[2][4];
#pragma unroll
        for (int ai = 0; ai < 2; ++ai)
#pragma unroll
            for (int m = 0; m < 4; ++m) rs[ai][m] = rsq ? __builtin_amdgcn_rsqf(rsq[row0 + ai * 128 + m * 16] * (1.0f / DM) + EPS) : 1.0f;
        const int seg = 2 * u.pn + (wc >> 1), type = seg >> 2, hd = seg & 3;
        const float lg = __builtin_log2f(1.0f - __builtin_exp2f(-5.0f - (float)hd));
        float amax = 0.f;
#pragma unroll
        for (int ai = 0; ai < 2; ++ai)
#pragma unroll
            for (int m = 0; m < 4; ++m) {
                const int row = row0 + ai * 128 + m * 16;
                float f = rs[ai][m];
                if (MODE == 0) {
                    const int p = row % PP, pc = p & 127; const bool valid = p >= NVALID0;
                    if (type == 0) f = __builtin_amdgcn_exp2f(lg * (float)pc);
                    else if (type == 1) f = valid ? 0.08838834764831845f * __builtin_amdgcn_exp2f(-lg * (float)pc) : 0.f;
                    else if (type == 2) f = valid ? 1.f : 0.f;
                    else if (type == 4) f = 0.125f * LOG2E;
                }
#pragma unroll
                for (int bj = 0; bj < 2; ++bj) {
                    const int col0 = u.pn * 256 + wc * 64 + bj * 32 + 8 * fq;
                    const f32x4 v0 = acc[ai][bj][m][0] * f, v1 = acc[ai][bj][m][1] * f;
                    u32x4 w; w.x = cvtpk(v0[0], v0[1]); w.y = cvtpk(v0[2], v0[3]); w.z = cvtpk(v1[0], v1[1]); w.w = cvtpk(v1[2], v1[3]);
                    *(u32x4*)(O + (size_t)row * ldc + col0) = w;
                    if (MODE == 0 && type == 5) amax = fmaxf(amax, fmaxf(fmaxf(fmaxf(fabsf(v0[0]), fabsf(v0[1])), fmaxf(fabsf(v0[2]), fabsf(v0[3]))), fmaxf(fmaxf(fabsf(v1[0]), fabsf(v1[1])), fmaxf(fabsf(v1[2]), fabsf(v1[3])))));
                }
            }
        if (MODE == 0 && type == 5) {
#pragma unroll
            for (int o = 1; o < 64; o <<= 1) amax = fmaxf(amax, __shfl_xor(amax, o));
            if ((threadIdx.x & 63) == 0) atomicMax(kinf + hd * 2 + (wc & 1), __float_as_uint(amax));
        }
    }
};

template <int MODE> struct EpiResidual {
    static constexpr bool PERM = true, BINTER = true;
    bf16_t* HB; float* H32; float* rowsq; const float* x0; const float* meta0;
    DI void operator()(const AccT& acc, const pg8::Unit& u, int wr, int wc, int fr, int fq, LAS unsigned char*) const {
        const int row0 = u.pm * 256 + wr * 64 + fr, col0 = u.pn * 256 + wc * 64 + 8 * fq;
#pragma unroll
        for (int ai = 0; ai < 2; ++ai)
#pragma unroll
            for (int m = 0; m < 4; ++m) {
                const int row = row0 + ai * 128 + m * 16;
                bf16_t* hp = HB + (size_t)row * DM + col0;
                const float* sp = nullptr;
                if (MODE == 0) { const int b = row / PP, p = row % PP; sp = (p < NVALID0) ? nullptr : (p < BLK) ? meta0 + (size_t)(p - NVALID0) * DM + col0 : x0 + ((size_t)b * SEQ + (p - BLK)) * DM + col0; }
                f32x4 v[2][2];
#pragma unroll
                for (int bj = 0; bj < 2; ++bj) {
                    if (MODE == 0) { v[bj][0] = sp ? *(const f32x4*)(sp + bj * 32) : (f32x4){0.f, 0.f, 0.f, 0.f}; v[bj][1] = sp ? *(const f32x4*)(sp + bj * 32 + 4) : (f32x4){0.f, 0.f, 0.f, 0.f}; }
                    else { const u32x4 q = *(const u32x4*)(hp + bj * 32);
                        v[bj][0] = (f32x4){__uint_as_float(q.x << 16), __uint_as_float(q.x & 0xffff0000u), __uint_as_float(q.y << 16), __uint_as_float(q.y & 0xffff0000u)};
                        v[bj][1] = (f32x4){__uint_as_float(q.z << 16), __uint_as_float(q.z & 0xffff0000u), __uint_as_float(q.w << 16), __uint_as_float(q.w & 0xffff0000u)}; }
                }
                float ss = 0.f;
#pragma unroll
                for (int bj = 0; bj < 2; ++bj) {
                    const f32x4 h0 = v[bj][0] + acc[ai][bj][m][0], h1 = v[bj][1] + acc[ai][bj][m][1];
                    ss += (h0[0] * h0[0] + h0[1] * h0[1]) + (h0[2] * h0[2] + h0[3] * h0[3]) + (h1[0] * h1[0] + h1[1] * h1[1]) + (h1[2] * h1[2] + h1[3] * h1[3]);
                    if (MODE == 2) { *(f32x4*)(H32 + (size_t)row * DM + col0 + bj * 32) = h0; *(f32x4*)(H32 + (size_t)row * DM + col0 + bj * 32 + 4) = h1; }
                    else { u32x4 w; w.x = cvtpk(h0[0], h0[1]); w.y = cvtpk(h0[2], h0[3]); w.z = cvtpk(h1[0], h1[1]); w.w = cvtpk(h1[2], h1[3]); *(u32x4*)(hp + bj * 32) = w; }
                }
                ss += __shfl_xor(ss, 16); ss += __shfl_xor(ss, 32);
                if (fq == 0) atomicAdd(rowsq + row, ss);
            }
    }
};

#define DPP_SHR1(old, src) __builtin_bit_cast(float, __builtin_amdgcn_update_dpp(__builtin_bit_cast(int, (old)), __builtin_bit_cast(int, (src)), 0x111, 0xF, 0xF, false))
#define DPP_SHR2(old, src) __builtin_bit_cast(float, __builtin_amdgcn_update_dpp(__builtin_bit_cast(int, (old)), __builtin_bit_cast(int, (src)), 0x112, 0xF, 0xF, false))
#define DPP_ROR1(src) __builtin_bit_cast(float, __builtin_amdgcn_update_dpp(0, __builtin_bit_cast(int, (src)), 0x121, 0xF, 0xF, false))
#define DPP_ROR2(src) __builtin_bit_cast(float, __builtin_amdgcn_update_dpp(0, __builtin_bit_cast(int, (src)), 0x122, 0xF, 0xF, false))
struct EpiFfnUp {
    static constexpr bool PERM = true, BINTER = false;
    bf16_t* ACT; const float* wconv; const float* bconv; const float* rsq;
    DI void operator()(const AccT& acc, const pg8::Unit& u, int wr, int wc, int fr, int fq, LAS unsigned char* lds) const {
        LAS float* halo = (LAS float*)(lds + 131072);
        const int vbase = 254 * u.pm - 2;
        const int cl = wc * 32 + 8 * fq;
        const int cg0 = u.pn * 128 + cl;
        float rv[2][4], rg[2][4];
#pragma unroll
        for (int ai = 0; ai < 2; ++ai)
#pragma unroll
            for (int m = 0; m < 4; ++m) { const int v = vbase + ai * 128 + wr * 64 + m * 16 + fr; const bool inr = v >= 0 && v < MROWS;
                const float r = inr ? __builtin_amdgcn_rsqf(rsq[inr ? v : 0] * (1.0f / DM) + EPS) : 0.f;
                rv[ai][m] = r; rg[ai][m] = (inr && (v % PP) >= NVALID0) ? r : 0.f; }
        f32x4 w0[2], w1[2], w2[2], bb[2];
#pragma unroll
        for (int n = 0; n < 2; ++n) { w0[n] = *(const f32x4*)(wconv + cg0 + 4 * n); w1[n] = *(const f32x4*)(wconv + DFF + cg0 + 4 * n); w2[n] = *(const f32x4*)(wconv + 2 * DFF + cg0 + 4 * n); bb[n] = *(const f32x4*)(bconv + cg0 + 4 * n); }
        if (fr >= 14) {
#pragma unroll
            for (int ai = 0; ai < 2; ++ai)
#pragma unroll
                for (int n = 0; n < 2; ++n) *(LAS f32x4*)(halo + ((2 * ai + wr) * 2 + (fr - 14)) * 128 + cl + 4 * n) = acc[ai][0][3][n] * rg[ai][3];
        }
        asm volatile("s_waitcnt lgkmcnt(0)" ::: "memory"); __builtin_amdgcn_s_barrier(); asm volatile("" ::: "memory");
#pragma unroll
        for (int ai = 0; ai < 2; ++ai) {
            const int grp = 2 * ai + wr;
            f32x4 pa[2], pb[2];
#pragma unroll
            for (int n = 0; n < 2; ++n) {
                if (grp > 0) {
                    const f32x4 h0 = *(LAS const f32x4*)(halo + ((grp - 1) * 2 + 0) * 128 + cl + 4 * n);
                    const f32x4 h1 = *(LAS const f32x4*)(halo + ((grp - 1) * 2 + 1) * 128 + cl + 4 * n);
                    pa[n] = h1; pb[n] = (fr == 0) ? h0 : h1;
                } else { pa[n] = (f32x4){0.f, 0.f, 0.f, 0.f}; pb[n] = pa[n]; }
            }
#pragma unroll
            for (int m = 0; m < 4; ++m) {
                const int lr = ai * 128 + wr * 64 + m * 16 + fr; const int v = vbase + lr;
                u32x4 w;
#pragma unroll
                for (int n = 0; n < 2; ++n) {
                    const f32x4 gv = acc[ai][0][m][n] * rg[ai][m];
                    f32x4 g1, g2;
#pragma unroll
                    for (int j = 0; j < 4; ++j) { float t = gv[j]; asm volatile("" : "+v"(t));
                        const float r1 = DPP_ROR1(t), r2 = DPP_ROR2(t); g1[j] = (fr >= 1) ? r1 : pa[n][j]; g2[j] = (fr >= 2) ? r2 : pb[n][j]; pa[n][j] = r1; pb[n][j] = r2; }
                    const f32x4 cv = bb[n] + w0[n] * g2 + w1[n] * g1 + w2[n] * gv;
                    const f32x4 vv = acc[ai][1][m][n] * rv[ai][m];
                    f32x4 o;
#pragma unroll
                    for (int j = 0; j < 4; ++j) o[j] = cv[j] * __builtin_amdgcn_rcpf(1.0f + __builtin_amdgcn_exp2f(-LOG2E * cv[j])) * vv[j];
                    if (n == 0) { w.x = cvtpk(o[0], o[1]); w.y = cvtpk(o[2], o[3]); } else { w.z = cvtpk(o[0], o[1]); w.w = cvtpk(o[2], o[3]); }
                }
                if (lr >= 2 && v < MROWS) *(u32x4*)(ACT + (size_t)v * DFF + cg0) = w;
            }
        }
    }
};

template <int NCH> DI void tile_load(const bf16_t* src, int ld, u32x4 (&v)[NCH], int tid) {
#pragma unroll
    for (int i = 0; i < NCH; ++i) { const int c = tid + NTHREADS * i, row = c >> 4, ch = c & 15; v[i] = *(const u32x4*)(src + (size_t)row * ld + ch * 8); }
}
template <int NCH> DI void tile_store(LAS unsigned char* img, const u32x4 (&v)[NCH], int tid) {
#pragma unroll
    for (int i = 0; i < NCH; ++i) { const int c = tid + NTHREADS * i, row = c >> 4, ch = c & 15; *(LAS u32x4*)(img + off_b(row, ch)) = v[i]; }
}

DI void tile_dma64(const bf16_t* src, int ld, LAS unsigned char* img, int wave, int lane) {
#pragma unroll
    for (int i = 0; i < 2; ++i) {
        const unsigned L = (unsigned)((wave * 2 + i) * 64 + lane), row = L >> 4, cpos = L & 15;
        const unsigned ch = cpos ^ (((row & 3u) << 2) | ((row >> 2) & 3u));
        __builtin_amdgcn_global_load_lds((const unsigned*)(src + (size_t)row * ld + ch * 8), (LAS unsigned*)(img + (wave * 2 + i) * 1024), 16, 0, 0);
    }
}
DI void glds16(const void* gsrc, unsigned lds_dst) { unsigned keep;
    asm volatile("s_mov_b32 %0, m0\n\ts_mov_b32 m0, %2\n\ts_nop 0\n\tglobal_load_lds_dwordx4 %1, off\n\ts_mov_b32 m0, %0" : "=&s"(keep) : "v"(gsrc), "s"(lds_dst) : "memory"); }
DI void tile_dma64_asm(const bf16_t* src, int ld, LAS unsigned char* img, int wave, int lane) {
#pragma unroll
    for (int i = 0; i < 2; ++i) {
        const unsigned L = (unsigned)((wave * 2 + i) * 64 + lane), row = L >> 4, cpos = L & 15;
        const unsigned ch = cpos ^ (((row & 3u) << 2) | ((row >> 2) & 3u));
        glds16(src + (size_t)row * ld + ch * 8, (unsigned)__builtin_amdgcn_readfirstlane((int)((unsigned)(uintptr_t)img + (unsigned)(wave * 2 + i) * 1024u)));
    }
}

DI void retention_item(const Params& P, LAS unsigned char* lds, int b, int hd, int nfull0, int nend) {
    const int tid = threadIdx.x, lane = tid & 63, w = __builtin_amdgcn_readfirstlane(tid >> 6), r = lane & 31, h = lane >> 5, ib = w & 3, eh = w >> 2;
    LAS unsigned char* Qimg = lds; LAS unsigned char* Kimg = lds + 32768; LAS unsigned char* Vimg = lds + 65536; LAS unsigned char* Timg = lds + 98304;
    LAS f32x2* X = (LAS f32x2*)(lds + 131072);
    const bf16_t* proj = (const bf16_t*)(P.ws + WS_BIG) + (size_t)(b * PP) * AB_IN;
    bf16_t* MIX = (bf16_t*)P.out;
    const float lg = __builtin_log2f(1.0f - __builtin_exp2f(-5.0f - (float)hd));
    const float g128 = __builtin_exp2f(128.0f * lg);
    __syncthreads();
    for (int i = tid; i < 2048; i += NTHREADS) ((LAS u32x4*)Timg)[i] = (u32x4){0u, 0u, 0u, 0u};
    f32x16 st[2];
#pragma unroll
    for (int i = 0; i < 16; ++i) { st[0][i] = 0.f; st[1][i] = 0.f; }
    u32x4 pq[4], pk[4], pv[4];
    if (nfull0 == 0) tile_load<4>(proj + hd * 128, AB_IN, pq, tid);
    tile_load<4>(proj + 512 + hd * 128, AB_IN, pk, tid); tile_load<4>(proj + 1024 + hd * 128, AB_IN, pv, tid);
    const float* rn = P.ab_ret_norm + hd * 128;
    for (int n = 0; n < nend; ++n) {
        const bool full = n >= nfull0;
        __syncthreads();
        if (full) tile_store<4>(Qimg, pq, tid);
        tile_store<4>(Kimg, pk, tid); tile_store<4>(Vimg, pv, tid);
        __syncthreads();
        if (n + 1 < nend) { const bf16_t* s = proj + (size_t)(n + 1) * 128 * AB_IN;
            if (n + 1 >= nfull0) tile_load<4>(s + hd * 128, AB_IN, pq, tid);
            tile_load<4>(s + 512 + hd * 128, AB_IN, pk, tid); tile_load<4>(s + 1024 + hd * 128, AB_IN, pv, tid); }
        f32x16 o[2];
#pragma unroll
        for (int i = 0; i < 16; ++i) { o[0][i] = 0.f; o[1][i] = 0.f; }
        if (full) {
#pragma unroll 2
        for (int s = 0; s < 8; ++s) { const bf16x8 qv = row_frag(Qimg, 32 * ib + r, 2 * s + h);
#pragma unroll
            for (int ec = 0; ec < 2; ++ec) { const bf16x8 a = tr_nat(Timg, 16 * s, 2 * eh + ec, lane); o[ec] = MFMA32(a, qv, o[ec]); } }
        for (int jb = 0; jb <= ib; ++jb) {
            f32x16 S;
#pragma unroll
            for (int i = 0; i < 16; ++i) S[i] = 0.f;
#pragma unroll 1
            for (int s = 0; s < 8; ++s) { const bf16x8 a = row_frag(Kimg, 32 * jb + r, 2 * s + h); const bf16x8 qv = row_frag(Qimg, 32 * ib + r, 2 * s + h); S = MFMA32(a, qv, S); }
            if (jb == ib) {
#pragma unroll
                for (int i = 0; i < 16; ++i) if (CROWC(i) + 4 * h > r) S[i] = 0.f;
            }
            const bf16x8 p0 = pack8(S[0], S[1], S[2], S[3], S[4], S[5], S[6], S[7]), p1 = pack8(S[8], S[9], S[10], S[11], S[12], S[13], S[14], S[15]);
#pragma unroll
            for (int ec = 0; ec < 2; ++ec) {
                const bf16x8 a0 = tr_perm(Vimg, 32 * jb, 2 * eh + ec, lane); o[ec] = MFMA32(a0, p0, o[ec]);
                const bf16x8 a1 = tr_perm(Vimg, 32 * jb + 16, 2 * eh + ec, lane); o[ec] = MFMA32(a1, p1, o[ec]);
            }
        }
        }
#pragma unroll 1
        for (int s = 0; s < 8; ++s) {
            const bf16x8 bk = tr_nat(Kimg, 16 * s, ib, lane);
#pragma unroll
            for (int ec = 0; ec < 2; ++ec) { const bf16x8 av = tr_nat(Vimg, 16 * s, 2 * eh + ec, lane); st[ec] = MFMA32(av, bk, st[ec]); }
        }
#pragma unroll
        for (int i = 0; i < 16; ++i) { st[0][i] *= g128; st[1][i] *= g128; }
        float s1 = 0.f, s2 = 0.f;
#pragma unroll
        for (int ec = 0; ec < 2; ++ec)
#pragma unroll
            for (int i = 0; i < 16; ++i) { s1 += o[ec][i]; s2 += o[ec][i] * o[ec][i]; }
        s1 += __shfl_xor(s1, 32); s2 += __shfl_xor(s2, 32);
        if (h == 0) X[(eh * 4 + ib) * 32 + r] = (f32x2){s1, s2};
        __syncthreads();
#pragma unroll
        for (int ec = 0; ec < 2; ++ec)
#pragma unroll
            for (int g = 0; g < 4; ++g) { u32x2 wv; wv.x = cvtpk(st[ec][4 * g], st[ec][4 * g + 1]); wv.y = cvtpk(st[ec][4 * g + 2], st[ec][4 * g + 3]);
                *(LAS u32x2*)(Timg + off_b(32 * ib + r, 4 * (2 * eh + ec) + g) + 8 * h) = wv; }
        if (!full) continue;
        const f32x2 xo = X[((1 - eh) * 4 + ib) * 32 + r];
        const float mean = (s1 + xo.x) * (1.0f / 128.0f);
        const float var = (s2 + xo.y) * (1.0f / 128.0f) - mean * mean;
        const float rstd = __builtin_amdgcn_rsqf(fmaxf(var, 0.f) + EPS);
        const size_t m = (size_t)(b * PP) + n * 128 + 32 * ib + r;
        const bf16_t* rg = (const bf16_t*)(P.ws + WS_BIG) + m * AB_IN + 1536 + hd * 128;
        bf16_t* op = MIX + m * DM + hd * 128;
#pragma unroll
        for (int ec = 0; ec < 2; ++ec)
#pragma unroll
            for (int g = 0; g < 4; ++g) {
                const int e = 32 * (2 * eh + ec) + 8 * g + 4 * h;
                const u32x2 gr = *(const u32x2*)(rg + e);
                const f32x4 nw = *(const f32x4*)(rn + e);
                float gate[4] = {__uint_as_float(gr.x << 16), __uint_as_float(gr.x & 0xffff0000u), __uint_as_float(gr.y << 16), __uint_as_float(gr.y & 0xffff0000u)};
                float y[4];
#pragma unroll
                for (int j = 0; j < 4; ++j) { const float sg = gate[j] * __builtin_amdgcn_rcpf(1.0f + __builtin_amdgcn_exp2f(-LOG2E * gate[j])); y[j] = (o[ec][4 * g + j] - mean) * rstd * nw[j] * sg; }
                u32x2 wv; wv.x = cvtpk(y[0], y[1]); wv.y = cvtpk(y[2], y[3]);
                *(u32x2*)(op + e) = wv;
            }
    }
}

DI void diffattn_item(const Params& P, LAS unsigned char* lds, int b, int hd, int qb, float lam, const float* kinf) {
    const int tid = threadIdx.x, lane = tid & 63, w = __builtin_amdgcn_readfirstlane(tid >> 6), r = lane & 31, h = lane >> 5, wq = w & 3, mp = w >> 2;
    LAS float* XO = (LAS float*)lds;
    LAS unsigned* flags = (LAS unsigned*)(lds + 131072);
    const bf16_t* proj = (const bf16_t*)(P.ws + WS_BIG) + (size_t)(b * PP) * AB_IN;
    bf16_t* MIX = (bf16_t*)P.out;
    const int qpos = 128 * qb + 32 * wq + r;
    const float slope = __builtin_exp2f(-2.0f * (float)(hd + 1));
    const float c2 = slope * LOG2E;
    bf16x8 qf[4];
    float q1 = 0.f;
    { const bf16_t* qp = proj + (size_t)qpos * AB_IN + 2048 + hd * 128 + mp * 64 + 8 * h;
#pragma unroll
      for (int s = 0; s < 4; ++s) { qf[s] = *(const bf16x8*)(qp + 16 * s);
#pragma unroll
          for (int j = 0; j < 8; ++j) q1 += fabsf(bf2f((unsigned short)qf[s][j])); } }
    q1 += __shfl_xor(q1, 32);
    const float sbound = q1 * kinf[hd * 2 + mp] * 1.01f + 1.0f;
    f32x16 O[4];
#pragma unroll
    for (int c = 0; c < 4; ++c)
#pragma unroll
        for (int i = 0; i < 16; ++i) O[c][i] = 0.f;
    float mrun = -1e30f, lrun = 0.f;
    const int ktop = 2 * qb + 1;
    unsigned vlo0, vhi0; tr_perm_offs(0, lane, vlo0, vhi0);
    const unsigned kof0 = off_b(r, 8 * mp + h);
#define DF_DMA(kt_, slot_) do { LAS unsigned char* nb_ = lds + (slot_) * 32768; \
        tile_dma64_asm(proj + (size_t)(64 * (kt_)) * AB_IN + 2560 + hd * 128, AB_IN, nb_, w, lane); \
        tile_dma64_asm(proj + (size_t)(64 * (kt_)) * AB_IN + 3072 + hd * 128, AB_IN, nb_ + 16384, w, lane); } while (0)
#define DF_QK(Sa, Sb, slot_) do { LAS unsigned char* kb_ = lds + (slot_) * 32768; \
        _Pragma("unroll") for (int i = 0; i < 16; ++i) { Sa[i] = 0.f; Sb[i] = 0.f; } \
        bf16x8 ka_[8]; \
        _Pragma("unroll") for (int s = 0; s < 4; ++s) { ka_[2 * s] = *(LAS const bf16x8*)(kb_ + (kof0 ^ (32u * s))); ka_[2 * s + 1] = *(LAS const bf16x8*)(kb_ + (kof0 ^ (32u * s)) + 8192); } \
        __builtin_amdgcn_sched_barrier(0); \
        _Pragma("unroll") for (int s = 0; s < 4; ++s) { Sa = MFMA32(ka_[2 * s], qf[s], Sa); Sb = MFMA32(ka_[2 * s + 1], qf[s], Sb); } } while (0)
    __syncthreads();
    DF_DMA(ktop, 0); DF_DMA(ktop - 1, 1);
    if (tid < 16) flags[tid] = 0u;
    asm volatile("s_waitcnt vmcnt(0)" ::: "memory");
    __syncthreads();
    f32x16 S0, S1;
    DF_QK(S0, S1, 0);
    int slot = 0;
    bf16x8 pp0 = {0, 0, 0, 0, 0, 0, 0, 0}, pp1 = pp0, pp2 = pp0, pp3 = pp0;
    LAS unsigned char* vprev = lds + 16384;
#define DF_LDV(c_, dst_, Vimg_) do { const unsigned vl_ = vlo0 ^ (64u * (c_)), vh_ = vhi0 ^ (64u * (c_)); \
        dst_[0] = tr_at(Vimg_, vl_, vh_, 0); dst_[1] = tr_at(Vimg_, vl_, vh_, 4096); dst_[2] = tr_at(Vimg_, vl_, vh_, 8192); dst_[3] = tr_at(Vimg_, vl_, vh_, 12288); } while (0)
#define DF_EXP4(S_, b_) do { _Pragma("unroll") for (int i_ = 0; i_ < 4; ++i_) { float e_ = __builtin_amdgcn_exp2f(S_[(b_) + i_] + dl); asm volatile("" : "+v"(e_));   S_[(b_) + i_] = e_; ps += e_; } } while (0)
    for (int kt = ktop; kt >= 0; --kt) {
        asm volatile("s_waitcnt vmcnt(0) lgkmcnt(0)\n\ts_barrier" ::: "memory");
        { LAS const unsigned* fr_ = flags + ((kt + 1) & 1) * 8;
          const u32x4 f0 = *(LAS const u32x4*)fr_, f1 = *(LAS const u32x4*)(fr_ + 4);
          if ((f0.x & f0.y & f0.z & f0.w & f1.x & f1.y & f1.z & f1.w) != 0u) break; }
        const int slot1 = (slot + 1) & 3;
        if (kt >= 2) DF_DMA(kt - 2, (slot + 2) & 3);
        LAS unsigned char* Vimg = lds + slot * 32768 + 16384;
        const bool boundary = (kt >= 2 * qb) || (kt < 2);
        const int k0 = 64 * kt + 4 * h;
        const float u0 = c2 * (float)(k0 - qpos);
        float amax = -3.0e38f;
        if (boundary) {
#pragma unroll
            for (int i = 0; i < 16; ++i) {
                float t0 = fmaf(c2, (float)CROWC(i), S0[i]), t1 = fmaf(c2, (float)(32 + CROWC(i)), S1[i]);
                const int kp = k0 + CROWC(i); if (kp > qpos || kp < NVALID0) t0 = -1e30f; if (kp + 32 > qpos || kp + 32 < NVALID0) t1 = -1e30f;
                S0[i] = t0; S1[i] = t1; amax = fmaxf(amax, fmaxf(t0, t1));
            }
        } else {
#pragma unroll
            for (int i = 0; i < 16; ++i) {
                const float t0 = fmaf(c2, (float)CROWC(i), S0[i]), t1 = fmaf(c2, (float)(32 + CROWC(i)), S1[i]);
                S0[i] = t0; S1[i] = t1; amax = fmaxf(amax, fmaxf(t0, t1));
            }
        }
        amax = fmaxf(amax + u0, -1e30f);
        const float bmax = fmaxf(amax, __shfl_xor(amax, 32));
        const float mold = mrun;
        mrun = fmaxf(mrun, bmax);
        const float dl = u0 - mrun;
        float ps = 0.f;
        {
            bf16x8 va[2][4];
            DF_LDV(0, va[0], vprev);
            DF_LDV(1, va[1], vprev);
            __builtin_amdgcn_sched_barrier(0);
            O[0] = MFMA32(va[0][0], pp0, O[0]); O[0] = MFMA32(va[0][1], pp1, O[0]); O[0] = MFMA32(va[0][2], pp2, O[0]); O[0] = MFMA32(va[0][3], pp3, O[0]);
            DF_EXP4(S0, 0); DF_EXP4(S1, 0);
            __builtin_amdgcn_sched_barrier(0);
            DF_LDV(2, va[0], vprev);
            O[1] = MFMA32(va[1][0], pp0, O[1]); O[1] = MFMA32(va[1][1], pp1, O[1]); O[1] = MFMA32(va[1][2], pp2, O[1]); O[1] = MFMA32(va[1][3], pp3, O[1]);
            DF_EXP4(S0, 4); DF_EXP4(S1, 4);
            __builtin_amdgcn_sched_barrier(0);
            DF_LDV(3, va[1], vprev);
            O[2] = MFMA32(va[0][0], pp0, O[2]); O[2] = MFMA32(va[0][1], pp1, O[2]); O[2] = MFMA32(va[0][2], pp2, O[2]); O[2] = MFMA32(va[0][3], pp3, O[2]);
            DF_EXP4(S0, 8); DF_EXP4(S1, 8);
            __builtin_amdgcn_sched_barrier(0);
            O[3] = MFMA32(va[1][0], pp0, O[3]); O[3] = MFMA32(va[1][1], pp1, O[3]); O[3] = MFMA32(va[1][2], pp2, O[3]); O[3] = MFMA32(va[1][3], pp3, O[3]);
            DF_EXP4(S0, 12); DF_EXP4(S1, 12);
            __builtin_amdgcn_sched_barrier(0);
        }
        if (__any(mrun > mold)) {
            const float al = __builtin_amdgcn_exp2f(mold - mrun);
            lrun *= al;
#pragma unroll
            for (int c = 0; c < 4; ++c)
#pragma unroll
                for (int i = 0; i < 16; ++i) O[c][i] *= al;
        }
        lrun += ps;
        pp0 = pack8(S0[0], S0[1], S0[2], S0[3], S0[4], S0[5], S0[6], S0[7]); pp1 = pack8(S0[8], S0[9], S0[10], S0[11], S0[12], S0[13], S0[14], S0[15]);
        pp2 = pack8(S1[0], S1[1], S1[2], S1[3], S1[4], S1[5], S1[6], S1[7]); pp3 = pack8(S1[8], S1[9], S1[10], S1[11], S1[12], S1[13], S1[14], S1[15]);
        vprev = Vimg;
        const bool okw = __all(sbound + c2 * (float)(64 * kt - 1 - qpos) - mrun < -150.0f);
        if (lane == 0) flags[(kt & 1) * 8 + w] = okw ? 1u : 0u;
        if (kt >= 1) DF_QK(S0, S1, slot1);
        slot = slot1;
    }
    {
        bf16x8 va[2][4];
        DF_LDV(0, va[0], vprev);
#pragma unroll
        for (int c = 0; c < 4; ++c) { if (c < 3) DF_LDV(c + 1, va[(c + 1) & 1], vprev); __builtin_amdgcn_sched_barrier(0);
            O[c] = MFMA32(va[c & 1][0], pp0, O[c]); O[c] = MFMA32(va[c & 1][1], pp1, O[c]); O[c] = MFMA32(va[c & 1][2], pp2, O[c]); O[c] = MFMA32(va[c & 1][3], pp3, O[c]);
            __builtin_amdgcn_sched_barrier(0); }
    }
#undef DF_EXP4
#undef DF_LDV
#undef DF_DMA
#undef DF_QK
    asm volatile("s_waitcnt vmcnt(0)" ::: "memory");
    __syncthreads();
    lrun += __shfl_xor(lrun, 32);
    const float inv = 1.0f / lrun;
    if (mp == 1) {
#pragma unroll
        for (int c = 0; c < 4; ++c)
#pragma unroll
            for (int i = 0; i < 16; ++i) XO[(wq * 64 + c * 16 + i) * 64 + lane] = O[c][i] * inv;
    }
    __syncthreads();
    if (mp == 0) {
        float ss = 0.f;
#pragma unroll
        for (int c = 0; c < 4; ++c)
#pragma unroll
            for (int i = 0; i < 16; ++i) { const float d = O[c][i] * inv - lam * XO[(wq * 64 + c * 16 + i) * 64 + lane]; O[c][i] = d; ss += d * d; }
        ss += __shfl_xor(ss, 32);
        const float rs = __builtin_amdgcn_rsqf(ss * (1.0f / 128.0f) + EPS) * 0.8f;
        const float* dn = P.ab_diff_norm + hd * 128;
        bf16_t* op = MIX + (size_t)(b * PP + qpos) * DM + 512 + hd * 128;
#pragma unroll
        for (int c = 0; c < 4; ++c)
#pragma unroll
            for (int g = 0; g < 4; ++g) {
                const int e = 32 * c + 8 * g + 4 * h;
                const f32x4 nw = *(const f32x4*)(dn + e);
                u32x2 wv; wv.x = cvtpk(O[c][4 * g] * rs * nw[0], O[c][4 * g + 1] * rs * nw[1]); wv.y = cvtpk(O[c][4 * g + 2] * rs * nw[2], O[c][4 * g + 3] * rs * nw[3]);
                *(u32x2*)(op + e) = wv;
            }
    }
}

DI void sb_block(f32x16& S, float& C, float c1, int k0, int qpos, int h, bool boundary) {
    float L[16]; float seg[4];
#pragma unroll
    for (int g = 0; g < 4; ++g) seg[g] = 0.f;
#pragma unroll
    for (int i = 0; i < 16; ++i) {
        const float z = S[i] * c1;
        const float e = __builtin_amdgcn_exp2f(-fabsf(z));
        const float sp = fmaxf(z, 0.f) + __builtin_amdgcn_logf(1.0f + e);
        bool ok = true;
        if (boundary) { const int kp = k0 + CROWC(i); ok = (kp < qpos) && (kp >= NVALID0); }
        L[i] = ok ? -sp : 0.f;
        S[i] = ok ? (z - sp) : -1e30f;
        seg[i >> 2] += L[i];
    }
    float oseg[4];
#pragma unroll
    for (int g = 0; g < 4; ++g) oseg[g] = __shfl_xor(seg[g], 32);
    float R = 0.f;
#pragma unroll
    for (int gi = 0; gi < 4; ++gi) {
        const int g = 3 - gi;
        float lat = C + R + (h == 0 ? oseg[g] : 0.f);
        S[4 * g + 3] = __builtin_amdgcn_exp2f(S[4 * g + 3] + lat); lat += L[4 * g + 3];
        S[4 * g + 2] = __builtin_amdgcn_exp2f(S[4 * g + 2] + lat); lat += L[4 * g + 2];
        S[4 * g + 1] = __builtin_amdgcn_exp2f(S[4 * g + 1] + lat); lat += L[4 * g + 1];
        S[4 * g + 0] = __builtin_amdgcn_exp2f(S[4 * g + 0] + lat);
        R += seg[g] + oseg[g];
    }
    C += R;
}
DI void stickbreak_item(const Params& P, LAS unsigned char* lds, int b, int hp, int qb) {
    const int tid = threadIdx.x, lane = tid & 63, w = __builtin_amdgcn_readfirstlane(tid >> 6), r = lane & 31, h = lane >> 5, wq = w & 3, hs = w >> 2;
    const int hd = 2 * hp + hs;
    LAS unsigned* flags = (LAS unsigned*)(lds + 131072);
    const bf16_t* proj = (const bf16_t*)(P.ws + WS_BIG) + (size_t)(b * PP) * C_IN;
    bf16_t* MIX = (bf16_t*)P.out;
    const int qpos = 128 * qb + 32 * wq + r;
    const float c1 = 0.08838834764831845f * LOG2E;
    bf16x8 qf[8];
    { const bf16_t* qp = proj + (size_t)qpos * C_IN + hd * 128 + 8 * h;
#pragma unroll
      for (int s = 0; s < 8; ++s) qf[s] = *(const bf16x8*)(qp + 16 * s); }
    f32x16 O[4];
#pragma unroll
    for (int c = 0; c < 4; ++c)
#pragma unroll
        for (int i = 0; i < 16; ++i) O[c][i] = 0.f;
    float C = 0.f;
    const int ktop = 2 * qb + 1;
    unsigned vlo0, vhi0; tr_perm_offs(0, lane, vlo0, vhi0);
    const unsigned kof0 = off_b(r, h);
    __syncthreads();
#define SB_DMA(kt_, base_) do { const bf16_t* s_ = proj + (size_t)(64 * (kt_)) * C_IN + hp * 256; \
        tile_dma64_asm(s_ + 1024, C_IN, (base_), w, lane); tile_dma64_asm(s_ + 1024 + 128, C_IN, (base_) + 16384, w, lane); \
        tile_dma64_asm(s_ + 2048, C_IN, (base_) + 32768, w, lane); tile_dma64_asm(s_ + 2048 + 128, C_IN, (base_) + 49152, w, lane); } while (0)
    SB_DMA(ktop, lds);
    if (tid < 16) flags[tid] = 0u;
    int cur = 0;
    for (int kt = ktop; kt >= 0; --kt) {
        asm volatile("s_waitcnt vmcnt(0)" ::: "memory");
        __syncthreads();
        { LAS const unsigned* fr_ = flags + ((kt + 1) & 1) * 8;
          const u32x4 f0 = *(LAS const u32x4*)fr_, f1 = *(LAS const u32x4*)(fr_ + 4);
          if ((f0.x & f0.y & f0.z & f0.w & f1.x & f1.y & f1.z & f1.w) != 0u) break; }
        LAS unsigned char* Kimg = lds + cur * 65536 + hs * 16384; LAS unsigned char* Vimg = Kimg + 32768;
        if (kt > 0) SB_DMA(kt - 1, lds + (cur ^ 1) * 65536);
        cur ^= 1;
        const bool boundary = (kt >= 2 * qb) || (kt < 2);
        const bool skip = (64 * kt >= 128 * qb + 32 * wq + 32);
        if (!skip) {
            f32x16 S0, S1;
#pragma unroll
            for (int i = 0; i < 16; ++i) { S0[i] = 0.f; S1[i] = 0.f; }
#pragma unroll
            for (int s = 0; s < 8; ++s) { const bf16x8 a0 = *(LAS const bf16x8*)(Kimg + (kof0 ^ (32u * s))), a1 = *(LAS const bf16x8*)(Kimg + (kof0 ^ (32u * s)) + 8192);
                S0 = MFMA32(a0, qf[s], S0); S1 = MFMA32(a1, qf[s], S1); }
            sb_block(S1, C, c1, 64 * kt + 32 + 4 * h, qpos, h, boundary);
            sb_block(S0, C, c1, 64 * kt + 4 * h, qpos, h, boundary);
            const bf16x8 p0 = pack8(S0[0], S0[1], S0[2], S0[3], S0[4], S0[5], S0[6], S0[7]), p1 = pack8(S0[8], S0[9], S0[10], S0[11], S0[12], S0[13], S0[14], S0[15]);
            const bf16x8 p2 = pack8(S1[0], S1[1], S1[2], S1[3], S1[4], S1[5], S1[6], S1[7]), p3 = pack8(S1[8], S1[9], S1[10], S1[11], S1[12], S1[13], S1[14], S1[15]);
#pragma unroll
            for (int c = 0; c < 4; ++c) {
                const unsigned vl = vlo0 ^ (64u * c), vh = vhi0 ^ (64u * c);
                const bf16x8 a0 = tr_at(Vimg, vl, vh, 0), a1 = tr_at(Vimg, vl, vh, 4096), a2 = tr_at(Vimg, vl, vh, 8192), a3 = tr_at(Vimg, vl, vh, 12288);
                O[c] = MFMA32(a0, p0, O[c]); O[c] = MFMA32(a1, p1, O[c]); O[c] = MFMA32(a2, p2, O[c]); O[c] = MFMA32(a3, p3, O[c]);
            }
        }
        const bool okw = __all(C < -160.0f);
        if (lane == 0) flags[(kt & 1) * 8 + w] = okw ? 1u : 0u;
    }
#undef SB_DMA
    bf16_t* op = MIX + (size_t)(b * PP + qpos) * DM + hd * 128;
#pragma unroll
    for (int c = 0; c < 4; ++c)
#pragma unroll
        for (int g = 0; g < 4; ++g) {
            const int e = 32 * c + 8 * g + 4 * h;
            u32x2 wv; wv.x = cvtpk(O[c][4 * g], O[c][4 * g + 1]); wv.y = cvtpk(O[c][4 * g + 2], O[c][4 * g + 3]);
            *(u32x2*)(op + e) = wv;
        }
}

DI unsigned f2bf(float f) { unsigned u = __builtin_bit_cast(unsigned, f); return (u + 0x7fffu + ((u >> 16) & 1u)) >> 16; }
DI unsigned pk2(float lo, float hi) { return f2bf(lo) | (f2bf(hi) << 16); }
DI void transpose_item(const float* W, int K, int N, bf16_t* WT, bool ffn_perm, LAS float* scr, int item, int lane, const float* kgain = nullptr) {
    const int nblk = N / 32, kb = item / nblk, nb = item % nblk, k0 = 64 * kb, n0 = 32 * nb;
#pragma unroll 8
    for (int i = 0; i < 32; ++i) { const int kk = 2 * i + (lane >> 5); const float gk = kgain ? kgain[k0 + kk] : 1.0f; scr[kk * 33 + (lane & 31)] = W[(size_t)(k0 + kk) * N + n0 + (lane & 31)] * gk; }
    asm volatile("s_waitcnt lgkmcnt(0)" ::: "memory");
    const int c = lane & 7;
#pragma unroll
    for (int j = 0; j < 4; ++j) { const int n = (lane >> 3) + 8 * j; const LAS float* s = scr + (8 * c) * 33 + n;
        u32x4 o; o.x = pk2(s[0 * 33], s[1 * 33]); o.y = pk2(s[2 * 33], s[3 * 33]); o.z = pk2(s[4 * 33], s[5 * 33]); o.w = pk2(s[6 * 33], s[7 * 33]);
        int col = n0 + n, drow = col;
        if (ffn_perm) { const int isval = col >= DFF; const int cc = isval ? col - DFF : col; drow = (cc >> 7) * 256 + isval * 128 + (cc & 127); }
        *(u32x4*)(WT + (size_t)drow * K + k0 + 8 * c) = o; }
    asm volatile("s_waitcnt lgkmcnt(0)" ::: "memory");
}
DI void norm_store_bf16(const f32x4 (&v)[4], const float* gain, bf16_t* orow, int lane) {
    float s = 0.f;
#pragma unroll
    for (int j = 0; j < 4; ++j) s += (v[j].x * v[j].x + v[j].y * v[j].y) + (v[j].z * v[j].z + v[j].w * v[j].w);
    const float rstd = __builtin_amdgcn_rsqf(wave_sum(s) * (1.0f / DM) + EPS);
#pragma unroll
    for (int j = 0; j < 4; ++j) { const f32x4 g = *(const f32x4*)(gain + 4 * lane + 256 * j);
        u32x2 wv; wv.x = cvtpk(v[j].x * rstd * g.x, v[j].y * rstd * g.y); wv.y = cvtpk(v[j].z * rstd * g.z, v[j].w * rstd * g.w);
        *(u32x2*)(orow + 4 * lane + 256 * j) = wv; }
}

#ifdef NO_RET
#define RET_CALL
#else
#define RET_CALL retention_item(P, lds, (it & 31) >> 2, it & 3, (it < 32) ? 36 : 0, (it < 32) ? 65 : 36);
#endif
#ifdef NO_DIFF
#define DIFF_CALL
#else
#define DIFF_CALL diffattn_item(P, lds, bh >> 2, bh & 3, 64 - (j >> 5), lam, (const float*)(ctl + 16));
#endif
#ifdef NO_SB
#define SB_CALL
#else
#define SB_CALL stickbreak_item(P, lds, bh >> 2, bh & 3, 64 - (it >> 5));
#endif
constexpr int I_OUT = (DM / 64) * (DM / 32), I_UP = (DM / 64) * (2 * DFF / 32), I_DN = (DFF / 64) * (DM / 32), I_IN1 = (DM / 64) * (C_IN / 32);
DI void deferred_convert(const Params& P, LAS unsigned char* lds, unsigned* ctr, int group, int wave, int lane) {
    LAS float* scr = (LAS float*)(lds + wave * 16384);
    const int total = group == 0 ? (I_OUT + I_UP + I_DN) : (I_IN1 + I_OUT + I_UP + I_DN);
    for (;;) {
        int it = 0; if (lane == 0) it = (int)atomicAdd(ctr, 1u);
        it = __builtin_amdgcn_readfirstlane(it);
        if (it >= total) break;
        int q = it;
        if (group == 0) {
            if (q < I_UP) { transpose_item(P.ffn_up, DM, 2 * DFF, (bf16_t*)(P.ws + WS_WUP0), true, scr, q, lane, P.ffn_norm); continue; } q -= I_UP;
            if (q < I_DN) { transpose_item(P.ffn_down, DFF, DM, (bf16_t*)(P.ws + WS_WDN0), false, scr, q, lane); continue; } q -= I_DN;
            transpose_item(P.ab_w_out, DM, DM, (bf16_t*)(P.ws + WS_WOUT0), false, scr, q, lane);
        } else {
            if (q < I_UP) { transpose_item(P.ffn_up + (size_t)DM * 2 * DFF, DM, 2 * DFF, (bf16_t*)(P.ws + WS_WUP1), true, scr, q, lane, P.ffn_norm + DM); continue; } q -= I_UP;
            if (q < I_DN) { transpose_item(P.ffn_down + (size_t)DFF * DM, DFF, DM, (bf16_t*)(P.ws + WS_WDN1), false, scr, q, lane); continue; } q -= I_DN;
            if (q < I_IN1) { transpose_item(P.c_w_in, DM, C_IN, (bf16_t*)(P.ws + WS_WIN1), false, scr, q, lane, P.mix_norm + DM); continue; } q -= I_IN1;
            transpose_item(P.c_w_out, DM, DM, (bf16_t*)(P.ws + WS_WOUT1), false, scr, q, lane);
        }
    }
}


#define XB_TMO      128
#define XB_XCNT(j)  (256  + 64 * (j))
#define XB_XSUB(j)  (1280 + 64 * (j))
#define XB_XGEN(j)  (2304 + 64 * (j))
#define XB_TOP      3328
#define XB_TOPGEN   3392
#define XCD_BAR_WORDS 3456
#define XB_SPIN_CAP (1u << 18)

__device__ __forceinline__ unsigned xb_ld(unsigned* p)              { return __hip_atomic_load(p, __ATOMIC_RELAXED, __HIP_MEMORY_SCOPE_AGENT); }
__device__ __forceinline__ unsigned xb_add(unsigned* p, unsigned v) { return __hip_atomic_fetch_add(p, v, __ATOMIC_RELAXED, __HIP_MEMORY_SCOPE_AGENT); }
__device__ __forceinline__ unsigned xb_xcc_id() { return (unsigned)__builtin_amdgcn_s_getreg((3 << 11) | 20) & 0xFu; }
#define XB_SPIN(cond, bar) do { unsigned _sp = 0; while (cond) { __builtin_amdgcn_s_sleep(1); \
    if ((++_sp & 255u) == 0u) { if (xb_ld(&(bar)[XB_TMO])) break; if (_sp > XB_SPIN_CAP) { atomicAdd(&(bar)[XB_TMO], 1u); break; } } } } while (0)

struct XcdBarrier {
    unsigned* bar; unsigned x;
    volatile LAS unsigned* st;
};

__device__ __forceinline__ XcdBarrier xcd_barrier_post(unsigned* bar, volatile LAS unsigned* st) {
    XcdBarrier b; b.bar = bar; b.x = xb_xcc_id(); b.st = st;
    if (threadIdx.x == 0) (void)xb_add(&bar[XB_XCNT(b.x)], 1u);
    return b;
}
__device__ __forceinline__ void xcd_barrier_complete(unsigned* bar, unsigned x, unsigned& nloc, unsigned& nx) {
    const unsigned G = gridDim.x * gridDim.y * gridDim.z;
    unsigned sum, cnt, mine, sp = 0u;
    for (;;) {
        sum = 0u; cnt = 0u; mine = 0u;
#pragma unroll
        for (unsigned j = 0; j < 16; ++j) { const unsigned c = xb_ld(&bar[XB_XCNT(j)]); sum += c; cnt += (c > 0u) ? 1u : 0u; mine = (j == x) ? c : mine; }
        if (sum == G) break;
        __builtin_amdgcn_s_sleep(1);
        if ((++sp & 255u) == 0u) { if (xb_ld(&bar[XB_TMO])) break; if (sp > XB_SPIN_CAP) { atomicAdd(&bar[XB_TMO], 1u); break; } }
    }
    nloc = mine > 0u ? mine : 1u; nx = cnt > 0u ? cnt : 1u;
}

__device__ __forceinline__ void xcd_barrier(const XcdBarrier& b) {
    asm volatile("s_waitcnt vmcnt(0)" ::: "memory");
    __syncthreads();
    if (threadIdx.x == 0) {
        unsigned* bar = b.bar;
        __builtin_amdgcn_s_waitcnt(0);
        unsigned nloc = b.st[0], nx = b.st[1];
        if (nloc == 0u) { xcd_barrier_complete(bar, b.x, nloc, nx); b.st[0] = nloc; b.st[1] = nx; }
        const unsigned old = xb_add(&bar[XB_XSUB(b.x)], 1u);
        const unsigned gen = old / nloc;
        if (old + 1u == (gen + 1u) * nloc) {
            __builtin_amdgcn_fence(__ATOMIC_RELEASE, "agent");
            asm volatile("s_waitcnt vmcnt(0)" ::: "memory");
            const unsigned og = xb_add(&bar[XB_TOP], 1u);
            const unsigned tg = og / nx;
            if (og + 1u == (tg + 1u) * nx) xb_add(&bar[XB_TOPGEN], 1u);
            else XB_SPIN(xb_ld(&bar[XB_TOPGEN]) == tg, bar);
            __builtin_amdgcn_fence(__ATOMIC_ACQUIRE, "agent");
            xb_add(&bar[XB_XGEN(b.x)], 1u);
            asm volatile("s_waitcnt vmcnt(0)" ::: "memory");
        } else {
            XB_SPIN(xb_ld(&bar[XB_XGEN(b.x)]) == gen, bar);
            __builtin_amdgcn_fence(__ATOMIC_ACQUIRE, "agent");
            asm volatile("s_waitcnt vmcnt(0)" ::: "memory");
        }
    }
    __syncthreads();
}


#ifndef DUP_MASK
#define DUP_MASK 0
#endif
#define NREP(k) (1 + ((DUP_MASK >> (k)) & 1))
constexpr int LDS_BYTES = 147456;
constexpr int NPHASES = 12;

__global__ void __launch_bounds__(NTHREADS, 2) fwd_megakernel(Params P) {
    extern __shared__ __attribute__((aligned(16))) unsigned char lds_raw[];
    LAS unsigned char* lds = (LAS unsigned char*)lds_raw;
    cg::grid_group grid = cg::this_grid();
    const int tid = threadIdx.x, lane = tid & 63, wave = __builtin_amdgcn_readfirstlane(tid >> 6);
    const int G = gridDim.x, gw = blockIdx.x * 8 + wave, NGW = G * 8;
    unsigned* ctl = (unsigned*)(P.ws + WS_CTL);
    bf16_t* Y = (bf16_t*)(P.ws + WS_Y);
    float* H = (float*)(P.ws + WS_H);
    bf16_t* BIG = (bf16_t*)(P.ws + WS_BIG);
    const int lo = P.ph_lo, hi = P.ph_hi;
#define IN(k) (lo <= (k) && (k) < hi)
#define SEAM(k) do { if (IN(k) && IN((k) + 1)) xcd_barrier(xbar); } while (0)

    if (IN(0)) {
        if (blockIdx.x == 0) { if (tid < 64) ctl[tid] = 0u; for (int i = tid; i < XCD_BAR_WORDS; i += NTHREADS) ctl[1024 + i] = 0u; }
        { float* rz = (float*)(P.ws + WS_RSQ); for (int i = blockIdx.x * NTHREADS + tid; i < 4 * MROWS; i += G * NTHREADS) rz[i] = 0.f; }
        LAS float* scr = (LAS float*)(lds + wave * 16384);
        constexpr int I_IN0 = (DM / 64) * (AB_IN / 32);
        for (int it = gw; it < I_IN0; it += NGW) transpose_item(P.ab_w_in, DM, AB_IN, (bf16_t*)(P.ws + WS_WIN0), false, scr, it, lane);
        for (int m = gw; m < MROWS; m += NGW) {
            const int b = m / PP, p = m % PP;
            f32x4 v[4];
            if (p < NVALID0) {
#pragma unroll
                for (int j = 0; j < 4; ++j) v[j] = (f32x4){0.f, 0.f, 0.f, 0.f};
            } else {
                const float* src = (p < BLK) ? P.meta + (size_t)(p - NVALID0) * DM : P.x + ((size_t)b * SEQ + (p - BLK)) * DM;
#pragma unroll
                for (int j = 0; j < 4; ++j) v[j] = *(const f32x4*)(src + 4 * lane + 256 * j);
            }
            norm_store_bf16(v, P.mix_norm, Y + (size_t)m * DM, lane);
        }
    }
    XcdBarrier xbar; xbar.bar = ctl + 1024; xbar.x = 0; xbar.st = (volatile LAS unsigned*)(lds + 147456 - 32);
    if (IN(0) && IN(1)) {
        grid.sync();
        if (tid == 0) { xbar.st[0] = 0u; xbar.st[1] = 0u; }
        __syncthreads();
        xbar = xcd_barrier_post(ctl + 1024, (volatile LAS unsigned*)(lds + 147456 - 32));
    }
    float* RSQ = (float*)(P.ws + WS_RSQ);
    bf16_t* MIXB = (bf16_t*)P.out;
    if (IN(1)) {
        pg8::Gemm g{Y, (const bf16_t*)(P.ws + WS_WIN0), DM, 256}; pg8::StaticOrder S; S.init(MROWS / 256, AB_IN / 256, G, (int)blockIdx.x);
        EpiProj<0> E{BIG, AB_IN, nullptr, ctl + 16};
        for (int rep = 0; rep < NREP(1); ++rep) pg8::gemm_phase(lds, g, S, E);
        deferred_convert(P, lds, ctl + 8, 0, wave, lane);
    }
    SEAM(1);
    if (IN(2)) {
        float d1 = 0.f, d2 = 0.f;
        for (int i = 0; i < 64; ++i) { d1 += P.lq1[i] * P.lk1[i]; d2 += P.lq2[i] * P.lk2[i]; }
        const float lam = __expf(d1) - __expf(d2) + 0.2f;
        LAS int* itm = (LAS int*)(lds + 147456 - 64);
        for (int rep = 0; rep < NREP(2); ++rep) {
#define FETCH_ITEM(dst) do { __syncthreads(); if (tid == 0) itm[0] = (int)atomicAdd(&ctl[0 + 4 * rep], 1u); __syncthreads(); dst = itm[0]; } while (0)
            int it; FETCH_ITEM(it);
#ifdef PROBE_P2
            while (it < 128) { const int itq = it; { const int it = itq & 63; RET_CALL } FETCH_ITEM(it); }
            while (it < 128 + 2 * 32 * 65) { const int j = (it - 128) % (32 * 65); const int bh = j & 31; DIFF_CALL FETCH_ITEM(it); }
#else
            while (it < 64) { RET_CALL FETCH_ITEM(it); }
            while (it < 64 + 32 * 65) { const int j = it - 64; const int bh = j & 31; DIFF_CALL FETCH_ITEM(it); }
#endif
#undef FETCH_ITEM
        }
    }
    SEAM(2);
    if (IN(3)) {
        pg8::Gemm g{MIXB, (const bf16_t*)(P.ws + WS_WOUT0), DM, 256}; pg8::StaticOrder S; S.init(MROWS / 256, DM / 256, G, (int)blockIdx.x);
        EpiResidual<0> E{Y, nullptr, RSQ, P.x, P.meta};
        pg8::gemm_phase(lds, g, S, E);
    }
    SEAM(3);
    if (IN(4)) {
        pg8::Gemm g{Y - 2 * DM, (const bf16_t*)(P.ws + WS_WUP0), DM, 254}; pg8::StaticOrder S; S.init((MROWS + 253) / 254, DFF / 128, G, (int)blockIdx.x);
        EpiFfnUp E{BIG, P.ffn_conv, P.ffn_conv_b, RSQ};
        for (int rep = 0; rep < NREP(4); ++rep) pg8::gemm_phase(lds, g, S, E);
    }
    SEAM(4);
    if (IN(5)) {
        pg8::Gemm g{BIG, (const bf16_t*)(P.ws + WS_WDN0), DFF, 256}; pg8::StaticOrder S; S.init(MROWS / 256, DM / 256, G, (int)blockIdx.x);
        EpiResidual<1> E{Y, nullptr, RSQ + MROWS, nullptr, nullptr};
        pg8::gemm_phase(lds, g, S, E);
        deferred_convert(P, lds, ctl + 9, 1, wave, lane);
    }
    SEAM(5);
    if (IN(6)) {
        pg8::Gemm g{Y, (const bf16_t*)(P.ws + WS_WIN1), DM, 256}; pg8::StaticOrder S; S.init(MROWS / 256, C_IN / 256, G, (int)blockIdx.x);
        EpiProj<1> E{BIG, C_IN, RSQ + MROWS, nullptr};
        pg8::gemm_phase(lds, g, S, E);
    }
    SEAM(6);
    if (IN(7)) {
        LAS int* itm = (LAS int*)(lds + 147456 - 64);
        for (int rep = 0; rep < NREP(7); ++rep)
        for (;;) {
            __syncthreads();
            if (tid == 0) itm[0] = (int)atomicAdd(&ctl[1 + 4 * rep], 1u);
            __syncthreads();
            const int it = itm[0];
            if (it >= 32 * 65) break;
            const int bh = it & 31;
            SB_CALL
        }
    }
    SEAM(7);
    if (IN(8)) {
        pg8::Gemm g{MIXB, (const bf16_t*)(P.ws + WS_WOUT1), DM, 256}; pg8::StaticOrder S; S.init(MROWS / 256, DM / 256, G, (int)blockIdx.x);
        EpiResidual<1> E{Y, nullptr, RSQ + 2 * MROWS, nullptr, nullptr};
        pg8::gemm_phase(lds, g, S, E);
    }
    SEAM(8);
    if (IN(9)) {
        pg8::Gemm g{Y - 2 * DM, (const bf16_t*)(P.ws + WS_WUP1), DM, 254}; pg8::StaticOrder S; S.init((MROWS + 253) / 254, DFF / 128, G, (int)blockIdx.x);
        EpiFfnUp E{BIG, P.ffn_conv + 3 * DFF, P.ffn_conv_b + DFF, RSQ + 2 * MROWS};
        pg8::gemm_phase(lds, g, S, E);
    }
    SEAM(9);
    if (IN(10)) {
        pg8::Gemm g{BIG, (const bf16_t*)(P.ws + WS_WDN1), DFF, 256}; pg8::StaticOrder S; S.init(MROWS / 256, DM / 256, G, (int)blockIdx.x);
        EpiResidual<1> E{Y, nullptr, RSQ + 3 * MROWS, nullptr, nullptr};
        pg8::gemm_phase(lds, g, S, E);
    }
    SEAM(10);
    if (IN(11)) {
        for (int mo = gw; mo < BATCH * SEQ; mo += NGW) {
            const int b = mo / SEQ, sq = mo % SEQ; const size_t m = (size_t)b * PP + BLK + sq;
            const float rstd = __builtin_amdgcn_rsqf(RSQ[3 * MROWS + m] * (1.0f / DM) + EPS);
#pragma unroll
            for (int j = 0; j < 4; ++j) { const u32x2 q = *(const u32x2*)(Y + m * DM + 4 * lane + 256 * j); const f32x4 g = *(const f32x4*)(P.final_norm + 4 * lane + 256 * j);
                const f32x4 v = (f32x4){__uint_as_float(q.x << 16), __uint_as_float(q.x & 0xffff0000u), __uint_as_float(q.y << 16), __uint_as_float(q.y & 0xffff0000u)};
                *(f32x4*)(P.out + (size_t)mo * DM + 4 * lane + 256 * j) = v * rstd * g; }
        }
    }
#undef IN
#undef SEAM
#undef NORM_PHASE
}

#ifndef MK_ONE_LAUNCH
#define MK_ONE_LAUNCH 1
#endif
extern "C" void kernel_launch(void* const* d_in, const int* in_sizes, int n_in, void* d_out, int out_size, void* d_ws, size_t ws_size, hipStream_t stream) {
    static int grid = 0;
    if (grid == 0) {
        if (n_in != 19 || ws_size < WS_END) { fprintf(stderr, "kernel_launch: unexpected n_in %d or ws_size %zu (need %zu)\n", n_in, ws_size, (size_t)WS_END); grid = -1; return; }
        int dev = 0, cus = 0, per_cu = 0;
        hipGetDevice(&dev); hipDeviceGetAttribute(&cus, hipDeviceAttributeMultiprocessorCount, dev);
        if (hipFuncSetAttribute((const void*)fwd_megakernel, hipFuncAttributeMaxDynamicSharedMemorySize, LDS_BYTES) != hipSuccess) { fprintf(stderr, "kernel_launch: hipFuncSetAttribute failed\n"); grid = -1; return; }
        if (hipOccupancyMaxActiveBlocksPerMultiprocessor(&per_cu, (const void*)fwd_megakernel, NTHREADS, LDS_BYTES) != hipSuccess || per_cu < 1) { fprintf(stderr, "kernel_launch: occupancy query says %d\n", per_cu); per_cu = 1; }
        (void)hipGetLastError();
        grid = cus * 1;
        if (grid <= 0) grid = 256;
    }
    if (grid < 0) return;
    Params p{};
    p.x = (const float*)d_in[0]; p.meta = (const float*)d_in[1]; p.mix_norm = (const float*)d_in[2]; p.ffn_norm = (const float*)d_in[3];
    p.ffn_up = (const float*)d_in[4]; p.ffn_conv = (const float*)d_in[5]; p.ffn_conv_b = (const float*)d_in[6]; p.ffn_down = (const float*)d_in[7];
    p.ab_w_in = (const float*)d_in[8]; p.ab_ret_norm = (const float*)d_in[9]; p.ab_diff_norm = (const float*)d_in[10];
    p.lq1 = (const float*)d_in[11]; p.lk1 = (const float*)d_in[12]; p.lq2 = (const float*)d_in[13]; p.lk2 = (const float*)d_in[14]; p.ab_w_out = (const float*)d_in[15];
    p.c_w_in = (const float*)d_in[16]; p.c_w_out = (const float*)d_in[17]; p.final_norm = (const float*)d_in[18];
    p.out = (float*)d_out; p.ws = (unsigned char*)d_ws;
#if MK_ONE_LAUNCH
    p.ph_lo = 0; p.ph_hi = NPHASES;
    void* args[] = {&p};
    hipError_t e = hipLaunchCooperativeKernel((const void*)fwd_megakernel, dim3(grid), dim3(NTHREADS), args, LDS_BYTES, stream);
    if (e != hipSuccess) fprintf(stderr, "cooperative launch failed: %s (grid %d)\n", hipGetErrorString(e), grid);
#else
    for (int ph = 0; ph < NPHASES; ++ph) {
        p.ph_lo = ph; p.ph_hi = ph + 1;
        hipLaunchKernelGGL(fwd_megakernel, dim3(grid), dim3(NTHREADS), LDS_BYTES, stream, p);
    }
#endif
}
```

```cpp
#include <hip/hip_runtime.h>
#include <hip/hip_cooperative_groups.h>
#include <cstdio>
#include <cstdint>
namespace cg = cooperative_groups;

#define LAS __attribute__((address_space(3)))
#define DI __device__ __forceinline__
typedef unsigned short bf16_t;
typedef short bf16x8 __attribute__((ext_vector_type(8)));
typedef short s16x4 __attribute__((ext_vector_type(4)));
typedef float f32x2 __attribute__((ext_vector_type(2)));
typedef float f32x4 __attribute__((ext_vector_type(4)));
typedef float f32x16 __attribute__((ext_vector_type(16)));
typedef unsigned u32x2 __attribute__((ext_vector_type(2)));
typedef unsigned u32x4 __attribute__((ext_vector_type(4)));
typedef __bf16 bf16x2_t __attribute__((ext_vector_type(2)));

constexpr int BATCH = 8, SEQ = 8192, DM = 1024, BLK = 128, NMETA = 16;
constexpr int PP = SEQ + BLK;
constexpr int MROWS = BATCH * PP;
constexpr int NVALID0 = BLK - NMETA;
constexpr int DFF = 2816;
constexpr int AB_IN = 3584, C_IN = 3072;
constexpr float EPS = 1e-6f;
constexpr float LOG2E = 1.4426950408889634f;
constexpr int NTHREADS = 512;

constexpr size_t MiB = 1u << 20;
constexpr size_t WS_CTL = 0;
constexpr size_t WS_WIN0 = 1 * MiB, WS_WOUT0 = 8 * MiB, WS_WUP0 = 10 * MiB, WS_WDN0 = 21 * MiB;
constexpr size_t WS_WIN1 = 27 * MiB, WS_WOUT1 = 33 * MiB, WS_WUP1 = 35 * MiB, WS_WDN1 = 46 * MiB;
constexpr size_t WS_YPAD = 52 * MiB;
constexpr size_t WS_Y = WS_YPAD + 2 * 2048;
constexpr size_t WS_H = 184 * MiB;
constexpr size_t WS_BIG = 444 * MiB;
constexpr size_t WS_RSQ = 899 * MiB;
constexpr size_t WS_END = 901 * MiB;

struct Params {
    const float* x; const float* meta; const float* mix_norm; const float* ffn_norm;
    const float* ffn_up; const float* ffn_conv; const float* ffn_conv_b; const float* ffn_down;
    const float* ab_w_in; const float* ab_ret_norm; const float* ab_diff_norm;
    const float* lq1; const float* lk1; const float* lq2; const float* lk2; const float* ab_w_out;
    const float* c_w_in; const float* c_w_out; const float* final_norm;
    float* out; unsigned char* ws; int ph_lo, ph_hi;
};

DI unsigned cvtpk(float lo, float hi) { f32x2 v = {lo, hi}; bf16x2_t b = __builtin_convertvector(v, bf16x2_t); return __builtin_bit_cast(unsigned, b); }
DI float bf2f(unsigned short u) { return __uint_as_float(((unsigned)u) << 16); }
DI bf16x8 pack8(float a0, float a1, float a2, float a3, float a4, float a5, float a6, float a7) {
    u32x4 p; p.x = cvtpk(a0, a1); p.y = cvtpk(a2, a3); p.z = cvtpk(a4, a5); p.w = cvtpk(a6, a7); return __builtin_bit_cast(bf16x8, p);
}
#define MFMA32(a, b, c) __builtin_amdgcn_mfma_f32_32x32x16_bf16((a), (b), (c), 0, 0, 0)
DI float wave_sum(float v) {
#pragma unroll
    for (int o = 1; o < 64; o <<= 1) v += __shfl_xor(v, o);
    return v;
}
DI unsigned off_b(unsigned row, unsigned ch) { return 256u * row + 16u * (ch ^ (((row & 3u) << 2) | ((row >> 2) & 3u))); }
typedef short v4i16_t __attribute__((ext_vector_type(4)));
DI s16x4 trread(LAS const unsigned char* p) { return __builtin_bit_cast(s16x4, __builtin_amdgcn_ds_read_tr16_b64_v4i16((LAS v4i16_t*)p)); }
DI bf16x8 tr_nat(LAS const unsigned char* img, unsigned row16, unsigned c, unsigned lane) {
    const unsigned h = lane >> 5, blk = (lane >> 4) & 1, q = (lane & 15) >> 2, p = lane & 3;
    const s16x4 lo = trread(img + off_b(row16 + 8 * h + q, 4 * c + 2 * blk + (p >> 1)) + 8 * (p & 1));
    const s16x4 hi = trread(img + off_b(row16 + 8 * h + 4 + q, 4 * c + 2 * blk + (p >> 1)) + 8 * (p & 1));
    return __builtin_shufflevector(lo, hi, 0, 1, 2, 3, 4, 5, 6, 7);
}
DI bf16x8 tr_perm(LAS const unsigned char* img, unsigned row16, unsigned c, unsigned lane) {
    const unsigned h = lane >> 5, blk = (lane >> 4) & 1, q = (lane & 15) >> 2, p = lane & 3;
    const s16x4 lo = trread(img + off_b(row16 + 4 * h + q, 4 * c + 2 * blk + (p >> 1)) + 8 * (p & 1));
    const s16x4 hi = trread(img + off_b(row16 + 8 + 4 * h + q, 4 * c + 2 * blk + (p >> 1)) + 8 * (p & 1));
    return __builtin_shufflevector(lo, hi, 0, 1, 2, 3, 4, 5, 6, 7);
}
DI void tr_perm_offs(unsigned c, unsigned lane, unsigned& lo, unsigned& hi) {
    const unsigned h = lane >> 5, blk = (lane >> 4) & 1, q = (lane & 15) >> 2, p = lane & 3;
    lo = off_b(4 * h + q, 4 * c + 2 * blk + (p >> 1)) + 8 * (p & 1);
    hi = off_b(8 + 4 * h + q, 4 * c + 2 * blk + (p >> 1)) + 8 * (p & 1);
}
DI bf16x8 tr_at(LAS const unsigned char* img, unsigned lo, unsigned hi, unsigned byteoff) {
    const s16x4 a = trread(img + lo + byteoff), b = trread(img + hi + byteoff);
    return __builtin_shufflevector(a, b, 0, 1, 2, 3, 4, 5, 6, 7);
}
DI bf16x8 row_frag(LAS const unsigned char* img, unsigned row, unsigned ch) { return *(LAS const bf16x8*)(img + off_b(row, ch)); }
#define CROWC(i) (((i) & 3) + 8 * ((i) >> 2))

namespace pg8 {
constexpr int BM = 256, BK = 64, HALF = 128, HTB = HALF * BK * 2, STAGE_BYTES = 8 * HTB, NXCD = 8, WGM = 8;
DI int lds_byte(int r, int c) { const int st = (r >> 4) * 2 + (c >> 5), rr = r & 15, cc = c & 31, ob = rr * 64 + cc * 2; return st * 1024 + (ob ^ (((ob >> 9) & 1) << 5)); }
DI void stage_rc(int b, int& R, int& C) { const int st = b / 1024, sb = b % 1024, swz = sb ^ (((sb >> 9) & 1) << 5); R = (st >> 1) * 16 + swz / 64; C = (st & 1) * 32 + (swz % 64) / 2; }
DI int perm32(int rho) { const int n = rho >> 4, i = rho & 15; return 8 * (i >> 2) + 4 * n + (i & 3); }
struct Unit { int pm, pn; };
struct Gemm { const bf16_t* A; const bf16_t* Bt; int K; int a_rows; };
struct StaticOrder {
    int nM, nN, nwg, G, c;
    DI void init(int nM_, int nN_, int G_, int c_) { nM = nM_; nN = nN_; nwg = nM * nN; G = G_; c = c_; }
    DI bool next(int i, Unit& u) const {
        const long L = (long)i * G + c; if (L >= nwg) return false;
        int wgid = (int)L; { const int q = nwg / NXCD, r = nwg % NXCD, xcd = wgid % NXCD, off = wgid / NXCD; wgid = (xcd < r ? xcd * (q + 1) : r * (q + 1) + (xcd - r) * q) + off; }
        const int nig = WGM * nN, gid = wgid / nig, fm = gid * WGM, gsz = (nM - fm) < WGM ? (nM - fm) : WGM;
        u.pm = fm + ((wgid % nig) % gsz); u.pn = (wgid % nig) / gsz; return true;
    }
};

template <class Epi>
DI void gemm_phase(LAS unsigned char* lds, const Gemm g, const StaticOrder& S, const Epi& E) {
    const int tid = threadIdx.x, wid = __builtin_amdgcn_readfirstlane(tid >> 6), lane = tid & 63, wr = wid >> 2, wc = wid & 3, fr = lane & 15, fq = lane >> 4;
    const int K = g.K, nt = K / BK;
    unsigned voffA[2], voffB[2];
#pragma unroll
    for (int i = 0; i < 2; ++i) { int R, C; stage_rc(tid * 16 + i * 8192, R, C);
        const int Rb = Epi::BINTER ? (64 * (R >> 5) + perm32(R & 31)) : Epi::PERM ? ((R & ~31) + perm32(R & 31)) : R;
        voffA[i] = (unsigned)(R * K + C) * 2u; voffB[i] = (unsigned)(Rb * K + C) * 2u; }
    const size_t kstep = (size_t)(BK * 2);
    const size_t hstep = (size_t)HALF * K * 2;
    const size_t hstepB = Epi::BINTER ? (size_t)32 * K * 2 : hstep;
    const size_t tstepB = 2 * hstep;
    const size_t tstepA = (size_t)g.a_rows * K * 2;
    const unsigned ldsw = (unsigned)wid * 1024u;
    const int aoff = lds_byte(wr * 64 + fr, fq * 8), boff = lds_byte(wc * 32 + fr, fq * 8);
#define PG8_SA(b, h) (((b) * 2 + (h)) * HTB)
#define PG8_SB(b, h) ((4 + (b) * 2 + (h)) * HTB)
#define PG8_STAGE(bufoff, gbase, voff) do { _Pragma("unroll") for (int _i = 0; _i < 2; ++_i) \
        __builtin_amdgcn_global_load_lds((const unsigned*)((const char*)(gbase) + (voff)[_i]), (LAS unsigned*)(lds + (bufoff) + ldsw + _i * 8192), 16, 0, 0); } while (0)
#define PG8_LDA(dst, b, h) do { _Pragma("unroll") for (int m = 0; m < 4; ++m) _Pragma("unroll") for (int k = 0; k < 2; ++k) dst[m][k] = *(const LAS bf16x8*)(lds + PG8_SA(b, h) + aoff + m * 2048 + k * 1024); } while (0)
#define PG8_LDB(dst, b, h) do { _Pragma("unroll") for (int n = 0; n < 2; ++n) _Pragma("unroll") for (int k = 0; k < 2; ++k) dst[n][k] = *(const LAS bf16x8*)(lds + PG8_SB(b, h) + boff + n * 2048 + k * 1024); } while (0)
#define PG8_MMA(ai, bj, At, Bt) do { __builtin_amdgcn_s_setprio(1); _Pragma("unroll") for (int m = 0; m < 4; ++m) _Pragma("unroll") for (int n = 0; n < 2; ++n) _Pragma("unroll") for (int k = 0; k < 2; ++k) \
        acc[ai][bj][m][n] = __builtin_amdgcn_mfma_f32_16x16x32_bf16(Bt[n][k], At[m][k], acc[ai][bj][m][n], 0, 0, 0); __builtin_amdgcn_s_setprio(0); } while (0)
#define PG8_WAIT_V(n) asm volatile("s_waitcnt vmcnt(" #n ")" ::: "memory")
#define PG8_WAIT_L(n) asm volatile("s_waitcnt lgkmcnt(" #n ")" ::: "memory")
#define PG8_BAR __builtin_amdgcn_s_barrier()
#define PG8_SCHED __builtin_amdgcn_sched_barrier(0)
    Unit cur, nxt; int ui = 0;
    if (!S.next(0, cur)) return;
    f32x4 acc[2][2][4][2];
#pragma unroll
    for (int a = 0; a < 2; ++a)
#pragma unroll
        for (int b = 0; b < 2; ++b)
#pragma unroll
            for (int m = 0; m < 4; ++m)
#pragma unroll
                for (int n = 0; n < 2; ++n) acc[a][b][m][n] = (f32x4){0.f, 0.f, 0.f, 0.f};
    bf16x8 At[4][2], B0[2][2], B1[2][2];
    const char* cA = (const char*)g.A + (size_t)cur.pm * tstepA; const char* cB = (const char*)g.Bt + (size_t)cur.pn * tstepB;
    PG8_STAGE(PG8_SB(0, 0), cB, voffB); PG8_STAGE(PG8_SB(0, 1), cB + hstepB, voffB); PG8_STAGE(PG8_SA(0, 0), cA, voffA); PG8_STAGE(PG8_SA(0, 1), cA + hstep, voffA);
    if (wr == 1) PG8_BAR;
    PG8_WAIT_V(2); PG8_BAR;
    PG8_STAGE(PG8_SB(1, 0), cB + kstep, voffB); PG8_STAGE(PG8_SA(1, 0), cA + kstep, voffA); PG8_STAGE(PG8_SB(1, 1), cB + hstepB + kstep, voffB);
    PG8_WAIT_V(6); PG8_BAR;
    for (;;) {
        const bool has_next = S.next(ui + 1, nxt);
        const char* nA = has_next ? (const char*)g.A + (size_t)nxt.pm * tstepA : cA; const char* nB = has_next ? (const char*)g.Bt + (size_t)nxt.pn * tstepB : cB;
        for (int t = 0; t < nt; t += 2) {
            const bool last = (t == nt - 2);
            const char* a1 = cA + (size_t)(t + 1) * kstep;
            const char* a2 = last ? nA : cA + (size_t)(t + 2) * kstep; const char* b2 = last ? nB : cB + (size_t)(t + 2) * kstep;
            const char* a3 = a2 + kstep; const char* b3 = b2 + kstep;
            PG8_LDB(B0, 0, 0); PG8_LDB(B1, 0, 1); PG8_SCHED; PG8_LDA(At, 0, 0); PG8_STAGE(PG8_SA(1, 1), a1 + hstep, voffA);
            PG8_WAIT_V(8); PG8_WAIT_L(0); PG8_BAR; PG8_MMA(0, 0, At, B0); PG8_MMA(0, 1, At, B1); PG8_BAR; PG8_SCHED;
            PG8_LDA(At, 0, 1); PG8_STAGE(PG8_SB(0, 0), b2, voffB); PG8_STAGE(PG8_SB(0, 1), b2 + hstepB, voffB); PG8_STAGE(PG8_SA(0, 0), a2, voffA);
            PG8_WAIT_V(8); PG8_WAIT_L(0); PG8_BAR; PG8_MMA(1, 0, At, B0); PG8_MMA(1, 1, At, B1); PG8_BAR; PG8_SCHED;
            PG8_LDB(B0, 1, 0); PG8_LDB(B1, 1, 1); PG8_SCHED; PG8_LDA(At, 1, 0); PG8_STAGE(PG8_SA(0, 1), a2 + hstep, voffA);
            PG8_WAIT_V(8); PG8_WAIT_L(0); PG8_BAR; PG8_MMA(0, 0, At, B0); PG8_MMA(0, 1, At, B1); PG8_BAR; PG8_SCHED;
            PG8_LDA(At, 1, 1); PG8_STAGE(PG8_SB(1, 0), b3, voffB); PG8_STAGE(PG8_SB(1, 1), b3 + hstepB, voffB); PG8_STAGE(PG8_SA(1, 0), a3, voffA);
            PG8_WAIT_V(8); PG8_WAIT_L(0); PG8_BAR; PG8_MMA(1, 0, At, B0); PG8_MMA(1, 1, At, B1); PG8_BAR; PG8_SCHED;
        }
        if (wr == 0) PG8_BAR;
        E(acc, cur, wr, wc, fr, fq, lds);
        if (!has_next) break;
#pragma unroll
        for (int a = 0; a < 2; ++a)
#pragma unroll
            for (int b = 0; b < 2; ++b)
#pragma unroll
                for (int m = 0; m < 4; ++m)
#pragma unroll
                    for (int n = 0; n < 2; ++n) acc[a][b][m][n] = (f32x4){0.f, 0.f, 0.f, 0.f};
        cur = nxt; cA = nA; cB = nB; ++ui;
        if (wr == 1) PG8_BAR;
    }
    PG8_WAIT_V(0);
    PG8_BAR;
#undef PG8_SA
#undef PG8_SB
#undef PG8_STAGE
#undef PG8_LDA
#undef PG8_LDB
#undef PG8_MMA
#undef PG8_WAIT_V
#undef PG8_WAIT_L
#undef PG8_BAR
#undef PG8_SCHED
}
}

typedef f32x4 AccT[2][2][4][2];

template <int MODE> struct EpiProj {
    static constexpr bool PERM = true, BINTER = true;
    bf16_t* O; int ldc; const float* rsq; unsigned* kinf;
    DI void operator()(const AccT& acc, const pg8::Unit& u, int wr, int wc, int fr, int fq, LAS unsigned char*) const {
        const int row0 = u.pm * 256 + wr * 64 + fr;
        float rs[2][4];
#pragma unroll
        for (int ai = 0; ai < 2; ++ai)
#pragma unroll
            for (int m = 0; m < 4; ++m) rs[ai][m] = rsq ? __builtin_amdgcn_rsqf(rsq[row0 + ai * 128 + m * 16] * (1.0f / DM) + EPS) : 1.0f;
        const int seg = 2 * u.pn + (wc >> 1), type = seg >> 2, hd = seg & 3;
        const float lg = __builtin_log2f(1.0f - __builtin_exp2f(-5.0f - (float)hd));
        float amax = 0.f;
#pragma unroll
        for (int ai = 0; ai < 2; ++ai)
#pragma unroll
            for (int m = 0; m < 4; ++m) {
                const int row = row0 + ai * 128 + m * 16;
                float f = rs[ai][m];
                if (MODE == 0) {
                    const int p = row % PP, pc = p & 127; const bool valid = p >= NVALID0;
                    if (type == 0) f = __builtin_amdgcn_exp2f(lg * (float)pc);
                    else if (type == 1) f = valid ? 0.08838834764831845f * __builtin_amdgcn_exp2f(-lg * (float)pc) : 0.f;
                    else if (type == 2) f = valid ? 1.f : 0.f;
                    else if (type == 4) f = 0.125f * LOG2E;
                }
#pragma unroll
                for (int bj = 0; bj < 2; ++bj) {
                    const int col0 = u.pn * 256 + wc * 64 + bj * 32 + 8 * fq;
                    const f32x4 v0 = acc[ai][bj][m][0] * f, v1 = acc[ai][bj][m][1] * f;
                    u32x4 w; w.x = cvtpk(v0[0], v0[1]); w.y = cvtpk(v0[2], v0[3]); w.z = cvtpk(v1[0], v1[1]); w.w = cvtpk(v1[2], v1[3]);
                    *(u32x4*)(O + (size_t)row * ldc + col0) = w;
                    if (MODE == 0 && type == 5) amax = fmaxf(amax, fmaxf(fmaxf(fmaxf(fabsf(v0[0]), fabsf(v0[1])), fmaxf(fabsf(v0[2]), fabsf(v0[3]))), fmaxf(fmaxf(fabsf(v1[0]), fabsf(v1[1])), fmaxf(fabsf(v1[2]), fabsf(v1[3])))));
                }
            }
        if (MODE == 0 && type == 5) {
#pragma unroll
            for (int o = 1; o < 64; o <<= 1) amax = fmaxf(amax, __shfl_xor(amax, o));
            if ((threadIdx.x & 63) == 0) atomicMax(kinf + hd * 2 + (wc & 1), __float_as_uint(amax));
        }
    }
};

template <int MODE> struct EpiResidual {
    static constexpr bool PERM = true, BINTER = true;
    bf16_t* HB; float* H32; float* rowsq; const float* x0; const float* meta0;
    DI void operator()(const AccT& acc, const pg8::Unit& u, int wr, int wc, int fr, int fq, LAS unsigned char*) const {
        const int row0 = u.pm * 256 + wr * 64 + fr, col0 = u.pn * 256 + wc * 64 + 8 * fq;
#pragma unroll
        for (int ai = 0; ai < 2; ++ai)
#pragma unroll
            for (int m = 0; m < 4; ++m) {
                const int row = row0 + ai * 128 + m * 16;
                bf16_t* hp = HB + (size_t)row * DM + col0;
                const float* sp = nullptr;
                if (MODE == 0) { const int b = row / PP, p = row % PP; sp = (p < NVALID0) ? nullptr : (p < BLK) ? meta0 + (size_t)(p - NVALID0) * DM + col0 : x0 + ((size_t)b * SEQ + (p - BLK)) * DM + col0; }
                f32x4 v[2][2];
#pragma unroll
                for (int bj = 0; bj < 2; ++bj) {
                    if (MODE == 0) { v[bj][0] = sp ? *(const f32x4*)(sp + bj * 32) : (f32x4){0.f, 0.f, 0.f, 0.f}; v[bj][1] = sp ? *(const f32x4*)(sp + bj * 32 + 4) : (f32x4){0.f, 0.f, 0.f, 0.f}; }
                    else { const u32x4 q = *(const u32x4*)(hp + bj * 32);
                        v[bj][0] = (f32x4){__uint_as_float(q.x << 16), __uint_as_float(q.x & 0xffff0000u), __uint_as_float(q.y << 16), __uint_as_float(q.y & 0xffff0000u)};
                        v[bj][1] = (f32x4){__uint_as_float(q.z << 16), __uint_as_float(q.z & 0xffff0000u), __uint_as_float(q.w << 16), __uint_as_float(q.w & 0xffff0000u)}; }
                }
                float ss = 0.f;
#pragma unroll
                for (int bj = 0; bj < 2; ++bj) {
                    const f32x4 h0 = v[bj][0] + acc[ai][bj][m][0], h1 = v[bj][1] + acc[ai][bj][m][1];
                    ss += (h0[0] * h0[0] + h0[1] * h0[1]) + (h0[2] * h0[2] + h0[3] * h0[3]) + (h1[0] * h1[0] + h1[1] * h1[1]) + (h1[2] * h1[2] + h1[3] * h1[3]);
                    if (MODE == 2) { *(f32x4*)(H32 + (size_t)row * DM + col0 + bj * 32) = h0; *(f32x4*)(H32 + (size_t)row * DM + col0 + bj * 32 + 4) = h1; }
                    else { u32x4 w; w.x = cvtpk(h0[0], h0[1]); w.y = cvtpk(h0[2], h0[3]); w.z = cvtpk(h1[0], h1[1]); w.w = cvtpk(h1[2], h1[3]); *(u32x4*)(hp + bj * 32) = w; }
                }
                ss += __shfl_xor(ss, 16); ss += __shfl_xor(ss, 32);
                if (fq == 0) atomicAdd(rowsq + row, ss);
            }
    }
};

#define DPP_SHR1(old, src) __builtin_bit_cast(float, __builtin_amdgcn_update_dpp(__builtin_bit_cast(int, (old)), __builtin_bit_cast(int, (src)), 0x111, 0xF, 0xF, false))
#define DPP_SHR2(old, src) __builtin_bit_cast(float, __builtin_amdgcn_update_dpp(__builtin_bit_cast(int, (old)), __builtin_bit_cast(int, (src)), 0x112, 0xF, 0xF, false))
#define DPP_ROR1(src) __builtin_bit_cast(float, __builtin_amdgcn_update_dpp(0, __builtin_bit_cast(int, (src)), 0x121, 0xF, 0xF, false))
#define DPP_ROR2(src) __builtin_bit_cast(float, __builtin_amdgcn_update_dpp(0, __builtin_bit_cast(int, (src)), 0x122, 0xF, 0xF, false))
struct EpiFfnUp {
    static constexpr bool PERM = true, BINTER = false;
    bf16_t* ACT; const float* wconv; const float* bconv; const float* rsq;
    DI void operator()(const AccT& acc, const pg8::Unit& u, int wr, int wc, int fr, int fq, LAS unsigned char* lds) const {
        LAS float* halo = (LAS float*)(lds + 131072);
        const int vbase = 254 * u.pm - 2;
        const int cl = wc * 32 + 8 * fq;
        const int cg0 = u.pn * 128 + cl;
        float rv[2][4], rg[2][4];
#pragma unroll
        for (int ai = 0; ai < 2; ++ai)
#pragma unroll
            for (int m = 0; m < 4; ++m) { const int v = vbase + ai * 128 + wr * 64 + m * 16 + fr; const bool inr = v >= 0 && v < MROWS;
                const float r = inr ? __builtin_amdgcn_rsqf(rsq[inr ? v : 0] * (1.0f / DM) + EPS) : 0.f;
                rv[ai][m] = r; rg[ai][m] = (inr && (v % PP) >= NVALID0) ? r : 0.f; }
        f32x4 w0[2], w1[2], w2[2], bb[2];
#pragma unroll
        for (int n = 0; n < 2; ++n) { w0[n] = *(const f32x4*)(wconv + cg0 + 4 * n); w1[n] = *(const f32x4*)(wconv + DFF + cg0 + 4 * n); w2[n] = *(const f32x4*)(wconv + 2 * DFF + cg0 + 4 * n); bb[n] = *(const f32x4*)(bconv + cg0 + 4 * n); }
        if (fr >= 14) {
#pragma unroll
            for (int ai = 0; ai < 2; ++ai)
#pragma unroll
                for (int n = 0; n < 2; ++n) *(LAS f32x4*)(halo + ((2 * ai + wr) * 2 + (fr - 14)) * 128 + cl + 4 * n) = acc[ai][0][3][n] * rg[ai][3];
        }
        asm volatile("s_waitcnt lgkmcnt(0)" ::: "memory"); __builtin_amdgcn_s_barrier(); asm volatile("" ::: "memory");
#pragma unroll
        for (int ai = 0; ai < 2; ++ai) {
            const int grp = 2 * ai + wr;
            f32x4 pa[2], pb[2];
#pragma unroll
            for (int n = 0; n < 2; ++n) {
                if (grp > 0) {
                    const f32x4 h0 = *(LAS const f32x4*)(halo + ((grp - 1) * 2 + 0) * 128 + cl + 4 * n);
                    const f32x4 h1 = *(LAS const f32x4*)(halo + ((grp - 1) * 2 + 1) * 128 + cl + 4 * n);
                    pa[n] = h1; pb[n] = (fr == 0) ? h0 : h1;
                } else { pa[n] = (f32x4){0.f, 0.f, 0.f, 0.f}; pb[n] = pa[n]; }
            }
#pragma unroll
            for (int m = 0; m < 4; ++m) {
                const int lr = ai * 128 + wr * 64 + m * 16 + fr; const int v = vbase + lr;
                u32x4 w;
#pragma unroll
                for (int n = 0; n < 2; ++n) {
                    const f32x4 gv = acc[ai][0][m][n] * rg[ai][m];
                    f32x4 g1, g2;
#pragma unroll
                    for (int j = 0; j < 4; ++j) { float t = gv[j]; asm volatile("" : "+v"(t));
                        const float r1 = DPP_ROR1(t), r2 = DPP_ROR2(t); g1[j] = (fr >= 1) ? r1 : pa[n][j]; g2[j] = (fr >= 2) ? r2 : pb[n][j]; pa[n][j] = r1; pb[n][j] = r2; }
                    const f32x4 cv = bb[n] + w0[n] * g2 + w1[n] * g1 + w2[n] * gv;
                    const f32x4 vv = acc[ai][1][m][n] * rv[ai][m];
                    f32x4 o;
#pragma unroll
                    for (int j = 0; j < 4; ++j) o[j] = cv[j] * __builtin_amdgcn_rcpf(1.0f + __builtin_amdgcn_exp2f(-LOG2E * cv[j])) * vv[j];
                    if (n == 0) { w.x = cvtpk(o[0], o[1]); w.y = cvtpk(o[2], o[3]); } else { w.z = cvtpk(o[0], o[1]); w.w = cvtpk(o[2], o[3]); }
                }
                if (lr >= 2 && v < MROWS) *(u32x4*)(ACT + (size_t)v * DFF + cg0) = w;
            }
        }
    }
};

template <int NCH> DI void tile_load(const bf16_t* src, int ld, u32x4 (&v)[NCH], int tid) {
#pragma unroll
    for (int i = 0; i < NCH; ++i) { const int c = tid + NTHREADS * i, row = c >> 4, ch = c & 15; v[i] = *(const u32x4*)(src + (size_t)row * ld + ch * 8); }
}
template <int NCH> DI void tile_store(LAS unsigned char* img, const u32x4 (&v)[NCH], int tid) {
#pragma unroll
    for (int i = 0; i < NCH; ++i) { const int c = tid + NTHREADS * i, row = c >> 4, ch = c & 15; *(LAS u32x4*)(img + off_b(row, ch)) = v[i]; }
}

DI void tile_dma64(const bf16_t* src, int ld, LAS unsigned char* img, int wave, int lane) {
#pragma unroll
    for (int i = 0; i < 2; ++i) {
        const unsigned L = (unsigned)((wave * 2 + i) * 64 + lane), row = L >> 4, cpos = L & 15;
        const unsigned ch = cpos ^ (((row & 3u) << 2) | ((row >> 2) & 3u));
        __builtin_amdgcn_global_load_lds((const unsigned*)(src + (size_t)row * ld + ch * 8), (LAS unsigned*)(img + (wave * 2 + i) * 1024), 16, 0, 0);
    }
}
DI void glds16(const void* gsrc, unsigned lds_dst) { unsigned keep;
    asm volatile("s_mov_b32 %0, m0\n\ts_mov_b32 m0, %2\n\ts_nop 0\n\tglobal_load_lds_dwordx4 %1, off\n\ts_mov_b32 m0, %0" : "=&s"(keep) : "v"(gsrc), "s"(lds_dst) : "memory"); }
DI void tile_dma64_asm(const bf16_t* src, int ld, LAS unsigned char* img, int wave, int lane) {
#pragma unroll
    for (int i = 0; i < 2; ++i) {
        const unsigned L = (unsigned)((wave * 2 + i) * 64 + lane), row = L >> 4, cpos = L & 15;
        const unsigned ch = cpos ^ (((row & 3u) << 2) | ((row >> 2) & 3u));
        glds16(src + (size_t)row * ld + ch * 8, (unsigned)__builtin_amdgcn_readfirstlane((int)((unsigned)(uintptr_t)img + (unsigned)(wave * 2 + i) * 1024u)));
    }
}

DI void retention_item(const Params& P, LAS unsigned char* lds, int b, int hd, int nfull0, int nend) {
    const int tid = threadIdx.x, lane = tid & 63, w = __builtin_amdgcn_readfirstlane(tid >> 6), r = lane & 31, h = lane >> 5, ib = w & 3, eh = w >> 2;
    LAS unsigned char* Qimg = lds; LAS unsigned char* Kimg = lds + 32768; LAS unsigned char* Vimg = lds + 65536; LAS unsigned char* Timg = lds + 98304;
    LAS f32x2* X = (LAS f32x2*)(lds + 131072);
    const bf16_t* proj = (const bf16_t*)(P.ws + WS_BIG) + (size_t)(b * PP) * AB_IN;
    bf16_t* MIX = (bf16_t*)P.out;
    const float lg = __builtin_log2f(1.0f - __builtin_exp2f(-5.0f - (float)hd));
    const float g128 = __builtin_exp2f(128.0f * lg);
    __syncthreads();
    for (int i = tid; i < 2048; i += NTHREADS) ((LAS u32x4*)Timg)[i] = (u32x4){0u, 0u, 0u, 0u};
    f32x16 st[2];
#pragma unroll
    for (int i = 0; i < 16; ++i) { st[0][i] = 0.f; st[1][i] = 0.f; }
    u32x4 pq[4], pk[4], pv[4];
    if (nfull0 == 0) tile_load<4>(proj + hd * 128, AB_IN, pq, tid);
    tile_load<4>(proj + 512 + hd * 128, AB_IN, pk, tid); tile_load<4>(proj + 1024 + hd * 128, AB_IN, pv, tid);
    const float* rn = P.ab_ret_norm + hd * 128;
    for (int n = 0; n < nend; ++n) {
        const bool full = n >= nfull0;
        __syncthreads();
        if (full) tile_store<4>(Qimg, pq, tid);
        tile_store<4>(Kimg, pk, tid); tile_store<4>(Vimg, pv, tid);
        __syncthreads();
        if (n + 1 < nend) { const bf16_t* s = proj + (size_t)(n + 1) * 128 * AB_IN;
            if (n + 1 >= nfull0) tile_load<4>(s + hd * 128, AB_IN, pq, tid);
            tile_load<4>(s + 512 + hd * 128, AB_IN, pk, tid); tile_load<4>(s + 1024 + hd * 128, AB_IN, pv, tid); }
        f32x16 o[2];
#pragma unroll
        for (int i = 0; i < 16; ++i) { o[0][i] = 0.f; o[1][i] = 0.f; }
        if (full) {
#pragma unroll 2
        for (int s = 0; s < 8; ++s) { const bf16x8 qv = row_frag(Qimg, 32 * ib + r, 2 * s + h);
#pragma unroll
            for (int ec = 0; ec < 2; ++ec) { const bf16x8 a = tr_nat(Timg, 16 * s, 2 * eh + ec, lane); o[ec] = MFMA32(a, qv, o[ec]); } }
        for (int jb = 0; jb <= ib; ++jb) {
            f32x16 S;
#pragma unroll
            for (int i = 0; i < 16; ++i) S[i] = 0.f;
#pragma unroll 1
            for (int s = 0; s < 8; ++s) { const bf16x8 a = row_frag(Kimg, 32 * jb + r, 2 * s + h); const bf16x8 qv = row_frag(Qimg, 32 * ib + r, 2 * s + h); S = MFMA32(a, qv, S); }
            if (jb == ib) {
#pragma unroll
                for (int i = 0; i < 16; ++i) if (CROWC(i) + 4 * h > r) S[i] = 0.f;
            }
            const bf16x8 p0 = pack8(S[0], S[1], S[2], S[3], S[4], S[5], S[6], S[7]), p1 = pack8(S[8], S[9], S[10], S[11], S[12], S[13], S[14], S[15]);
#pragma unroll
            for (int ec = 0; ec < 2; ++ec) {
                const bf16x8 a0 = tr_perm(Vimg, 32 * jb, 2 * eh + ec, lane); o[ec] = MFMA32(a0, p0, o[ec]);
                const bf16x8 a1 = tr_perm(Vimg, 32 * jb + 16, 2 * eh + ec, lane); o[ec] = MFMA32(a1, p1, o[ec]);
            }
        }
        }
#pragma unroll 1
        for (int s = 0; s < 8; ++s) {
            const bf16x8 bk = tr_nat(Kimg, 16 * s, ib, lane);
#pragma unroll
            for (int ec = 0; ec < 2; ++ec) { const bf16x8 av = tr_nat(Vimg, 16 * s, 2 * eh + ec, lane); st[ec] = MFMA32(av, bk, st[ec]); }
        }
#pragma unroll
        for (int i = 0; i < 16; ++i) { st[0][i] *= g128; st[1][i] *= g128; }
        float s1 = 0.f, s2 = 0.f;
#pragma unroll
        for (int ec = 0; ec < 2; ++ec)
#pragma unroll
            for (int i = 0; i < 16; ++i) { s1 += o[ec][i]; s2 += o[ec][i] * o[ec][i]; }
        s1 += __shfl_xor(s1, 32); s2 += __shfl_xor(s2, 32);
        if (h == 0) X[(eh * 4 + ib) * 32 + r] = (f32x2){s1, s2};
        __syncthreads();
#pragma unroll
        for (int ec = 0; ec < 2; ++ec)
#pragma unroll
            for (int g = 0; g < 4; ++g) { u32x2 wv; wv.x = cvtpk(st[ec][4 * g], st[ec][4 * g + 1]); wv.y = cvtpk(st[ec][4 * g + 2], st[ec][4 * g + 3]);
                *(LAS u32x2*)(Timg + off_b(32 * ib + r, 4 * (2 * eh + ec) + g) + 8 * h) = wv; }
        if (!full) continue;
        const f32x2 xo = X[((1 - eh) * 4 + ib) * 32 + r];
        const float mean = (s1 + xo.x) * (1.0f / 128.0f);
        const float var = (s2 + xo.y) * (1.0f / 128.0f) - mean * mean;
        const float rstd = __builtin_amdgcn_rsqf(fmaxf(var, 0.f) + EPS);
        const size_t m = (size_t)(b * PP) + n * 128 + 32 * ib + r;
        const bf16_t* rg = (const bf16_t*)(P.ws + WS_BIG) + m * AB_IN + 1536 + hd * 128;
        bf16_t* op = MIX + m * DM + hd * 128;
#pragma unroll
        for (int ec = 0; ec < 2; ++ec)
#pragma unroll
            for (int g = 0; g < 4; ++g) {
                const int e = 32 * (2 * eh + ec) + 8 * g + 4 * h;
                const u32x2 gr = *(const u32x2*)(rg + e);
                const f32x4 nw = *(const f32x4*)(rn + e);
                float gate[4] = {__uint_as_float(gr.x << 16), __uint_as_float(gr.x & 0xffff0000u), __uint_as_float(gr.y << 16), __uint_as_float(gr.y & 0xffff0000u)};
                float y[4];
#pragma unroll
                for (int j = 0; j < 4; ++j) { const float sg = gate[j] * __builtin_amdgcn_rcpf(1.0f + __builtin_amdgcn_exp2f(-LOG2E * gate[j])); y[j] = (o[ec][4 * g + j] - mean) * rstd * nw[j] * sg; }
                u32x2 wv; wv.x = cvtpk(y[0], y[1]); wv.y = cvtpk(y[2], y[3]);
                *(u32x2*)(op + e) = wv;
            }
    }
}

DI void diffattn_item(const Params& P, LAS unsigned char* lds, int b, int hd, int qb, float lam, const float* kinf) {
    const int tid = threadIdx.x, lane = tid & 63, w = __builtin_amdgcn_readfirstlane(tid >> 6), r = lane & 31, h = lane >> 5, wq = w & 3, mp = w >> 2;
    LAS float* XO = (LAS float*)lds;
    LAS unsigned* flags = (LAS unsigned*)(lds + 131072);
    const bf16_t* proj = (const bf16_t*)(P.ws + WS_BIG) + (size_t)(b * PP) * AB_IN;
    bf16_t* MIX = (bf16_t*)P.out;
    const int qpos = 128 * qb + 32 * wq + r;
    const float slope = __builtin_exp2f(-2.0f * (float)(hd + 1));
    const float c2 = slope * LOG2E;
    bf16x8 qf[4];
    float q1 = 0.f;
    { const bf16_t* qp = proj + (size_t)qpos * AB_IN + 2048 + hd * 128 + mp * 64 + 8 * h;
#pragma unroll
      for (int s = 0; s < 4; ++s) { qf[s] = *(const bf16x8*)(qp + 16 * s);
#pragma unroll
          for (int j = 0; j < 8; ++j) q1 += fabsf(bf2f((unsigned short)qf[s][j])); } }
    q1 += __shfl_xor(q1, 32);
    const float sbound = q1 * kinf[hd * 2 + mp] * 1.01f + 1.0f;
    f32x16 O[4];
#pragma unroll
    for (int c = 0; c < 4; ++c)
#pragma unroll
        for (int i = 0; i < 16; ++i) O[c][i] = 0.f;
    float mrun = -1e30f, lrun = 0.f;
    const int ktop = 2 * qb + 1;
    unsigned vlo0, vhi0; tr_perm_offs(0, lane, vlo0, vhi0);
    const unsigned kof0 = off_b(r, 8 * mp + h);
#define DF_DMA(kt_, slot_) do { LAS unsigned char* nb_ = lds + (slot_) * 32768; \
        tile_dma64_asm(proj + (size_t)(64 * (kt_)) * AB_IN + 2560 + hd * 128, AB_IN, nb_, w, lane); \
        tile_dma64_asm(proj + (size_t)(64 * (kt_)) * AB_IN + 3072 + hd * 128, AB_IN, nb_ + 16384, w, lane); } while (0)
#define DF_QK(Sa, Sb, slot_) do { LAS unsigned char* kb_ = lds + (slot_) * 32768; \
        _Pragma("unroll") for (int i = 0; i < 16; ++i) { Sa[i] = 0.f; Sb[i] = 0.f; } \
        bf16x8 ka_[8]; \
        _Pragma("unroll") for (int s = 0; s < 4; ++s) { ka_[2 * s] = *(LAS const bf16x8*)(kb_ + (kof0 ^ (32u * s))); ka_[2 * s + 1] = *(LAS const bf16x8*)(kb_ + (kof0 ^ (32u * s)) + 8192); } \
        __builtin_amdgcn_sched_barrier(0); \
        _Pragma("unroll") for (int s = 0; s < 4; ++s) { Sa = MFMA32(ka_[2 * s], qf[s], Sa); Sb = MFMA32(ka_[2 * s + 1], qf[s], Sb); } } while (0)
    __syncthreads();
    DF_DMA(ktop, 0); DF_DMA(ktop - 1, 1);
    if (tid < 16) flags[tid] = 0u;
    asm volatile("s_waitcnt vmcnt(0)" ::: "memory");
    __syncthreads();
    f32x16 S0, S1;
    DF_QK(S0, S1, 0);
    int slot = 0;
    bf16x8 pp0 = {0, 0, 0, 0, 0, 0, 0, 0}, pp1 = pp0, pp2 = pp0, pp3 = pp0;
    LAS unsigned char* vprev = lds + 16384;
#define DF_LDV(c_, dst_, Vimg_) do { const unsigned vl_ = vlo0 ^ (64u * (c_)), vh_ = vhi0 ^ (64u * (c_)); \
        dst_[0] = tr_at(Vimg_, vl_, vh_, 0); dst_[1] = tr_at(Vimg_, vl_, vh_, 4096); dst_[2] = tr_at(Vimg_, vl_, vh_, 8192); dst_[3] = tr_at(Vimg_, vl_, vh_, 12288); } while (0)
#define DF_EXP4(S_, b_) do { _Pragma("unroll") for (int i_ = 0; i_ < 4; ++i_) { float e_ = __builtin_amdgcn_exp2f(S_[(b_) + i_] + dl); asm volatile("" : "+v"(e_));   S_[(b_) + i_] = e_; ps += e_; } } while (0)
    for (int kt = ktop; kt >= 0; --kt) {
        asm volatile("s_waitcnt vmcnt(0) lgkmcnt(0)\n\ts_barrier" ::: "memory");
        { LAS const unsigned* fr_ = flags + ((kt + 1) & 1) * 8;
          const u32x4 f0 = *(LAS const u32x4*)fr_, f1 = *(LAS const u32x4*)(fr_ + 4);
          if ((f0.x & f0.y & f0.z & f0.w & f1.x & f1.y & f1.z & f1.w) != 0u) break; }
        const int slot1 = (slot + 1) & 3;
        if (kt >= 2) DF_DMA(kt - 2, (slot + 2) & 3);
        LAS unsigned char* Vimg = lds + slot * 32768 + 16384;
        const bool boundary = (kt >= 2 * qb) || (kt < 2);
        const int k0 = 64 * kt + 4 * h;
        const float u0 = c2 * (float)(k0 - qpos);
        float amax = -3.0e38f;
        if (boundary) {
#pragma unroll
            for (int i = 0; i < 16; ++i) {
                float t0 = fmaf(c2, (float)CROWC(i), S0[i]), t1 = fmaf(c2, (float)(32 + CROWC(i)), S1[i]);
                const int kp = k0 + CROWC(i); if (kp > qpos || kp < NVALID0) t0 = -1e30f; if (kp + 32 > qpos || kp + 32 < NVALID0) t1 = -1e30f;
                S0[i] = t0; S1[i] = t1; amax = fmaxf(amax, fmaxf(t0, t1));
            }
        } else {
#pragma unroll
            for (int i = 0; i < 16; ++i) {
                const float t0 = fmaf(c2, (float)CROWC(i), S0[i]), t1 = fmaf(c2, (float)(32 + CROWC(i)), S1[i]);
                S0[i] = t0; S1[i] = t1; amax = fmaxf(amax, fmaxf(t0, t1));
            }
        }
        amax = fmaxf(amax + u0, -1e30f);
        const float bmax = fmaxf(amax, __shfl_xor(amax, 32));
        const float mold = mrun;
        mrun = fmaxf(mrun, bmax);
        const float dl = u0 - mrun;
        float ps = 0.f;
        {
            bf16x8 va[2][4];
            DF_LDV(0, va[0], vprev);
            DF_LDV(1, va[1], vprev);
            __builtin_amdgcn_sched_barrier(0);
            O[0] = MFMA32(va[0][0], pp0, O[0]); O[0] = MFMA32(va[0][1], pp1, O[0]); O[0] = MFMA32(va[0][2], pp2, O[0]); O[0] = MFMA32(va[0][3], pp3, O[0]);
            DF_EXP4(S0, 0); DF_EXP4(S1, 0);
            __builtin_amdgcn_sched_barrier(0);
            DF_LDV(2, va[0], vprev);
            O[1] = MFMA32(va[1][0], pp0, O[1]); O[1] = MFMA32(va[1][1], pp1, O[1]); O[1] = MFMA32(va[1][2], pp2, O[1]); O[1] = MFMA32(va[1][3], pp3, O[1]);
            DF_EXP4(S0, 4); DF_EXP4(S1, 4);
            __builtin_amdgcn_sched_barrier(0);
            DF_LDV(3, va[1], vprev);
            O[2] = MFMA32(va[0][0], pp0, O[2]); O[2] = MFMA32(va[0][1], pp1, O[2]); O[2] = MFMA32(va[0][2], pp2, O[2]); O[2] = MFMA32(va[0][3], pp3, O[2]);
            DF_EXP4(S0, 8); DF_EXP4(S1, 8);
            __builtin_amdgcn_sched_barrier(0);
            O[3] = MFMA32(va[1][0], pp0, O[3]); O[3] = MFMA32(va[1][1], pp1, O[3]); O[3] = MFMA32(va[1][2], pp2, O[3]); O[3] = MFMA32(va[1][3], pp3, O[3]);
            DF_EXP4(S0, 12); DF_EXP4(S1, 12);
            __builtin_amdgcn_sched_barrier(0);
        }
        if (__any(mrun > mold)) {
            const float al = __builtin_amdgcn_exp2f(mold - mrun);
            lrun *= al;
#pragma unroll
            for (int c = 0; c < 4; ++c)
#pragma unroll
                for (int i = 0; i < 16; ++i) O[c][i] *= al;
        }
        lrun += ps;
        pp0 = pack8(S0[0], S0[1], S0[2], S0[3], S0[4], S0[5], S0[6], S0[7]); pp1 = pack8(S0[8], S0[9], S0[10], S0[11], S0[12], S0[13], S0[14], S0[15]);
        pp2 = pack8(S1[0], S1[1], S1[2], S1[3], S1[4], S1[5], S1[6], S1[7]); pp3 = pack8(S1[8], S1[9], S1[10], S1[11], S1[12], S1[13], S1[14], S1[15]);
        vprev = Vimg;
        const bool okw = __all(sbound + c2 * (float)(64 * kt - 1 - qpos) - mrun < -150.0f);
        if (lane == 0) flags[(kt & 1) * 8 + w] = okw ? 1u : 0u;
        if (kt >= 1) DF_QK(S0, S1, slot1);
        slot = slot1;
    }
    {
        bf16x8 va[2][4];
        DF_LDV(0, va[0], vprev);
#pragma unroll
        for (int c = 0; c < 4; ++c) { if (c < 3) DF_LDV(c + 1, va[(c + 1) & 1], vprev); __builtin_amdgcn_sched_barrier(0);
            O[c] = MFMA32(va[c & 1][0], pp0, O[c]); O[c] = MFMA32(va[c & 1][1], pp1, O[c]); O[c] = MFMA32(va[c & 1][2], pp2, O[c]); O[c] = MFMA32(va[c & 1][3], pp3, O[c]);
            __builtin_amdgcn_sched_barrier(0); }
    }
#undef DF_EXP4
#undef DF_LDV
#undef DF_DMA
#undef DF_QK
    asm volatile("s_waitcnt vmcnt(0)" ::: "memory");
    __syncthreads();
    lrun += __shfl_xor(lrun, 32);
    const float inv = 1.0f / lrun;
    if (mp == 1) {
#pragma unroll
        for (int c = 0; c < 4; ++c)
#pragma unroll
            for (int i = 0; i < 16; ++i) XO[(wq * 64 + c * 16 + i) * 64 + lane] = O[c][i] * inv;
    }
    __syncthreads();
    if (mp == 0) {
        float ss = 0.f;
#pragma unroll
        for (int c = 0; c < 4; ++c)
#pragma unroll
            for (int i = 0; i < 16; ++i) { const float d = O[c][i] * inv - lam * XO[(wq * 64 + c * 16 + i) * 64 + lane]; O[c][i] = d; ss += d * d; }
        ss += __shfl_xor(ss, 32);
        const float rs = __builtin_amdgcn_rsqf(ss * (1.0f / 128.0f) + EPS) * 0.8f;
        const float* dn = P.ab_diff_norm + hd * 128;
        bf16_t* op = MIX + (size_t)(b * PP + qpos) * DM + 512 + hd * 128;
#pragma unroll
        for (int c = 0; c < 4; ++c)
#pragma unroll
            for (int g = 0; g < 4; ++g) {
                const int e = 32 * c + 8 * g + 4 * h;
                const f32x4 nw = *(const f32x4*)(dn + e);
                u32x2 wv; wv.x = cvtpk(O[c][4 * g] * rs * nw[0], O[c][4 * g + 1] * rs * nw[1]); wv.y = cvtpk(O[c][4 * g + 2] * rs * nw[2], O[c][4 * g + 3] * rs * nw[3]);
                *(u32x2*)(op + e) = wv;
            }
    }
}

DI void sb_block(f32x16& S, float& C, float c1, int k0, int qpos, int h, bool boundary) {
    float L[16]; float seg[4];
#pragma unroll
    for (int g = 0; g < 4; ++g) seg[g] = 0.f;
#pragma unroll
    for (int i = 0; i < 16; ++i) {
        const float z = S[i] * c1;
        const float e = __builtin_amdgcn_exp2f(-fabsf(z));
        const float sp = fmaxf(z, 0.f) + __builtin_amdgcn_logf(1.0f + e);
        bool ok = true;
        if (boundary) { const int kp = k0 + CROWC(i); ok = (kp < qpos) && (kp >= NVALID0); }
        L[i] = ok ? -sp : 0.f;
        S[i] = ok ? (z - sp) : -1e30f;
        seg[i >> 2] += L[i];
    }
    float oseg[4];
#pragma unroll
    for (int g = 0; g < 4; ++g) oseg[g] = __shfl_xor(seg[g], 32);
    float R = 0.f;
#pragma unroll
    for (int gi = 0; gi < 4; ++gi) {
        const int g = 3 - gi;
        float lat = C + R + (h == 0 ? oseg[g] : 0.f);
        S[4 * g + 3] = __builtin_amdgcn_exp2f(S[4 * g + 3] + lat); lat += L[4 * g + 3];
        S[4 * g + 2] = __builtin_amdgcn_exp2f(S[4 * g + 2] + lat); lat += L[4 * g + 2];
        S[4 * g + 1] = __builtin_amdgcn_exp2f(S[4 * g + 1] + lat); lat += L[4 * g + 1];
        S[4 * g + 0] = __builtin_amdgcn_exp2f(S[4 * g + 0] + lat);
        R += seg[g] + oseg[g];
    }
    C += R;
}
DI void stickbreak_item(const Params& P, LAS unsigned char* lds, int b, int hp, int qb) {
    const int tid = threadIdx.x, lane = tid & 63, w = __builtin_amdgcn_readfirstlane(tid >> 6), r = lane & 31, h = lane >> 5, wq = w & 3, hs = w >> 2;
    const int hd = 2 * hp + hs;
    LAS unsigned* flags = (LAS unsigned*)(lds + 131072);
    const bf16_t* proj = (const bf16_t*)(P.ws + WS_BIG) + (size_t)(b * PP) * C_IN;
    bf16_t* MIX = (bf16_t*)P.out;
    const int qpos = 128 * qb + 32 * wq + r;
    const float c1 = 0.08838834764831845f * LOG2E;
    bf16x8 qf[8];
    { const bf16_t* qp = proj + (size_t)qpos * C_IN + hd * 128 + 8 * h;
#pragma unroll
      for (int s = 0; s < 8; ++s) qf[s] = *(const bf16x8*)(qp + 16 * s); }
    f32x16 O[4];
#pragma unroll
    for (int c = 0; c < 4; ++c)
#pragma unroll
        for (int i = 0; i < 16; ++i) O[c][i] = 0.f;
    float C = 0.f;
    const int ktop = 2 * qb + 1;
    unsigned vlo0, vhi0; tr_perm_offs(0, lane, vlo0, vhi0);
    const unsigned kof0 = off_b(r, h);
    __syncthreads();
#define SB_DMA(kt_, base_) do { const bf16_t* s_ = proj + (size_t)(64 * (kt_)) * C_IN + hp * 256; \
        tile_dma64_asm(s_ + 1024, C_IN, (base_), w, lane); tile_dma64_asm(s_ + 1024 + 128, C_IN, (base_) + 16384, w, lane); \
        tile_dma64_asm(s_ + 2048, C_IN, (base_) + 32768, w, lane); tile_dma64_asm(s_ + 2048 + 128, C_IN, (base_) + 49152, w, lane); } while (0)
    SB_DMA(ktop, lds);
    if (tid < 16) flags[tid] = 0u;
    int cur = 0;
    for (int kt = ktop; kt >= 0; --kt) {
        asm volatile("s_waitcnt vmcnt(0)" ::: "memory");
        __syncthreads();
        { LAS const unsigned* fr_ = flags + ((kt + 1) & 1) * 8;
          const u32x4 f0 = *(LAS const u32x4*)fr_, f1 = *(LAS const u32x4*)(fr_ + 4);
          if ((f0.x & f0.y & f0.z & f0.w & f1.x & f1.y & f1.z & f1.w) != 0u) break; }
        LAS unsigned char* Kimg = lds + cur * 65536 + hs * 16384; LAS unsigned char* Vimg = Kimg + 32768;
        if (kt > 0) SB_DMA(kt - 1, lds + (cur ^ 1) * 65536);
        cur ^= 1;
        const bool boundary = (kt >= 2 * qb) || (kt < 2);
        const bool skip = (64 * kt >= 128 * qb + 32 * wq + 32);
        if (!skip) {
            f32x16 S0, S1;
#pragma unroll
            for (int i = 0; i < 16; ++i) { S0[i] = 0.f; S1[i] = 0.f; }
#pragma unroll
            for (int s = 0; s < 8; ++s) { const bf16x8 a0 = *(LAS const bf16x8*)(Kimg + (kof0 ^ (32u * s))), a1 = *(LAS const bf16x8*)(Kimg + (kof0 ^ (32u * s)) + 8192);
                S0 = MFMA32(a0, qf[s], S0); S1 = MFMA32(a1, qf[s], S1); }
            sb_block(S1, C, c1, 64 * kt + 32 + 4 * h, qpos, h, boundary);
            sb_block(S0, C, c1, 64 * kt + 4 * h, qpos, h, boundary);
            const bf16x8 p0 = pack8(S0[0], S0[1], S0[2], S0[3], S0[4], S0[5], S0[6], S0[7]), p1 = pack8(S0[8], S0[9], S0[10], S0[11], S0[12], S0[13], S0[14], S0[15]);
            const bf16x8 p2 = pack8(S1[0], S1[1], S1[2], S1[3], S1[4], S1[5], S1[6], S1[7]), p3 = pack8(S1[8], S1[9], S1[10], S1[11], S1[12], S1[13], S1[14], S1[15]);
#pragma unroll
            for (int c = 0; c < 4; ++c) {
                const unsigned vl = vlo0 ^ (64u * c), vh = vhi0 ^ (64u * c);
                const bf16x8 a0 = tr_at(Vimg, vl, vh, 0), a1 = tr_at(Vimg, vl, vh, 4096), a2 = tr_at(Vimg, vl, vh, 8192), a3 = tr_at(Vimg, vl, vh, 12288);
                O[c] = MFMA32(a0, p0, O[c]); O[c] = MFMA32(a1, p1, O[c]); O[c] = MFMA32(a2, p2, O[c]); O[c] = MFMA32(a3, p3, O[c]);
            }
        }
        const bool okw = __all(C < -160.0f);
        if (lane == 0) flags[(kt & 1) * 8 + w] = okw ? 1u : 0u;
    }
#undef SB_DMA
    bf16_t* op = MIX + (size_t)(b * PP + qpos) * DM + hd * 128;
#pragma unroll
    for (int c = 0; c < 4; ++c)
#pragma unroll
        for (int g = 0; g < 4; ++g) {
            const int e = 32 * c + 8 * g + 4 * h;
            u32x2 wv; wv.x = cvtpk(O[c][4 * g], O[c][4 * g + 1]); wv.y = cvtpk(O[c][4 * g + 2], O[c][4 * g + 3]);
            *(u32x2*)(op + e) = wv;
        }
}

DI unsigned f2bf(float f) { unsigned u = __builtin_bit_cast(unsigned, f); return (u + 0x7fffu + ((u >> 16) & 1u)) >> 16; }
DI unsigned pk2(float lo, float hi) { return f2bf(lo) | (f2bf(hi) << 16); }
DI void transpose_item(const float* W, int K, int N, bf16_t* WT, bool ffn_perm, LAS float* scr, int item, int lane, const float* kgain = nullptr) {
    const int nblk = N / 32, kb = item / nblk, nb = item % nblk, k0 = 64 * kb, n0 = 32 * nb;
#pragma unroll 8
    for (int i = 0; i < 32; ++i) { const int kk = 2 * i + (lane >> 5); const float gk = kgain ? kgain[k0 + kk] : 1.0f; scr[kk * 33 + (lane & 31)] = W[(size_t)(k0 + kk) * N + n0 + (lane & 31)] * gk; }
    asm volatile("s_waitcnt lgkmcnt(0)" ::: "memory");
    const int c = lane & 7;
#pragma unroll
    for (int j = 0; j < 4; ++j) { const int n = (lane >> 3) + 8 * j; const LAS float* s = scr + (8 * c) * 33 + n;
        u32x4 o; o.x = pk2(s[0 * 33], s[1 * 33]); o.y = pk2(s[2 * 33], s[3 * 33]); o.z = pk2(s[4 * 33], s[5 * 33]); o.w = pk2(s[6 * 33], s[7 * 33]);
        int col = n0 + n, drow = col;
        if (ffn_perm) { const int isval = col >= DFF; const int cc = isval ? col - DFF : col; drow = (cc >> 7) * 256 + isval * 128 + (cc & 127); }
        *(u32x4*)(WT + (size_t)drow * K + k0 + 8 * c) = o; }
    asm volatile("s_waitcnt lgkmcnt(0)" ::: "memory");
}
DI void norm_store_bf16(const f32x4 (&v)[4], const float* gain, bf16_t* orow, int lane) {
    float s = 0.f;
#pragma unroll
    for (int j = 0; j < 4; ++j) s += (v[j].x * v[j].x + v[j].y * v[j].y) + (v[j].z * v[j].z + v[j].w * v[j].w);
    const float rstd = __builtin_amdgcn_rsqf(wave_sum(s) * (1.0f / DM) + EPS);
#pragma unroll
    for (int j = 0; j < 4; ++j) { const f32x4 g = *(const f32x4*)(gain + 4 * lane + 256 * j);
        u32x2 wv; wv.x = cvtpk(v[j].x * rstd * g.x, v[j].y * rstd * g.y); wv.y = cvtpk(v[j].z * rstd * g.z, v[j].w * rstd * g.w);
        *(u32x2*)(orow + 4 * lane + 256 * j) = wv; }
}

#ifdef NO_RET
#define RET_CALL
#else
#define RET_CALL retention_item(P, lds, (it & 31) >> 2, it & 3, (it < 32) ? 36 : 0, (it < 32) ? 65 : 36);
#endif
#ifdef NO_DIFF
#define DIFF_CALL
#else
#define DIFF_CALL diffattn_item(P, lds, bh >> 2, bh & 3, 64 - (j >> 5), lam, (const float*)(ctl + 16));
#endif
#ifdef NO_SB
#define SB_CALL
#else
#define SB_CALL stickbreak_item(P, lds, bh >> 2, bh & 3, 64 - (it >> 5));
#endif
constexpr int I_OUT = (DM / 64) * (DM / 32), I_UP = (DM / 64) * (2 * DFF / 32), I_DN = (DFF / 64) * (DM / 32), I_IN1 = (DM / 64) * (C_IN / 32);
DI void deferred_convert(const Params& P, LAS unsigned char* lds, unsigned* ctr, int group, int wave, int lane) {
    LAS float* scr = (LAS float*)(lds + wave * 16384);
    const int total = group == 0 ? (I_OUT + I_UP + I_DN) : (I_IN1 + I_OUT + I_UP + I_DN);
    for (;;) {
        int it = 0; if (lane == 0) it = (int)atomicAdd(ctr, 1u);
        it = __builtin_amdgcn_readfirstlane(it);
        if (it >= total) break;
        int q = it;
        if (group == 0) {
            if (q < I_UP) { transpose_item(P.ffn_up, DM, 2 * DFF, (bf16_t*)(P.ws + WS_WUP0), true, scr, q, lane, P.ffn_norm); continue; } q -= I_UP;
            if (q < I_DN) { transpose_item(P.ffn_down, DFF, DM, (bf16_t*)(P.ws + WS_WDN0), false, scr, q, lane); continue; } q -= I_DN;
            transpose_item(P.ab_w_out, DM, DM, (bf16_t*)(P.ws + WS_WOUT0), false, scr, q, lane);
        } else {
            if (q < I_UP) { transpose_item(P.ffn_up + (size_t)DM * 2 * DFF, DM, 2 * DFF, (bf16_t*)(P.ws + WS_WUP1), true, scr, q, lane, P.ffn_norm + DM); continue; } q -= I_UP;
            if (q < I_DN) { transpose_item(P.ffn_down + (size_t)DFF * DM, DFF, DM, (bf16_t*)(P.ws + WS_WDN1), false, scr, q, lane); continue; } q -= I_DN;
            if (q < I_IN1) { transpose_item(P.c_w_in, DM, C_IN, (bf16_t*)(P.ws + WS_WIN1), false, scr, q, lane, P.mix_norm + DM); continue; } q -= I_IN1;
            transpose_item(P.c_w_out, DM, DM, (bf16_t*)(P.ws + WS_WOUT1), false, scr, q, lane);
        }
    }
}


#define XB_TMO      128
#define XB_XCNT(j)  (256  + 64 * (j))
#define XB_XSUB(j)  (1280 + 64 * (j))
#define XB_XGEN(j)  (2304 + 64 * (j))
#define XB_TOP      3328
#define XB_TOPGEN   3392
#define XCD_BAR_WORDS 3456
#define XB_SPIN_CAP (1u << 18)

__device__ __forceinline__ unsigned xb_ld(unsigned* p)              { return __hip_atomic_load(p, __ATOMIC_RELAXED, __HIP_MEMORY_SCOPE_AGENT); }
__device__ __forceinline__ unsigned xb_add(unsigned* p, unsigned v) { return __hip_atomic_fetch_add(p, v, __ATOMIC_RELAXED, __HIP_MEMORY_SCOPE_AGENT); }
__device__ __forceinline__ unsigned xb_xcc_id() { return (unsigned)__builtin_amdgcn_s_getreg((3 << 11) | 20) & 0xFu; }
#define XB_SPIN(cond, bar) do { unsigned _sp = 0; while (cond) { __builtin_amdgcn_s_sleep(1); \
    if ((++_sp & 255u) == 0u) { if (xb_ld(&(bar)[XB_TMO])) break; if (_sp > XB_SPIN_CAP) { atomicAdd(&(bar)[XB_TMO], 1u); break; } } } } while (0)

struct XcdBarrier {
    unsigned* bar; unsigned x;
    volatile LAS unsigned* st;
};

__device__ __forceinline__ XcdBarrier xcd_barrier_post(unsigned* bar, volatile LAS unsigned* st) {
    XcdBarrier b; b.bar = bar; b.x = xb_xcc_id(); b.st = st;
    if (threadIdx.x == 0) (void)xb_add(&bar[XB_XCNT(b.x)], 1u);
    return b;
}
__device__ __forceinline__ void xcd_barrier_complete(unsigned* bar, unsigned x, unsigned& nloc, unsigned& nx) {
    const unsigned G = gridDim.x * gridDim.y * gridDim.z;
    unsigned sum, cnt, mine, sp = 0u;
    for (;;) {
        sum = 0u; cnt = 0u; mine = 0u;
#pragma unroll
        for (unsigned j = 0; j < 16; ++j) { const unsigned c = xb_ld(&bar[XB_XCNT(j)]); sum += c; cnt += (c > 0u) ? 1u : 0u; mine = (j == x) ? c : mine; }
        if (sum == G) break;
        __builtin_amdgcn_s_sleep(1);
        if ((++sp & 255u) == 0u) { if (xb_ld(&bar[XB_TMO])) break; if (sp > XB_SPIN_CAP) { atomicAdd(&bar[XB_TMO], 1u); break; } }
    }
    nloc = mine > 0u ? mine : 1u; nx = cnt > 0u ? cnt : 1u;
}

__device__ __forceinline__ void xcd_barrier(const XcdBarrier& b) {
    asm volatile("s_waitcnt vmcnt(0)" ::: "memory");
    __syncthreads();
    if (threadIdx.x == 0) {
        unsigned* bar = b.bar;
        __builtin_amdgcn_s_waitcnt(0);
        unsigned nloc = b.st[0], nx = b.st[1];
        if (nloc == 0u) { xcd_barrier_complete(bar, b.x, nloc, nx); b.st[0] = nloc; b.st[1] = nx; }
        const unsigned old = xb_add(&bar[XB_XSUB(b.x)], 1u);
        const unsigned gen = old / nloc;
        if (old + 1u == (gen + 1u) * nloc) {
            __builtin_amdgcn_fence(__ATOMIC_RELEASE, "agent");
            asm volatile("s_waitcnt vmcnt(0)" ::: "memory");
            const unsigned og = xb_add(&bar[XB_TOP], 1u);
            const unsigned tg = og / nx;
            if (og + 1u == (tg + 1u) * nx) xb_add(&bar[XB_TOPGEN], 1u);
            else XB_SPIN(xb_ld(&bar[XB_TOPGEN]) == tg, bar);
            __builtin_amdgcn_fence(__ATOMIC_ACQUIRE, "agent");
            xb_add(&bar[XB_XGEN(b.x)], 1u);
            asm volatile("s_waitcnt vmcnt(0)" ::: "memory");
        } else {
            XB_SPIN(xb_ld(&bar[XB_XGEN(b.x)]) == gen, bar);
            __builtin_amdgcn_fence(__ATOMIC_ACQUIRE, "agent");
            asm volatile("s_waitcnt vmcnt(0)" ::: "memory");
        }
    }
    __syncthreads();
}


#ifndef DUP_MASK
#define DUP_MASK 0
#endif
#define NREP(k) (1 + ((DUP_MASK >> (k)) & 1))
constexpr int LDS_BYTES = 147456;
constexpr int NPHASES = 12;

__global__ void __launch_bounds__(NTHREADS, 2) fwd_megakernel(Params P) {
    extern __shared__ __attribute__((aligned(16))) unsigned char lds_raw[];
    LAS unsigned char* lds = (LAS unsigned char*)lds_raw;
    cg::grid_group grid = cg::this_grid();
    const int tid = threadIdx.x, lane = tid & 63, wave = __builtin_amdgcn_readfirstlane(tid >> 6);
    const int G = gridDim.x, gw = blockIdx.x * 8 + wave, NGW = G * 8;
    unsigned* ctl = (unsigned*)(P.ws + WS_CTL);
    bf16_t* Y = (bf16_t*)(P.ws + WS_Y);
    float* H = (float*)(P.ws + WS_H);
    bf16_t* BIG = (bf16_t*)(P.ws + WS_BIG);
    const int lo = P.ph_lo, hi = P.ph_hi;
#define IN(k) (lo <= (k) && (k) < hi)
#define SEAM(k) do { if (IN(k) && IN((k) + 1)) xcd_barrier(xbar); } while (0)

    if (IN(0)) {
        if (blockIdx.x == 0) { if (tid < 64) ctl[tid] = 0u; for (int i = tid; i < XCD_BAR_WORDS; i += NTHREADS) ctl[1024 + i] = 0u; }
        { float* rz = (float*)(P.ws + WS_RSQ); for (int i = blockIdx.x * NTHREADS + tid; i < 4 * MROWS; i += G * NTHREADS) rz[i] = 0.f; }
        LAS float* scr = (LAS float*)(lds + wave * 16384);
        constexpr int I_IN0 = (DM / 64) * (AB_IN / 32);
        for (int it = gw; it < I_IN0; it += NGW) transpose_item(P.ab_w_in, DM, AB_IN, (bf16_t*)(P.ws + WS_WIN0), false, scr, it, lane);
        for (int m = gw; m < MROWS; m += NGW) {
            const int b = m / PP, p = m % PP;
            f32x4 v[4];
            if (p < NVALID0) {
#pragma unroll
                for (int j = 0; j < 4; ++j) v[j] = (f32x4){0.f, 0.f, 0.f, 0.f};
            } else {
                const float* src = (p < BLK) ? P.meta + (size_t)(p - NVALID0) * DM : P.x + ((size_t)b * SEQ + (p - BLK)) * DM;
#pragma unroll
                for (int j = 0; j < 4; ++j) v[j] = *(const f32x4*)(src + 4 * lane + 256 * j);
            }
            norm_store_bf16(v, P.mix_norm, Y + (size_t)m * DM, lane);
        }
    }
    XcdBarrier xbar; xbar.bar = ctl + 1024; xbar.x = 0; xbar.st = (volatile LAS unsigned*)(lds + 147456 - 32);
    if (IN(0) && IN(1)) {
        grid.sync();
        if (tid == 0) { xbar.st[0] = 0u; xbar.st[1] = 0u; }
        __syncthreads();
        xbar = xcd_barrier_post(ctl + 1024, (volatile LAS unsigned*)(lds + 147456 - 32));
    }
    float* RSQ = (float*)(P.ws + WS_RSQ);
    bf16_t* MIXB = (bf16_t*)P.out;
    if (IN(1)) {
        pg8::Gemm g{Y, (const bf16_t*)(P.ws + WS_WIN0), DM, 256}; pg8::StaticOrder S; S.init(MROWS / 256, AB_IN / 256, G, (int)blockIdx.x);
        EpiProj<0> E{BIG, AB_IN, nullptr, ctl + 16};
        for (int rep = 0; rep < NREP(1); ++rep) pg8::gemm_phase(lds, g, S, E);
        deferred_convert(P, lds, ctl + 8, 0, wave, lane);
    }
    SEAM(1);
    if (IN(2)) {
        float d1 = 0.f, d2 = 0.f;
        for (int i = 0; i < 64; ++i) { d1 += P.lq1[i] * P.lk1[i]; d2 += P.lq2[i] * P.lk2[i]; }
        const float lam = __expf(d1) - __expf(d2) + 0.2f;
        LAS int* itm = (LAS int*)(lds + 147456 - 64);
        for (int rep = 0; rep < NREP(2); ++rep) {
#define FETCH_ITEM(dst) do { __syncthreads(); if (tid == 0) itm[0] = (int)atomicAdd(&ctl[0 + 4 * rep], 1u); __syncthreads(); dst = itm[0]; } while (0)
            int it; FETCH_ITEM(it);
#ifdef PROBE_P2
            while (it < 128) { const int itq = it; { const int it = itq & 63; RET_CALL } FETCH_ITEM(it); }
            while (it < 128 + 2 * 32 * 65) { const int j = (it - 128) % (32 * 65); const int bh = j & 31; DIFF_CALL FETCH_ITEM(it); }
#else
            while (it < 64) { RET_CALL FETCH_ITEM(it); }
            while (it < 64 + 32 * 65) { const int j = it - 64; const int bh = j & 31; DIFF_CALL FETCH_ITEM(it); }
#endif
#undef FETCH_ITEM
        }
    }
    SEAM(2);
    if (IN(3)) {
        pg8::Gemm g{MIXB, (const bf16_t*)(P.ws + WS_WOUT0), DM, 256}; pg8::StaticOrder S; S.init(MROWS / 256, DM / 256, G, (int)blockIdx.x);
        EpiResidual<0> E{Y, nullptr, RSQ, P.x, P.meta};
        pg8::gemm_phase(lds, g, S, E);
    }
    SEAM(3);
    if (IN(4)) {
        pg8::Gemm g{Y - 2 * DM, (const bf16_t*)(P.ws + WS_WUP0), DM, 254}; pg8::StaticOrder S; S.init((MROWS + 253) / 254, DFF / 128, G, (int)blockIdx.x);
        EpiFfnUp E{BIG, P.ffn_conv, P.ffn_conv_b, RSQ};
        for (int rep = 0; rep < NREP(4); ++rep) pg8::gemm_phase(lds, g, S, E);
    }
    SEAM(4);
    if (IN(5)) {
        pg8::Gemm g{BIG, (const bf16_t*)(P.ws + WS_WDN0), DFF, 256}; pg8::StaticOrder S; S.init(MROWS / 256, DM / 256, G, (int)blockIdx.x);
        EpiResidual<1> E{Y, nullptr, RSQ + MROWS, nullptr, nullptr};
        pg8::gemm_phase(lds, g, S, E);
        deferred_convert(P, lds, ctl + 9, 1, wave, lane);
    }
    SEAM(5);
    if (IN(6)) {
        pg8::Gemm g{Y, (const bf16_t*)(P.ws + WS_WIN1), DM, 256}; pg8::StaticOrder S; S.init(MROWS / 256, C_IN / 256, G, (int)blockIdx.x);
        EpiProj<1> E{BIG, C_IN, RSQ + MROWS, nullptr};
        pg8::gemm_phase(lds, g, S, E);
    }
    SEAM(6);
    if (IN(7)) {
        LAS int* itm = (LAS int*)(lds + 147456 - 64);
        for (int rep = 0; rep < NREP(7); ++rep)
        for (;;) {
            __syncthreads();
            if (tid == 0) itm[0] = (int)atomicAdd(&ctl[1 + 4 * rep], 1u);
            __syncthreads();
            const int it = itm[0];
            if (it >= 32 * 65) break;
            const int bh = it & 31;
            SB_CALL
        }
    }
    SEAM(7);
    if (IN(8)) {
        pg8::Gemm g{MIXB, (const bf16_t*)(P.ws + WS_WOUT1), DM, 256}; pg8::StaticOrder S; S.init(MROWS / 256, DM / 256, G, (int)blockIdx.x);
        EpiResidual<1> E{Y, nullptr, RSQ + 2 * MROWS, nullptr, nullptr};
        pg8::gemm_phase(lds, g, S, E);
    }
    SEAM(8);
    if (IN(9)) {
        pg8::Gemm g{Y - 2 * DM, (const bf16_t*)(P.ws + WS_WUP1), DM, 254}; pg8::StaticOrder S; S.init((MROWS + 253) / 254, DFF / 128, G, (int)blockIdx.x);
        EpiFfnUp E{BIG, P.ffn_conv + 3 * DFF, P.ffn_conv_b + DFF, RSQ + 2 * MROWS};
        pg8::gemm_phase(lds, g, S, E);
    }
    SEAM(9);
    if (IN(10)) {
        pg8::Gemm g{BIG, (const bf16_t*)(P.ws + WS_WDN1), DFF, 256}; pg8::StaticOrder S; S.init(MROWS / 256, DM / 256, G, (int)blockIdx.x);
        EpiResidual<1> E{Y, nullptr, RSQ + 3 * MROWS, nullptr, nullptr};
        pg8::gemm_phase(lds, g, S, E);
    }
    SEAM(10);
    if (IN(11)) {
        for (int mo = gw; mo < BATCH * SEQ; mo += NGW) {
            const int b = mo / SEQ, sq = mo % SEQ; const size_t m = (size_t)b * PP + BLK + sq;
            const float rstd = __builtin_amdgcn_rsqf(RSQ[3 * MROWS + m] * (1.0f / DM) + EPS);
#pragma unroll
            for (int j = 0; j < 4; ++j) { const u32x2 q = *(const u32x2*)(Y + m * DM + 4 * lane + 256 * j); const f32x4 g = *(const f32x4*)(P.final_norm + 4 * lane + 256 * j);
                const f32x4 v = (f32x4){__uint_as_float(q.x << 16), __uint_as_float(q.x & 0xffff0000u), __uint_as_float(q.y << 16), __uint_as_float(q.y & 0xffff0000u)};
                *(f32x4*)(P.out + (size_t)mo * DM + 4 * lane + 256 * j) = v * rstd * g; }
        }
    }
#undef IN
#undef SEAM
#undef NORM_PHASE
}

#ifndef MK_ONE_LAUNCH
#define MK_ONE_LAUNCH 1
#endif
extern "C" void kernel_launch(void* const* d_in, const int* in_sizes, int n_in, void* d_out, int out_size, void* d_ws, size_t ws_size, hipStream_t stream) {
    static int grid = 0;
    if (grid == 0) {
        if (n_in != 19 || ws_size < WS_END) { fprintf(stderr, "kernel_launch: unexpected n_in %d or ws_size %zu (need %zu)\n", n_in, ws_size, (size_t)WS_END); grid = -1; return; }
        int dev = 0, cus = 0, per_cu = 0;
        hipGetDevice(&dev); hipDeviceGetAttribute(&cus, hipDeviceAttributeMultiprocessorCount, dev);
        if (hipFuncSetAttribute((const void*)fwd_megakernel, hipFuncAttributeMaxDynamicSharedMemorySize, LDS_BYTES) != hipSuccess) { fprintf(stderr, "kernel_launch: hipFuncSetAttribute failed\n"); grid = -1; return; }
        if (hipOccupancyMaxActiveBlocksPerMultiprocessor(&per_cu, (const void*)fwd_megakernel, NTHREADS, LDS_BYTES) != hipSuccess || per_cu < 1) { fprintf(stderr, "kernel_launch: occupancy query says %d\n", per_cu); per_cu = 1; }
        (void)hipGetLastError();
        grid = cus * 1;
        if (grid <= 0) grid = 256;
    }
    if (grid < 0) return;
    Params p{};
    p.x = (const float*)d_in[0]; p.meta = (const float*)d_in[1]; p.mix_norm = (const float*)d_in[2]; p.ffn_norm = (const float*)d_in[3];
    p.ffn_up = (const float*)d_in[4]; p.ffn_conv = (const float*)d_in[5]; p.ffn_conv_b = (const float*)d_in[6]; p.ffn_down = (const float*)d_in[7];
    p.ab_w_in = (const float*)d_in[8]; p.ab_ret_norm = (const float*)d_in[9]; p.ab_diff_norm = (const float*)d_in[10];
    p.lq1 = (const float*)d_in[11]; p.lk1 = (const float*)d_in[12]; p.lq2 = (const float*)d_in[13]; p.lk2 = (const float*)d_in[14]; p.ab_w_out = (const float*)d_in[15];
    p.c_w_in = (const float*)d_in[16]; p.c_w_out = (const float*)d_in[17]; p.final_norm = (const float*)d_in[18];
    p.out = (float*)d_out; p.ws = (unsigned char*)d_ws;
#if MK_ONE_LAUNCH
    p.ph_lo = 0; p.ph_hi = NPHASES;
    void* args[] = {&p};
    hipError_t e = hipLaunchCooperativeKernel((const void*)fwd_megakernel, dim3(grid), dim3(NTHREADS), args, LDS_BYTES, stream);
    if (e != hipSuccess) fprintf(stderr, "cooperative launch failed: %s (grid %d)\n", hipGetErrorString(e), grid);
#else
    for (int ph = 0; ph < NPHASES; ++ph) {
        p.ph_lo = ph; p.ph_hi = ph + 1;
        hipLaunchKernelGGL(fwd_megakernel, dim3(grid), dim3(NTHREADS), LDS_BYTES, stream, p);
    }
#endif
}
```

```cpp
#include <hip/hip_runtime.h>
#include <hip/hip_cooperative_groups.h>
#include <cstdio>
#include <cstdint>
namespace cg = cooperative_groups;

#define LAS __attribute__((address_space(3)))
#define DI __device__ __forceinline__
typedef unsigned short bf16_t;
typedef short bf16x8 __attribute__((ext_vector_type(8)));
typedef short s16x4 __attribute__((ext_vector_type(4)));
typedef float f32x2 __attribute__((ext_vector_type(2)));
typedef float f32x4 __attribute__((ext_vector_type(4)));
typedef float f32x16 __attribute__((ext_vector_type(16)));
typedef unsigned u32x2 __attribute__((ext_vector_type(2)));
typedef unsigned u32x4 __attribute__((ext_vector_type(4)));
typedef __bf16 bf16x2_t __attribute__((ext_vector_type(2)));

constexpr int BATCH = 8, SEQ = 8192, DM = 1024, BLK = 128, NMETA = 16;
constexpr int PP = SEQ + BLK;
constexpr int MROWS = BATCH * PP;
constexpr int NVALID0 = BLK - NMETA;
constexpr int DFF = 2816;
constexpr int AB_IN = 3584, C_IN = 3072;
constexpr float EPS = 1e-6f;
constexpr float LOG2E = 1.4426950408889634f;
constexpr int NTHREADS = 512;

constexpr size_t MiB = 1u << 20;
constexpr size_t WS_CTL = 0;
constexpr size_t WS_WIN0 = 1 * MiB, WS_WOUT0 = 8 * MiB, WS_WUP0 = 10 * MiB, WS_WDN0 = 21 * MiB;
constexpr size_t WS_WIN1 = 27 * MiB, WS_WOUT1 = 33 * MiB, WS_WUP1 = 35 * MiB, WS_WDN1 = 46 * MiB;
constexpr size_t WS_YPAD = 52 * MiB;
constexpr size_t WS_Y = WS_YPAD + 2 * 2048;
constexpr size_t WS_H = 184 * MiB;
constexpr size_t WS_BIG = 444 * MiB;
constexpr size_t WS_RSQ = 899 * MiB;
constexpr size_t WS_END = 901 * MiB;

struct Params {
    const float* x; const float* meta; const float* mix_norm; const float* ffn_norm;
    const float* ffn_up; const float* ffn_conv; const float* ffn_conv_b; const float* ffn_down;
    const float* ab_w_in; const float* ab_ret_norm; const float* ab_diff_norm;
    const float* lq1; const float* lk1; const float* lq2; const float* lk2; const float* ab_w_out;
    const float* c_w_in; const float* c_w_out; const float* final_norm;
    float* out; unsigned char* ws; int ph_lo, ph_hi;
};

DI unsigned cvtpk(float lo, float hi) { f32x2 v = {lo, hi}; bf16x2_t b = __builtin_convertvector(v, bf16x2_t); return __builtin_bit_cast(unsigned, b); }
DI float bf2f(unsigned short u) { return __uint_as_float(((unsigned)u) << 16); }
DI bf16x8 pack8(float a0, float a1, float a2, float a3, float a4, float a5, float a6, float a7) {
    u32x4 p; p.x = cvtpk(a0, a1); p.y = cvtpk(a2, a3); p.z = cvtpk(a4, a5); p.w = cvtpk(a6, a7); return __builtin_bit_cast(bf16x8, p);
}
#define MFMA32(a, b, c) __builtin_amdgcn_mfma_f32_32x32x16_bf16((a), (b), (c), 0, 0, 0)
DI float wave_sum(float v) {
#pragma unroll
    for (int o = 1; o < 64; o <<= 1) v += __shfl_xor(v, o);
    return v;
}
DI unsigned off_b(unsigned row, unsigned ch) { return 256u * row + 16u * (ch ^ (((row & 3u) << 2) | ((row >> 2) & 3u))); }
typedef short v4i16_t __attribute__((ext_vector_type(4)));
DI s16x4 trread(LAS const unsigned char* p) { return __builtin_bit_cast(s16x4, __builtin_amdgcn_ds_read_tr16_b64_v4i16((LAS v4i16_t*)p)); }
DI bf16x8 tr_nat(LAS const unsigned char* img, unsigned row16, unsigned c, unsigned lane) {
    const unsigned h = lane >> 5, blk = (lane >> 4) & 1, q = (lane & 15) >> 2, p = lane & 3;
    const s16x4 lo = trread(img + off_b(row16 + 8 * h + q, 4 * c + 2 * blk + (p >> 1)) + 8 * (p & 1));
    const s16x4 hi = trread(img + off_b(row16 + 8 * h + 4 + q, 4 * c + 2 * blk + (p >> 1)) + 8 * (p & 1));
    return __builtin_shufflevector(lo, hi, 0, 1, 2, 3, 4, 5, 6, 7);
}
DI bf16x8 tr_perm(LAS const unsigned char* img, unsigned row16, unsigned c, unsigned lane) {
    const unsigned h = lane >> 5, blk = (lane >> 4) & 1, q = (lane & 15) >> 2, p = lane & 3;
    const s16x4 lo = trread(img + off_b(row16 + 4 * h + q, 4 * c + 2 * blk + (p >> 1)) + 8 * (p & 1));
    const s16x4 hi = trread(img + off_b(row16 + 8 + 4 * h + q, 4 * c + 2 * blk + (p >> 1)) + 8 * (p & 1));
    return __builtin_shufflevector(lo, hi, 0, 1, 2, 3, 4, 5, 6, 7);
}
DI void tr_perm_offs(unsigned c, unsigned lane, unsigned& lo, unsigned& hi) {
    const unsigned h = lane >> 5, blk = (lane >> 4) & 1, q = (lane & 15) >> 2, p = lane & 3;
    lo = off_b(4 * h + q, 4 * c + 2 * blk + (p >> 1)) + 8 * (p & 1);
    hi = off_b(8 + 4 * h + q, 4 * c + 2 * blk + (p >> 1)) + 8 * (p & 1);
}
DI bf16x8 tr_at(LAS const unsigned char* img, unsigned lo, unsigned hi, unsigned byteoff) {
    const s16x4 a = trread(img + lo + byteoff), b = trread(img + hi + byteoff);
    return __builtin_shufflevector(a, b, 0, 1, 2, 3, 4, 5, 6, 7);
}
DI bf16x8 row_frag(LAS const unsigned char* img, unsigned row, unsigned ch) { return *(LAS const bf16x8*)(img + off_b(row, ch)); }
#define CROWC(i) (((i) & 3) + 8 * ((i) >> 2))

namespace pg8 {
constexpr int BM = 256, BK = 64, HALF = 128, HTB = HALF * BK * 2, STAGE_BYTES = 8 * HTB, NXCD = 8, WGM = 8;
DI int lds_byte(int r, int c) { const int st = (r >> 4) * 2 + (c >> 5), rr = r & 15, cc = c & 31, ob = rr * 64 + cc * 2; return st * 1024 + (ob ^ (((ob >> 9) & 1) << 5)); }
DI void stage_rc(int b, int& R, int& C) { const int st = b / 1024, sb = b % 1024, swz = sb ^ (((sb >> 9) & 1) << 5); R = (st >> 1) * 16 + swz / 64; C = (st & 1) * 32 + (swz % 64) / 2; }
DI int perm32(int rho) { const int n = rho >> 4, i = rho & 15; return 8 * (i >> 2) + 4 * n + (i & 3); }
struct Unit { int pm, pn; };
struct Gemm { const bf16_t* A; const bf16_t* Bt; int K; int a_rows; };
struct StaticOrder {
    int nM, nN, nwg, G, c;
    DI void init(int nM_, int nN_, int G_, int c_) { nM = nM_; nN = nN_; nwg = nM * nN; G = G_; c = c_; }
    DI bool next(int i, Unit& u) const {
        const long L = (long)i * G + c; if (L >= nwg) return false;
        int wgid = (int)L; { const int q = nwg / NXCD, r = nwg % NXCD, xcd = wgid % NXCD, off = wgid / NXCD; wgid = (xcd < r ? xcd * (q + 1) : r * (q + 1) + (xcd - r) * q) + off; }
        const int nig = WGM * nN, gid = wgid / nig, fm = gid * WGM, gsz = (nM - fm) < WGM ? (nM - fm) : WGM;
        u.pm = fm + ((wgid % nig) % gsz); u.pn = (wgid % nig) / gsz; return true;
    }
};

template <class Epi>
DI void gemm_phase(LAS unsigned char* lds, const Gemm g, const StaticOrder& S, const Epi& E) {
    const int tid = threadIdx.x, wid = __builtin_amdgcn_readfirstlane(tid >> 6), lane = tid & 63, wr = wid >> 2, wc = wid & 3, fr = lane & 15, fq = lane >> 4;
    const int K = g.K, nt = K / BK;
    unsigned voffA[2], voffB[2];
#pragma unroll
    for (int i = 0; i < 2; ++i) { int R, C; stage_rc(tid * 16 + i * 8192, R, C);
        const int Rb = Epi::BINTER ? (64 * (R >> 5) + perm32(R & 31)) : Epi::PERM ? ((R & ~31) + perm32(R & 31)) : R;
        voffA[i] = (unsigned)(R * K + C) * 2u; voffB[i] = (unsigned)(Rb * K + C) * 2u; }
    const size_t kstep = (size_t)(BK * 2);
    const size_t hstep = (size_t)HALF * K * 2;
    const size_t hstepB = Epi::BINTER ? (size_t)32 * K * 2 : hstep;
    const size_t tstepB = 2 * hstep;
    const size_t tstepA = (size_t)g.a_rows * K * 2;
    const unsigned ldsw = (unsigned)wid * 1024u;
    const int aoff = lds_byte(wr * 64 + fr, fq * 8), boff = lds_byte(wc * 32 + fr, fq * 8);
#define PG8_SA(b, h) (((b) * 2 + (h)) * HTB)
#define PG8_SB(b, h) ((4 + (b) * 2 + (h)) * HTB)
#define PG8_STAGE(bufoff, gbase, voff) do { _Pragma("unroll") for (int _i = 0; _i < 2; ++_i) \
        __builtin_amdgcn_global_load_lds((const unsigned*)((const char*)(gbase) + (voff)[_i]), (LAS unsigned*)(lds + (bufoff) + ldsw + _i * 8192), 16, 0, 0); } while (0)
#define PG8_LDA(dst, b, h) do { _Pragma("unroll") for (int m = 0; m < 4; ++m) _Pragma("unroll") for (int k = 0; k < 2; ++k) dst[m][k] = *(const LAS bf16x8*)(lds + PG8_SA(b, h) + aoff + m * 2048 + k * 1024); } while (0)
#define PG8_LDB(dst, b, h) do { _Pragma("unroll") for (int n = 0; n < 2; ++n) _Pragma("unroll") for (int k = 0; k < 2; ++k) dst[n][k] = *(const LAS bf16x8*)(lds + PG8_SB(b, h) + boff + n * 2048 + k * 1024); } while (0)
#define PG8_MMA(ai, bj, At, Bt) do { __builtin_amdgcn_s_setprio(1); _Pragma("unroll") for (int m = 0; m < 4; ++m) _Pragma("unroll") for (int n = 0; n < 2; ++n) _Pragma("unroll") for (int k = 0; k < 2; ++k) \
        acc[ai][bj][m][n] = __builtin_amdgcn_mfma_f32_16x16x32_bf16(Bt[n][k], At[m][k], acc[ai][bj][m][n], 0, 0, 0); __builtin_amdgcn_s_setprio(0); } while (0)
#define PG8_WAIT_V(n) asm volatile("s_waitcnt vmcnt(" #n ")" ::: "memory")
#define PG8_WAIT_L(n) asm volatile("s_waitcnt lgkmcnt(" #n ")" ::: "memory")
#define PG8_BAR __builtin_amdgcn_s_barrier()
#define PG8_SCHED __builtin_amdgcn_sched_barrier(0)
    Unit cur, nxt; int ui = 0;
    if (!S.next(0, cur)) return;
    f32x4 acc[2][2][4][2];
#pragma unroll
    for (int a = 0; a < 2; ++a)
#pragma unroll
        for (int b = 0; b < 2; ++b)
#pragma unroll
            for (int m = 0; m < 4; ++m)
#pragma unroll
                for (int n = 0; n < 2; ++n) acc[a][b][m][n] = (f32x4){0.f, 0.f, 0.f, 0.f};
    bf16x8 At[4][2], B0[2][2], B1[2][2];
    const char* cA = (const char*)g.A + (size_t)cur.pm * tstepA; const char* cB = (const char*)g.Bt + (size_t)cur.pn * tstepB;
    PG8_STAGE(PG8_SB(0, 0), cB, voffB); PG8_STAGE(PG8_SB(0, 1), cB + hstepB, voffB); PG8_STAGE(PG8_SA(0, 0), cA, voffA); PG8_STAGE(PG8_SA(0, 1), cA + hstep, voffA);
    if (wr == 1) PG8_BAR;
    PG8_WAIT_V(2); PG8_BAR;
    PG8_STAGE(PG8_SB(1, 0), cB + kstep, voffB); PG8_STAGE(PG8_SA(1, 0), cA + kstep, voffA); PG8_STAGE(PG8_SB(1, 1), cB + hstepB + kstep, voffB);
    PG8_WAIT_V(6); PG8_BAR;
    for (;;) {
        const bool has_next = S.next(ui + 1, nxt);
        const char* nA = has_next ? (const char*)g.A + (size_t)nxt.pm * tstepA : cA; const char* nB = has_next ? (const char*)g.Bt + (size_t)nxt.pn * tstepB : cB;
        for (int t = 0; t < nt; t += 2) {
            const bool last = (t == nt - 2);
            const char* a1 = cA + (size_t)(t + 1) * kstep;
            const char* a2 = last ? nA : cA + (size_t)(t + 2) * kstep; const char* b2 = last ? nB : cB + (size_t)(t + 2) * kstep;
            const char* a3 = a2 + kstep; const char* b3 = b2 + kstep;
            PG8_LDB(B0, 0, 0); PG8_LDB(B1, 0, 1); PG8_SCHED; PG8_LDA(At, 0, 0); PG8_STAGE(PG8_SA(1, 1), a1 + hstep, voffA);
            PG8_WAIT_V(8); PG8_WAIT_L(0); PG8_BAR; PG8_MMA(0, 0, At, B0); PG8_MMA(0, 1, At, B1); PG8_BAR; PG8_SCHED;
            PG8_LDA(At, 0, 1); PG8_STAGE(PG8_SB(0, 0), b2, voffB); PG8_STAGE(PG8_SB(0, 1), b2 + hstepB, voffB); PG8_STAGE(PG8_SA(0, 0), a2, voffA);
            PG8_WAIT_V(8); PG8_WAIT_L(0); PG8_BAR; PG8_MMA(1, 0, At, B0); PG8_MMA(1, 1, At, B1); PG8_BAR; PG8_SCHED;
            PG8_LDB(B0, 1, 0); PG8_LDB(B1, 1, 1); PG8_SCHED; PG8_LDA(At, 1, 0); PG8_STAGE(PG8_SA(0, 1), a2 + hstep, voffA);
            PG8_WAIT_V(8); PG8_WAIT_L(0); PG8_BAR; PG8_MMA(0, 0, At, B0); PG8_MMA(0, 1, At, B1); PG8_BAR; PG8_SCHED;
            PG8_LDA(At, 1, 1); PG8_STAGE(PG8_SB(1, 0), b3, voffB); PG8_STAGE(PG8_SB(1, 1), b3 + hstepB, voffB); PG8_STAGE(PG8_SA(1, 0), a3, voffA);
            PG8_WAIT_V(8); PG8_WAIT_L(0); PG8_BAR; PG8_MMA(1, 0, At, B0); PG8_MMA(1, 1, At, B1); PG8_BAR; PG8_SCHED;
        }
        if (wr == 0) PG8_BAR;
        E(acc, cur, wr, wc, fr, fq, lds);
        if (!has_next) break;
#pragma unroll
        for (int a = 0; a < 2; ++a)
#pragma unroll
            for (int b = 0; b < 2; ++b)
#pragma unroll
                for (int m = 0; m < 4; ++m)
#pragma unroll
                    for (int n = 0; n < 2; ++n) acc[a][b][m][n] = (f32x4){0.f, 0.f, 0.f, 0.f};
        cur = nxt; cA = nA; cB = nB; ++ui;
        if (wr == 1) PG8_BAR;
    }
    PG8_WAIT_V(0);
    PG8_BAR;
#undef PG8_SA
#undef PG8_SB
#undef PG8_STAGE
#undef PG8_LDA
#undef PG8_LDB
#undef PG8_MMA
#undef PG8_WAIT_V
#undef PG8_WAIT_L
#undef PG8_BAR
#undef PG8_SCHED
}
}

typedef f32x4 AccT[2][2][4][2];

template <int MODE> struct EpiProj {
    static constexpr bool PERM = true, BINTER = true;
    bf16_t* O; int ldc; const float* rsq; unsigned* kinf;
    DI void operator()(const AccT& acc, const pg8::Unit& u, int wr, int wc, int fr, int fq, LAS unsigned char*) const {
        const int row0 = u.pm * 256 + wr * 64 + fr;
        float rs[2][4];
#pragma unroll
        for (int ai = 0; ai < 2; ++ai)
#pragma unroll
            for (int m = 0; m < 4; ++m) rs[ai][m] = rsq ? __builtin_amdgcn_rsqf(rsq[row0 + ai * 128 + m * 16] * (1.0f / DM) + EPS) : 1.0f;
        const int seg = 2 * u.pn + (wc >> 1), type = seg >> 2, hd = seg & 3;
        const float lg = __builtin_log2f(1.0f - __builtin_exp2f(-5.0f - (float)hd));
        float amax = 0.f;
#pragma unroll
        for (int ai = 0; ai < 2; ++ai)
#pragma unroll
            for (int m = 0; m < 4; ++m) {
                const int row = row0 + ai * 128 + m * 16;
                float f = rs[ai][m];
                if (MODE == 1 && seg < 8) f *= 0.08838834764831845f * LOG2E;
                if (MODE == 0) {
                    const int p = row % PP, pc = p & 127; const bool valid = p >= NVALID0;
                    if (type == 0) f = __builtin_amdgcn_exp2f(lg * (float)pc);
                    else if (type == 1) f = valid ? 0.08838834764831845f * __builtin_amdgcn_exp2f(-lg * (float)pc) : 0.f;
                    else if (type == 2) f = valid ? 1.f : 0.f;
                    else if (type == 4) f = 0.125f * LOG2E;
                }
#pragma unroll
                for (int bj = 0; bj < 2; ++bj) {
                    const int col0 = u.pn * 256 + wc * 64 + bj * 32 + 8 * fq;
                    const f32x4 v0 = acc[ai][bj][m][0] * f, v1 = acc[ai][bj][m][1] * f;
                    u32x4 w; w.x = cvtpk(v0[0], v0[1]); w.y = cvtpk(v0[2], v0[3]); w.z = cvtpk(v1[0], v1[1]); w.w = cvtpk(v1[2], v1[3]);
                    *(u32x4*)(O + (size_t)row * ldc + col0) = w;
                    if (MODE == 0 && type == 5) amax = fmaxf(amax, fmaxf(fmaxf(fmaxf(fabsf(v0[0]), fabsf(v0[1])), fmaxf(fabsf(v0[2]), fabsf(v0[3]))), fmaxf(fmaxf(fabsf(v1[0]), fabsf(v1[1])), fmaxf(fabsf(v1[2]), fabsf(v1[3])))));
                }
            }
        if (MODE == 0 && type == 5) {
#pragma unroll
            for (int o = 1; o < 64; o <<= 1) amax = fmaxf(amax, __shfl_xor(amax, o));
            if ((threadIdx.x & 63) == 0) atomicMax(kinf + hd * 2 + (wc & 1), __float_as_uint(amax));
        }
    }
};

template <int MODE> struct EpiResidual {
    static constexpr bool PERM = true, BINTER = true;
    bf16_t* HB; float* H32; float* rowsq; const float* x0; const float* meta0;
    DI void operator()(const AccT& acc, const pg8::Unit& u, int wr, int wc, int fr, int fq, LAS unsigned char*) const {
        const int row0 = u.pm * 256 + wr * 64 + fr, col0 = u.pn * 256 + wc * 64 + 8 * fq;
#pragma unroll
        for (int ai = 0; ai < 2; ++ai)
#pragma unroll
            for (int m = 0; m < 4; ++m) {
                const int row = row0 + ai * 128 + m * 16;
                bf16_t* hp = HB + (size_t)row * DM + col0;
                const float* sp = nullptr;
                if (MODE == 0) { const int b = row / PP, p = row % PP; sp = (p < NVALID0) ? nullptr : (p < BLK) ? meta0 + (size_t)(p - NVALID0) * DM + col0 : x0 + ((size_t)b * SEQ + (p - BLK)) * DM + col0; }
                f32x4 v[2][2];
#pragma unroll
                for (int bj = 0; bj < 2; ++bj) {
                    if (MODE == 0) { v[bj][0] = sp ? *(const f32x4*)(sp + bj * 32) : (f32x4){0.f, 0.f, 0.f, 0.f}; v[bj][1] = sp ? *(const f32x4*)(sp + bj * 32 + 4) : (f32x4){0.f, 0.f, 0.f, 0.f}; }
                    else { const u32x4 q = *(const u32x4*)(hp + bj * 32);
                        v[bj][0] = (f32x4){__uint_as_float(q.x << 16), __uint_as_float(q.x & 0xffff0000u), __uint_as_float(q.y << 16), __uint_as_float(q.y & 0xffff0000u)};
                        v[bj][1] = (f32x4){__uint_as_float(q.z << 16), __uint_as_float(q.z & 0xffff0000u), __uint_as_float(q.w << 16), __uint_as_float(q.w & 0xffff0000u)}; }
                }
                float ss = 0.f;
#pragma unroll
                for (int bj = 0; bj < 2; ++bj) {
                    const f32x4 h0 = v[bj][0] + acc[ai][bj][m][0], h1 = v[bj][1] + acc[ai][bj][m][1];
                    ss += (h0[0] * h0[0] + h0[1] * h0[1]) + (h0[2] * h0[2] + h0[3] * h0[3]) + (h1[0] * h1[0] + h1[1] * h1[1]) + (h1[2] * h1[2] + h1[3] * h1[3]);
                    if (MODE == 2) { *(f32x4*)(H32 + (size_t)row * DM + col0 + bj * 32) = h0; *(f32x4*)(H32 + (size_t)row * DM + col0 + bj * 32 + 4) = h1; }
                    else { u32x4 w; w.x = cvtpk(h0[0], h0[1]); w.y = cvtpk(h0[2], h0[3]); w.z = cvtpk(h1[0], h1[1]); w.w = cvtpk(h1[2], h1[3]); *(u32x4*)(hp + bj * 32) = w; }
                }
                ss += __shfl_xor(ss, 16); ss += __shfl_xor(ss, 32);
                if (fq == 0) atomicAdd(rowsq + row, ss);
            }
    }
};

#define DPP_SHR1(old, src) __builtin_bit_cast(float, __builtin_amdgcn_update_dpp(__builtin_bit_cast(int, (old)), __builtin_bit_cast(int, (src)), 0x111, 0xF, 0xF, false))
#define DPP_SHR2(old, src) __builtin_bit_cast(float, __builtin_amdgcn_update_dpp(__builtin_bit_cast(int, (old)), __builtin_bit_cast(int, (src)), 0x112, 0xF, 0xF, false))
#define DPP_ROR1(src) __builtin_bit_cast(float, __builtin_amdgcn_update_dpp(0, __builtin_bit_cast(int, (src)), 0x121, 0xF, 0xF, false))
#define DPP_ROR2(src) __builtin_bit_cast(float, __builtin_amdgcn_update_dpp(0, __builtin_bit_cast(int, (src)), 0x122, 0xF, 0xF, false))
struct EpiFfnUp {
    static constexpr bool PERM = true, BINTER = false;
    bf16_t* ACT; const float* wconv; const float* bconv; const float* rsq;
    DI void operator()(const AccT& acc, const pg8::Unit& u, int wr, int wc, int fr, int fq, LAS unsigned char* lds) const {
        LAS float* halo = (LAS float*)(lds + 131072);
        const int vbase = 254 * u.pm - 2;
        const int cl = wc * 32 + 8 * fq;
        const int cg0 = u.pn * 128 + cl;
        float rv[2][4], rg[2][4];
#pragma unroll
        for (int ai = 0; ai < 2; ++ai)
#pragma unroll
            for (int m = 0; m < 4; ++m) { const int v = vbase + ai * 128 + wr * 64 + m * 16 + fr; const bool inr = v >= 0 && v < MROWS;
                const float r = inr ? __builtin_amdgcn_rsqf(rsq[inr ? v : 0] * (1.0f / DM) + EPS) : 0.f;
                rv[ai][m] = r; rg[ai][m] = (inr && (v % PP) >= NVALID0) ? r : 0.f; }
        f32x4 w0[2], w1[2], w2[2], bb[2];
#pragma unroll
        for (int n = 0; n < 2; ++n) { w0[n] = *(const f32x4*)(wconv + cg0 + 4 * n); w1[n] = *(const f32x4*)(wconv + DFF + cg0 + 4 * n); w2[n] = *(const f32x4*)(wconv + 2 * DFF + cg0 + 4 * n); bb[n] = *(const f32x4*)(bconv + cg0 + 4 * n); }
        if (fr >= 14) {
#pragma unroll
            for (int ai = 0; ai < 2; ++ai)
#pragma unroll
                for (int n = 0; n < 2; ++n) *(LAS f32x4*)(halo + ((2 * ai + wr) * 2 + (fr - 14)) * 128 + cl + 4 * n) = acc[ai][0][3][n] * rg[ai][3];
        }
        asm volatile("s_waitcnt lgkmcnt(0)" ::: "memory"); __builtin_amdgcn_s_barrier(); asm volatile("" ::: "memory");
#pragma unroll
        for (int ai = 0; ai < 2; ++ai) {
            const int grp = 2 * ai + wr;
            f32x4 pa[2], pb[2];
#pragma unroll
            for (int n = 0; n < 2; ++n) {
                if (grp > 0) {
                    const f32x4 h0 = *(LAS const f32x4*)(halo + ((grp - 1) * 2 + 0) * 128 + cl + 4 * n);
                    const f32x4 h1 = *(LAS const f32x4*)(halo + ((grp - 1) * 2 + 1) * 128 + cl + 4 * n);
                    pa[n] = h1; pb[n] = (fr == 0) ? h0 : h1;
                } else { pa[n] = (f32x4){0.f, 0.f, 0.f, 0.f}; pb[n] = pa[n]; }
            }
#pragma unroll
            for (int m = 0; m < 4; ++m) {
                const int lr = ai * 128 + wr * 64 + m * 16 + fr; const int v = vbase + lr;
                u32x4 w;
#pragma unroll
                for (int n = 0; n < 2; ++n) {
                    const f32x4 gv = acc[ai][0][m][n] * rg[ai][m];
                    f32x4 g1, g2;
#pragma unroll
                    for (int j = 0; j < 4; ++j) { float t = gv[j]; asm volatile("" : "+v"(t));
                        const float r1 = DPP_ROR1(t), r2 = DPP_ROR2(t); g1[j] = (fr >= 1) ? r1 : pa[n][j]; g2[j] = (fr >= 2) ? r2 : pb[n][j]; pa[n][j] = r1; pb[n][j] = r2; }
                    const f32x4 cv = bb[n] + w0[n] * g2 + w1[n] * g1 + w2[n] * gv;
                    const f32x4 vv = acc[ai][1][m][n] * rv[ai][m];
                    f32x4 o;
#pragma unroll
                    for (int j = 0; j < 4; ++j) o[j] = cv[j] * __builtin_amdgcn_rcpf(1.0f + __builtin_amdgcn_exp2f(-LOG2E * cv[j])) * vv[j];
                    if (n == 0) { w.x = cvtpk(o[0], o[1]); w.y = cvtpk(o[2], o[3]); } else { w.z = cvtpk(o[0], o[1]); w.w = cvtpk(o[2], o[3]); }
                }
                if (lr >= 2 && v < MROWS) *(u32x4*)(ACT + (size_t)v * DFF + cg0) = w;
            }
        }
    }
};

template <int NCH> DI void tile_load(const bf16_t* src, int ld, u32x4 (&v)[NCH], int tid) {
#pragma unroll
    for (int i = 0; i < NCH; ++i) { const int c = tid + NTHREADS * i, row = c >> 4, ch = c & 15; v[i] = *(const u32x4*)(src + (size_t)row * ld + ch * 8); }
}
template <int NCH> DI void tile_store(LAS unsigned char* img, const u32x4 (&v)[NCH], int tid) {
#pragma unroll
    for (int i = 0; i < NCH; ++i) { const int c = tid + NTHREADS * i, row = c >> 4, ch = c & 15; *(LAS u32x4*)(img + off_b(row, ch)) = v[i]; }
}

DI void tile_dma64(const bf16_t* src, int ld, LAS unsigned char* img, int wave, int lane) {
#pragma unroll
    for (int i = 0; i < 2; ++i) {
        const unsigned L = (unsigned)((wave * 2 + i) * 64 + lane), row = L >> 4, cpos = L & 15;
        const unsigned ch = cpos ^ (((row & 3u) << 2) | ((row >> 2) & 3u));
        __builtin_amdgcn_global_load_lds((const unsigned*)(src + (size_t)row * ld + ch * 8), (LAS unsigned*)(img + (wave * 2 + i) * 1024), 16, 0, 0);
    }
}
DI void glds16(const void* gsrc, unsigned lds_dst) { unsigned keep;
    asm volatile("s_mov_b32 %0, m0\n\ts_mov_b32 m0, %2\n\ts_nop 0\n\tglobal_load_lds_dwordx4 %1, off\n\ts_mov_b32 m0, %0" : "=&s"(keep) : "v"(gsrc), "s"(lds_dst) : "memory"); }
DI void tile_dma64_asm(const bf16_t* src, int ld, LAS unsigned char* img, int wave, int lane) {
#pragma unroll
    for (int i = 0; i < 2; ++i) {
        const unsigned L = (unsigned)((wave * 2 + i) * 64 + lane), row = L >> 4, cpos = L & 15;
        const unsigned ch = cpos ^ (((row & 3u) << 2) | ((row >> 2) & 3u));
        glds16(src + (size_t)row * ld + ch * 8, (unsigned)__builtin_amdgcn_readfirstlane((int)((unsigned)(uintptr_t)img + (unsigned)(wave * 2 + i) * 1024u)));
    }
}

DI void retention_item(const Params& P, LAS unsigned char* lds, int b, int hd, int nfull0, int nend) {
    const int tid = threadIdx.x, lane = tid & 63, w = __builtin_amdgcn_readfirstlane(tid >> 6), r = lane & 31, h = lane >> 5, ib = w & 3, eh = w >> 2;
    LAS unsigned char* Qimg = lds; LAS unsigned char* Kimg = lds + 32768; LAS unsigned char* Vimg = lds + 65536; LAS unsigned char* Timg = lds + 98304;
    LAS f32x2* X = (LAS f32x2*)(lds + 131072);
    const bf16_t* proj = (const bf16_t*)(P.ws + WS_BIG) + (size_t)(b * PP) * AB_IN;
    bf16_t* MIX = (bf16_t*)P.out;
    const float lg = __builtin_log2f(1.0f - __builtin_exp2f(-5.0f - (float)hd));
    const float g128 = __builtin_exp2f(128.0f * lg);
    __syncthreads();
    for (int i = tid; i < 2048; i += NTHREADS) ((LAS u32x4*)Timg)[i] = (u32x4){0u, 0u, 0u, 0u};
    f32x16 st[2];
#pragma unroll
    for (int i = 0; i < 16; ++i) { st[0][i] = 0.f; st[1][i] = 0.f; }
    u32x4 pq[4], pk[4], pv[4];
    if (nfull0 == 0) tile_load<4>(proj + hd * 128, AB_IN, pq, tid);
    tile_load<4>(proj + 512 + hd * 128, AB_IN, pk, tid); tile_load<4>(proj + 1024 + hd * 128, AB_IN, pv, tid);
    const float* rn = P.ab_ret_norm + hd * 128;
    for (int n = 0; n < nend; ++n) {
        const bool full = n >= nfull0;
        __syncthreads();
        if (full) tile_store<4>(Qimg, pq, tid);
        tile_store<4>(Kimg, pk, tid); tile_store<4>(Vimg, pv, tid);
        __syncthreads();
        if (n + 1 < nend) { const bf16_t* s = proj + (size_t)(n + 1) * 128 * AB_IN;
            if (n + 1 >= nfull0) tile_load<4>(s + hd * 128, AB_IN, pq, tid);
            tile_load<4>(s + 512 + hd * 128, AB_IN, pk, tid); tile_load<4>(s + 1024 + hd * 128, AB_IN, pv, tid); }
        f32x16 o[2];
#pragma unroll
        for (int i = 0; i < 16; ++i) { o[0][i] = 0.f; o[1][i] = 0.f; }
        if (full) {
#pragma unroll 2
        for (int s = 0; s < 8; ++s) { const bf16x8 qv = row_frag(Qimg, 32 * ib + r, 2 * s + h);
#pragma unroll
            for (int ec = 0; ec < 2; ++ec) { const bf16x8 a = tr_nat(Timg, 16 * s, 2 * eh + ec, lane); o[ec] = MFMA32(a, qv, o[ec]); } }
        for (int jb = 0; jb <= ib; ++jb) {
            f32x16 S;
#pragma unroll
            for (int i = 0; i < 16; ++i) S[i] = 0.f;
#pragma unroll 1
            for (int s = 0; s < 8; ++s) { const bf16x8 a = row_frag(Kimg, 32 * jb + r, 2 * s + h); const bf16x8 qv = row_frag(Qimg, 32 * ib + r, 2 * s + h); S = MFMA32(a, qv, S); }
            if (jb == ib) {
#pragma unroll
                for (int i = 0; i < 16; ++i) if (CROWC(i) + 4 * h > r) S[i] = 0.f;
            }
            const bf16x8 p0 = pack8(S[0], S[1], S[2], S[3], S[4], S[5], S[6], S[7]), p1 = pack8(S[8], S[9], S[10], S[11], S[12], S[13], S[14], S[15]);
#pragma unroll
            for (int ec = 0; ec < 2; ++ec) {
                const bf16x8 a0 = tr_perm(Vimg, 32 * jb, 2 * eh + ec, lane); o[ec] = MFMA32(a0, p0, o[ec]);
                const bf16x8 a1 = tr_perm(Vimg, 32 * jb + 16, 2 * eh + ec, lane); o[ec] = MFMA32(a1, p1, o[ec]);
            }
        }
        }
#pragma unroll 1
        for (int s = 0; s < 8; ++s) {
            const bf16x8 bk = tr_nat(Kimg, 16 * s, ib, lane);
#pragma unroll
            for (int ec = 0; ec < 2; ++ec) { const bf16x8 av = tr_nat(Vimg, 16 * s, 2 * eh + ec, lane); st[ec] = MFMA32(av, bk, st[ec]); }
        }
#pragma unroll
        for (int i = 0; i < 16; ++i) { st[0][i] *= g128; st[1][i] *= g128; }
        float s1 = 0.f, s2 = 0.f;
#pragma unroll
        for (int ec = 0; ec < 2; ++ec)
#pragma unroll
            for (int i = 0; i < 16; ++i) { s1 += o[ec][i]; s2 += o[ec][i] * o[ec][i]; }
        s1 += __shfl_xor(s1, 32); s2 += __shfl_xor(s2, 32);
        if (h == 0) X[(eh * 4 + ib) * 32 + r] = (f32x2){s1, s2};
        __syncthreads();
#pragma unroll
        for (int ec = 0; ec < 2; ++ec)
#pragma unroll
            for (int g = 0; g < 4; ++g) { u32x2 wv; wv.x = cvtpk(st[ec][4 * g], st[ec][4 * g + 1]); wv.y = cvtpk(st[ec][4 * g + 2], st[ec][4 * g + 3]);
                *(LAS u32x2*)(Timg + off_b(32 * ib + r, 4 * (2 * eh + ec) + g) + 8 * h) = wv; }
        if (!full) continue;
        const f32x2 xo = X[((1 - eh) * 4 + ib) * 32 + r];
        const float mean = (s1 + xo.x) * (1.0f / 128.0f);
        const float var = (s2 + xo.y) * (1.0f / 128.0f) - mean * mean;
        const float rstd = __builtin_amdgcn_rsqf(fmaxf(var, 0.f) + EPS);
        const size_t m = (size_t)(b * PP) + n * 128 + 32 * ib + r;
        const bf16_t* rg = (const bf16_t*)(P.ws + WS_BIG) + m * AB_IN + 1536 + hd * 128;
        bf16_t* op = MIX + m * DM + hd * 128;
#pragma unroll
        for (int ec = 0; ec < 2; ++ec)
#pragma unroll
            for (int g = 0; g < 4; ++g) {
                const int e = 32 * (2 * eh + ec) + 8 * g + 4 * h;
                const u32x2 gr = *(const u32x2*)(rg + e);
                const f32x4 nw = *(const f32x4*)(rn + e);
                float gate[4] = {__uint_as_float(gr.x << 16), __uint_as_float(gr.x & 0xffff0000u), __uint_as_float(gr.y << 16), __uint_as_float(gr.y & 0xffff0000u)};
                float y[4];
#pragma unroll
                for (int j = 0; j < 4; ++j) { const float sg = gate[j] * __builtin_amdgcn_rcpf(1.0f + __builtin_amdgcn_exp2f(-LOG2E * gate[j])); y[j] = (o[ec][4 * g + j] - mean) * rstd * nw[j] * sg; }
                u32x2 wv; wv.x = cvtpk(y[0], y[1]); wv.y = cvtpk(y[2], y[3]);
                *(u32x2*)(op + e) = wv;
            }
    }
}

DI void diffattn_item(const Params& P, LAS unsigned char* lds, int b, int hd, int qb, float lam, const float* kinf) {
    const int tid = threadIdx.x, lane = tid & 63, w = __builtin_amdgcn_readfirstlane(tid >> 6), r = lane & 31, h = lane >> 5, wq = w & 3, mp = w >> 2;
    LAS float* XO = (LAS float*)lds;
    LAS unsigned* flags = (LAS unsigned*)(lds + 131072);
    const bf16_t* proj = (const bf16_t*)(P.ws + WS_BIG) + (size_t)(b * PP) * AB_IN;
    bf16_t* MIX = (bf16_t*)P.out;
    const int qpos = 128 * qb + 32 * wq + r;
    const float slope = __builtin_exp2f(-2.0f * (float)(hd + 1));
    const float c2 = slope * LOG2E;
    bf16x8 qf[4];
    float q1 = 0.f;
    { const bf16_t* qp = proj + (size_t)qpos * AB_IN + 2048 + hd * 128 + mp * 64 + 8 * h;
#pragma unroll
      for (int s = 0; s < 4; ++s) { qf[s] = *(const bf16x8*)(qp + 16 * s);
#pragma unroll
          for (int j = 0; j < 8; ++j) q1 += fabsf(bf2f((unsigned short)qf[s][j])); } }
    q1 += __shfl_xor(q1, 32);
    const float sbound = q1 * kinf[hd * 2 + mp] * 1.01f + 1.0f;
    f32x16 O[4];
#pragma unroll
    for (int c = 0; c < 4; ++c)
#pragma unroll
        for (int i = 0; i < 16; ++i) O[c][i] = 0.f;
    float mrun = -1e30f, lrun = 0.f;
    const int ktop = 2 * qb + 1;
    unsigned vlo0, vhi0; tr_perm_offs(0, lane, vlo0, vhi0);
    const unsigned kof0 = off_b(r, 8 * mp + h);
#define DF_DMA(kt_, slot_) do { LAS unsigned char* nb_ = lds + (slot_) * 32768; \
        tile_dma64_asm(proj + (size_t)(64 * (kt_)) * AB_IN + 2560 + hd * 128, AB_IN, nb_, w, lane); \
        tile_dma64_asm(proj + (size_t)(64 * (kt_)) * AB_IN + 3072 + hd * 128, AB_IN, nb_ + 16384, w, lane); } while (0)
#define DF_QK(Sa, Sb, slot_) do { LAS unsigned char* kb_ = lds + (slot_) * 32768; \
        _Pragma("unroll") for (int i = 0; i < 16; ++i) { Sa[i] = 0.f; Sb[i] = 0.f; } \
        bf16x8 ka_[8]; \
        _Pragma("unroll") for (int s = 0; s < 4; ++s) { ka_[2 * s] = *(LAS const bf16x8*)(kb_ + (kof0 ^ (32u * s))); ka_[2 * s + 1] = *(LAS const bf16x8*)(kb_ + (kof0 ^ (32u * s)) + 8192); } \
        __builtin_amdgcn_sched_barrier(0); \
        _Pragma("unroll") for (int s = 0; s < 4; ++s) { Sa = MFMA32(ka_[2 * s], qf[s], Sa); Sb = MFMA32(ka_[2 * s + 1], qf[s], Sb); } } while (0)
    __syncthreads();
    DF_DMA(ktop, 0); DF_DMA(ktop - 1, 1);
    if (tid < 16) flags[tid] = 0u;
    asm volatile("s_waitcnt vmcnt(0)" ::: "memory");
    __syncthreads();
    f32x16 S0, S1;
    DF_QK(S0, S1, 0);
    int slot = 0;
    bf16x8 pp0 = {0, 0, 0, 0, 0, 0, 0, 0}, pp1 = pp0, pp2 = pp0, pp3 = pp0;
    LAS unsigned char* vprev = lds + 16384;
#define DF_LDV(c_, dst_, Vimg_) do { const unsigned vl_ = vlo0 ^ (64u * (c_)), vh_ = vhi0 ^ (64u * (c_)); \
        dst_[0] = tr_at(Vimg_, vl_, vh_, 0); dst_[1] = tr_at(Vimg_, vl_, vh_, 4096); dst_[2] = tr_at(Vimg_, vl_, vh_, 8192); dst_[3] = tr_at(Vimg_, vl_, vh_, 12288); } while (0)
#define DF_EXP4(S_, b_) do { _Pragma("unroll") for (int i_ = 0; i_ < 4; ++i_) { float e_ = __builtin_amdgcn_exp2f(S_[(b_) + i_] + dl); asm volatile("" : "+v"(e_));   S_[(b_) + i_] = e_; ps += e_; } } while (0)
    for (int kt = ktop; kt >= 0; --kt) {
        asm volatile("s_waitcnt vmcnt(0) lgkmcnt(0)\n\ts_barrier" ::: "memory");
        { LAS const unsigned* fr_ = flags + ((kt + 1) & 1) * 8;
          const u32x4 f0 = *(LAS const u32x4*)fr_, f1 = *(LAS const u32x4*)(fr_ + 4);
          if ((f0.x & f0.y & f0.z & f0.w & f1.x & f1.y & f1.z & f1.w) != 0u) break; }
        const int slot1 = (slot + 1) & 3;
        if (kt >= 2) DF_DMA(kt - 2, (slot + 2) & 3);
        LAS unsigned char* Vimg = lds + slot * 32768 + 16384;
        const bool boundary = (kt >= 2 * qb) || (kt < 2);
        const int k0 = 64 * kt + 4 * h;
        const float u0 = c2 * (float)(k0 - qpos);
        float amax = -3.0e38f;
        if (boundary) {
#pragma unroll
            for (int i = 0; i < 16; ++i) {
                float t0 = fmaf(c2, (float)CROWC(i), S0[i]), t1 = fmaf(c2, (float)(32 + CROWC(i)), S1[i]);
                const int kp = k0 + CROWC(i); if (kp > qpos || kp < NVALID0) t0 = -1e30f; if (kp + 32 > qpos || kp + 32 < NVALID0) t1 = -1e30f;
                S0[i] = t0; S1[i] = t1; amax = fmaxf(amax, fmaxf(t0, t1));
            }
        } else {
#pragma unroll
            for (int i = 0; i < 16; ++i) {
                const float t0 = fmaf(c2, (float)CROWC(i), S0[i]), t1 = fmaf(c2, (float)(32 + CROWC(i)), S1[i]);
                S0[i] = t0; S1[i] = t1; amax = fmaxf(amax, fmaxf(t0, t1));
            }
        }
        amax = fmaxf(amax + u0, -1e30f);
        const float bmax = fmaxf(amax, __shfl_xor(amax, 32));
        const float mold = mrun;
        mrun = fmaxf(mrun, bmax);
        const float dl = u0 - mrun;
        float ps = 0.f;
        {
            bf16x8 va[2][4];
            DF_LDV(0, va[0], vprev);
            DF_LDV(1, va[1], vprev);
            __builtin_amdgcn_sched_barrier(0);
            O[0] = MFMA32(va[0][0], pp0, O[0]); O[0] = MFMA32(va[0][1], pp1, O[0]); O[0] = MFMA32(va[0][2], pp2, O[0]); O[0] = MFMA32(va[0][3], pp3, O[0]);
            DF_EXP4(S0, 0); DF_EXP4(S1, 0);
            __builtin_amdgcn_sched_barrier(0);
            DF_LDV(2, va[0], vprev);
            O[1] = MFMA32(va[1][0], pp0, O[1]); O[1] = MFMA32(va[1][1], pp1, O[1]); O[1] = MFMA32(va[1][2], pp2, O[1]); O[1] = MFMA32(va[1][3], pp3, O[1]);
            DF_EXP4(S0, 4); DF_EXP4(S1, 4);
            __builtin_amdgcn_sched_barrier(0);
            DF_LDV(3, va[1], vprev);
            O[2] = MFMA32(va[0][0], pp0, O[2]); O[2] = MFMA32(va[0][1], pp1, O[2]); O[2] = MFMA32(va[0][2], pp2, O[2]); O[2] = MFMA32(va[0][3], pp3, O[2]);
            DF_EXP4(S0, 8); DF_EXP4(S1, 8);
            __builtin_amdgcn_sched_barrier(0);
            O[3] = MFMA32(va[1][0], pp0, O[3]); O[3] = MFMA32(va[1][1], pp1, O[3]); O[3] = MFMA32(va[1][2], pp2, O[3]); O[3] = MFMA32(va[1][3], pp3, O[3]);
            DF_EXP4(S0, 12); DF_EXP4(S1, 12);
            __builtin_amdgcn_sched_barrier(0);
        }
        if (__any(mrun > mold)) {
            const float al = __builtin_amdgcn_exp2f(mold - mrun);
            lrun *= al;
#pragma unroll
            for (int c = 0; c < 4; ++c)
#pragma unroll
                for (int i = 0; i < 16; ++i) O[c][i] *= al;
        }
        lrun += ps;
        pp0 = pack8(S0[0], S0[1], S0[2], S0[3], S0[4], S0[5], S0[6], S0[7]); pp1 = pack8(S0[8], S0[9], S0[10], S0[11], S0[12], S0[13], S0[14], S0[15]);
        pp2 = pack8(S1[0], S1[1], S1[2], S1[3], S1[4], S1[5], S1[6], S1[7]); pp3 = pack8(S1[8], S1[9], S1[10], S1[11], S1[12], S1[13], S1[14], S1[15]);
        vprev = Vimg;
        const bool okw = __all(sbound + c2 * (float)(64 * kt - 1 - qpos) - mrun < -150.0f);
        if (lane == 0) flags[(kt & 1) * 8 + w] = okw ? 1u : 0u;
        if (kt >= 1) DF_QK(S0, S1, slot1);
        slot = slot1;
    }
    {
        bf16x8 va[2][4];
        DF_LDV(0, va[0], vprev);
#pragma unroll
        for (int c = 0; c < 4; ++c) { if (c < 3) DF_LDV(c + 1, va[(c + 1) & 1], vprev); __builtin_amdgcn_sched_barrier(0);
            O[c] = MFMA32(va[c & 1][0], pp0, O[c]); O[c] = MFMA32(va[c & 1][1], pp1, O[c]); O[c] = MFMA32(va[c & 1][2], pp2, O[c]); O[c] = MFMA32(va[c & 1][3], pp3, O[c]);
            __builtin_amdgcn_sched_barrier(0); }
    }
#undef DF_EXP4
#undef DF_LDV
#undef DF_DMA
#undef DF_QK
    asm volatile("s_waitcnt vmcnt(0)" ::: "memory");
    __syncthreads();
    lrun += __shfl_xor(lrun, 32);
    const float inv = 1.0f / lrun;
    if (mp == 1) {
#pragma unroll
        for (int c = 0; c < 4; ++c)
#pragma unroll
            for (int i = 0; i < 16; ++i) XO[(wq * 64 + c * 16 + i) * 64 + lane] = O[c][i] * inv;
    }
    __syncthreads();
    if (mp == 0) {
        float ss = 0.f;
#pragma unroll
        for (int c = 0; c < 4; ++c)
#pragma unroll
            for (int i = 0; i < 16; ++i) { const float d = O[c][i] * inv - lam * XO[(wq * 64 + c * 16 + i) * 64 + lane]; O[c][i] = d; ss += d * d; }
        ss += __shfl_xor(ss, 32);
        const float rs = __builtin_amdgcn_rsqf(ss * (1.0f / 128.0f) + EPS) * 0.8f;
        const float* dn = P.ab_diff_norm + hd * 128;
        bf16_t* op = MIX + (size_t)(b * PP + qpos) * DM + 512 + hd * 128;
#pragma unroll
        for (int c = 0; c < 4; ++c)
#pragma unroll
            for (int g = 0; g < 4; ++g) {
                const int e = 32 * c + 8 * g + 4 * h;
                const f32x4 nw = *(const f32x4*)(dn + e);
                u32x2 wv; wv.x = cvtpk(O[c][4 * g] * rs * nw[0], O[c][4 * g + 1] * rs * nw[1]); wv.y = cvtpk(O[c][4 * g + 2] * rs * nw[2], O[c][4 * g + 3] * rs * nw[3]);
                *(u32x2*)(op + e) = wv;
            }
    }
}

DI void sb_block(f32x16& S, float& C, int k0, int qpos, int h, bool boundary) {
    float L[16]; float seg[4];
#pragma unroll
    for (int g = 0; g < 4; ++g) seg[g] = 0.f;
#pragma unroll
    for (int i = 0; i < 16; ++i) {
        const float z = S[i];
        const float e = __builtin_amdgcn_exp2f(-fabsf(z));
        const float sp = fmaxf(z, 0.f) + __builtin_amdgcn_logf(1.0f + e);
        bool ok = true;
        if (boundary) { const int kp = k0 + CROWC(i); ok = (kp < qpos) && (kp >= NVALID0); }
        L[i] = ok ? -sp : 0.f;
        S[i] = ok ? (z - sp) : -1e30f;
        seg[i >> 2] += L[i];
    }
    float oseg[4];
#pragma unroll
    for (int g = 0; g < 4; ++g) oseg[g] = __shfl_xor(seg[g], 32);
    float R = 0.f;
#pragma unroll
    for (int gi = 0; gi < 4; ++gi) {
        const int g = 3 - gi;
        float lat = C + R + (h == 0 ? oseg[g] : 0.f);
        S[4 * g + 3] = __builtin_amdgcn_exp2f(S[4 * g + 3] + lat); lat += L[4 * g + 3];
        S[4 * g + 2] = __builtin_amdgcn_exp2f(S[4 * g + 2] + lat); lat += L[4 * g + 2];
        S[4 * g + 1] = __builtin_amdgcn_exp2f(S[4 * g + 1] + lat); lat += L[4 * g + 1];
        S[4 * g + 0] = __builtin_amdgcn_exp2f(S[4 * g + 0] + lat);
        R += seg[g] + oseg[g];
    }
    C += R;
}
DI void stickbreak_item(const Params& P, LAS unsigned char* lds, int b, int hp, int qb) {
    const int tid = threadIdx.x, lane = tid & 63, w = __builtin_amdgcn_readfirstlane(tid >> 6), r = lane & 31, h = lane >> 5, wq = w & 3, hs = w >> 2;
    const int hd = 2 * hp + hs;
    LAS unsigned* flags = (LAS unsigned*)(lds + 131072);
    const bf16_t* proj = (const bf16_t*)(P.ws + WS_BIG) + (size_t)(b * PP) * C_IN;
    bf16_t* MIX = (bf16_t*)P.out;
    const int qpos = 128 * qb + 32 * wq + r;
    bf16x8 qf[8];
    { const bf16_t* qp = proj + (size_t)qpos * C_IN + hd * 128 + 8 * h;
#pragma unroll
      for (int s = 0; s < 8; ++s) qf[s] = *(const bf16x8*)(qp + 16 * s); }
    f32x16 O[4];
#pragma unroll
    for (int c = 0; c < 4; ++c)
#pragma unroll
        for (int i = 0; i < 16; ++i) O[c][i] = 0.f;
    float C = 0.f;
    const int ktop = 2 * qb + 1;
    unsigned vlo0, vhi0; tr_perm_offs(0, lane, vlo0, vhi0);
    const unsigned kof0 = off_b(r, h);
    __syncthreads();
#define SB_DMA(kt_, base_) do { const bf16_t* s_ = proj + (size_t)(64 * (kt_)) * C_IN + hp * 256; \
        tile_dma64_asm(s_ + 1024, C_IN, (base_), w, lane); tile_dma64_asm(s_ + 1024 + 128, C_IN, (base_) + 16384, w, lane); \
        tile_dma64_asm(s_ + 2048, C_IN, (base_) + 32768, w, lane); tile_dma64_asm(s_ + 2048 + 128, C_IN, (base_) + 49152, w, lane); } while (0)
    SB_DMA(ktop, lds);
    if (tid < 16) flags[tid] = 0u;
    int cur = 0;
    for (int kt = ktop; kt >= 0; --kt) {
        asm volatile("s_waitcnt vmcnt(0)" ::: "memory");
        __syncthreads();
        { LAS const unsigned* fr_ = flags + ((kt + 1) & 1) * 8;
          const u32x4 f0 = *(LAS const u32x4*)fr_, f1 = *(LAS const u32x4*)(fr_ + 4);
          if ((f0.x & f0.y & f0.z & f0.w & f1.x & f1.y & f1.z & f1.w) != 0u) break; }
        LAS unsigned char* Kimg = lds + cur * 65536 + hs * 16384; LAS unsigned char* Vimg = Kimg + 32768;
        if (kt > 0) SB_DMA(kt - 1, lds + (cur ^ 1) * 65536);
        cur ^= 1;
        const bool boundary = (kt >= 2 * qb) || (kt < 2);
        const bool skip = (64 * kt >= 128 * qb + 32 * wq + 32);
        if (!skip) {
            f32x16 S0, S1;
#pragma unroll
            for (int i = 0; i < 16; ++i) { S0[i] = 0.f; S1[i] = 0.f; }
#pragma unroll
            for (int s = 0; s < 8; ++s) { const bf16x8 a0 = *(LAS const bf16x8*)(Kimg + (kof0 ^ (32u * s))), a1 = *(LAS const bf16x8*)(Kimg + (kof0 ^ (32u * s)) + 8192);
                S0 = MFMA32(a0, qf[s], S0); S1 = MFMA32(a1, qf[s], S1); }
            sb_block(S1, C, 64 * kt + 32 + 4 * h, qpos, h, boundary);
            sb_block(S0, C, 64 * kt + 4 * h, qpos, h, boundary);
            const bf16x8 p0 = pack8(S0[0], S0[1], S0[2], S0[3], S0[4], S0[5], S0[6], S0[7]), p1 = pack8(S0[8], S0[9], S0[10], S0[11], S0[12], S0[13], S0[14], S0[15]);
            const bf16x8 p2 = pack8(S1[0], S1[1], S1[2], S1[3], S1[4], S1[5], S1[6], S1[7]), p3 = pack8(S1[8], S1[9], S1[10], S1[11], S1[12], S1[13], S1[14], S1[15]);
#pragma unroll
            for (int c = 0; c < 4; ++c) {
                const unsigned vl = vlo0 ^ (64u * c), vh = vhi0 ^ (64u * c);
                const bf16x8 a0 = tr_at(Vimg, vl, vh, 0), a1 = tr_at(Vimg, vl, vh, 4096), a2 = tr_at(Vimg, vl, vh, 8192), a3 = tr_at(Vimg, vl, vh, 12288);
                O[c] = MFMA32(a0, p0, O[c]); O[c] = MFMA32(a1, p1, O[c]); O[c] = MFMA32(a2, p2, O[c]); O[c] = MFMA32(a3, p3, O[c]);
            }
        }
        const bool okw = __all(C < -160.0f);
        if (lane == 0) flags[(kt & 1) * 8 + w] = okw ? 1u : 0u;
    }
#undef SB_DMA
    bf16_t* op = MIX + (size_t)(b * PP + qpos) * DM + hd * 128;
#pragma unroll
    for (int c = 0; c < 4; ++c)
#pragma unroll
        for (int g = 0; g < 4; ++g) {
            const int e = 32 * c + 8 * g + 4 * h;
            u32x2 wv; wv.x = cvtpk(O[c][4 * g], O[c][4 * g + 1]); wv.y = cvtpk(O[c][4 * g + 2], O[c][4 * g + 3]);
            *(u32x2*)(op + e) = wv;
        }
}

DI unsigned f2bf(float f) { unsigned u = __builtin_bit_cast(unsigned, f); return (u + 0x7fffu + ((u >> 16) & 1u)) >> 16; }
DI unsigned pk2(float lo, float hi) { return f2bf(lo) | (f2bf(hi) << 16); }
DI void transpose_item(const float* W, int K, int N, bf16_t* WT, bool ffn_perm, LAS float* scr, int item, int lane, const float* kgain = nullptr) {
    const int nblk = N / 32, kb = item / nblk, nb = item % nblk, k0 = 64 * kb, n0 = 32 * nb;
#pragma unroll 8
    for (int i = 0; i < 32; ++i) { const int kk = 2 * i + (lane >> 5); const float gk = kgain ? kgain[k0 + kk] : 1.0f; scr[kk * 33 + (lane & 31)] = W[(size_t)(k0 + kk) * N + n0 + (lane & 31)] * gk; }
    asm volatile("s_waitcnt lgkmcnt(0)" ::: "memory");
    const int c = lane & 7;
#pragma unroll
    for (int j = 0; j < 4; ++j) { const int n = (lane >> 3) + 8 * j; const LAS float* s = scr + (8 * c) * 33 + n;
        u32x4 o; o.x = pk2(s[0 * 33], s[1 * 33]); o.y = pk2(s[2 * 33], s[3 * 33]); o.z = pk2(s[4 * 33], s[5 * 33]); o.w = pk2(s[6 * 33], s[7 * 33]);
        int col = n0 + n, drow = col;
        if (ffn_perm) { const int isval = col >= DFF; const int cc = isval ? col - DFF : col; drow = (cc >> 7) * 256 + isval * 128 + (cc & 127); }
        *(u32x4*)(WT + (size_t)drow * K + k0 + 8 * c) = o; }
    asm volatile("s_waitcnt lgkmcnt(0)" ::: "memory");
}
DI void norm_store_bf16(const f32x4 (&v)[4], const float* gain, bf16_t* orow, int lane) {
    float s = 0.f;
#pragma unroll
    for (int j = 0; j < 4; ++j) s += (v[j].x * v[j].x + v[j].y * v[j].y) + (v[j].z * v[j].z + v[j].w * v[j].w);
    const float rstd = __builtin_amdgcn_rsqf(wave_sum(s) * (1.0f / DM) + EPS);
#pragma unroll
    for (int j = 0; j < 4; ++j) { const f32x4 g = *(const f32x4*)(gain + 4 * lane + 256 * j);
        u32x2 wv; wv.x = cvtpk(v[j].x * rstd * g.x, v[j].y * rstd * g.y); wv.y = cvtpk(v[j].z * rstd * g.z, v[j].w * rstd * g.w);
        *(u32x2*)(orow + 4 * lane + 256 * j) = wv; }
}

#ifdef NO_RET
#define RET_CALL
#else
#define RET_CALL retention_item(P, lds, (it & 31) >> 2, it & 3, (it < 32) ? 36 : 0, (it < 32) ? 65 : 36);
#endif
#ifdef NO_DIFF
#define DIFF_CALL
#else
#define DIFF_CALL diffattn_item(P, lds, bh >> 2, bh & 3, 64 - (j >> 5), lam, (const float*)(ctl + 16));
#endif
#ifdef NO_SB
#define SB_CALL
#else
#define SB_CALL stickbreak_item(P, lds, bh >> 2, bh & 3, 64 - (it >> 5));
#endif
constexpr int I_OUT = (DM / 64) * (DM / 32), I_UP = (DM / 64) * (2 * DFF / 32), I_DN = (DFF / 64) * (DM / 32), I_IN1 = (DM / 64) * (C_IN / 32);
DI void deferred_convert(const Params& P, LAS unsigned char* lds, unsigned* ctr, int group, int wave, int lane) {
    LAS float* scr = (LAS float*)(lds + wave * 16384);
    const int total = group == 0 ? (I_OUT + I_UP + I_DN) : (I_IN1 + I_OUT + I_UP + I_DN);
    for (;;) {
        int it = 0; if (lane == 0) it = (int)atomicAdd(ctr, 1u);
        it = __builtin_amdgcn_readfirstlane(it);
        if (it >= total) break;
        int q = it;
        if (group == 0) {
            if (q < I_UP) { transpose_item(P.ffn_up, DM, 2 * DFF, (bf16_t*)(P.ws + WS_WUP0), true, scr, q, lane, P.ffn_norm); continue; } q -= I_UP;
            if (q < I_DN) { transpose_item(P.ffn_down, DFF, DM, (bf16_t*)(P.ws + WS_WDN0), false, scr, q, lane); continue; } q -= I_DN;
            transpose_item(P.ab_w_out, DM, DM, (bf16_t*)(P.ws + WS_WOUT0), false, scr, q, lane);
        } else {
            if (q < I_UP) { transpose_item(P.ffn_up + (size_t)DM * 2 * DFF, DM, 2 * DFF, (bf16_t*)(P.ws + WS_WUP1), true, scr, q, lane, P.ffn_norm + DM); continue; } q -= I_UP;
            if (q < I_DN) { transpose_item(P.ffn_down + (size_t)DFF * DM, DFF, DM, (bf16_t*)(P.ws + WS_WDN1), false, scr, q, lane); continue; } q -= I_DN;
            if (q < I_IN1) { transpose_item(P.c_w_in, DM, C_IN, (bf16_t*)(P.ws + WS_WIN1), false, scr, q, lane, P.mix_norm + DM); continue; } q -= I_IN1;
            transpose_item(P.c_w_out, DM, DM, (bf16_t*)(P.ws + WS_WOUT1), false, scr, q, lane);
        }
    }
}


#define XB_TMO      128
#define XB_XCNT(j)  (256  + 64 * (j))
#define XB_XSUB(j)  (1280 + 64 * (j))
#define XB_XGEN(j)  (2304 + 64 * (j))
#define XB_TOP      3328
#define XB_TOPGEN   3392
#define XCD_BAR_WORDS 3456
#define XB_SPIN_CAP (1u << 18)

__device__ __forceinline__ unsigned xb_ld(unsigned* p)              { return __hip_atomic_load(p, __ATOMIC_RELAXED, __HIP_MEMORY_SCOPE_AGENT); }
__device__ __forceinline__ unsigned xb_add(unsigned* p, unsigned v) { return __hip_atomic_fetch_add(p, v, __ATOMIC_RELAXED, __HIP_MEMORY_SCOPE_AGENT); }
__device__ __forceinline__ unsigned xb_xcc_id() { return (unsigned)__builtin_amdgcn_s_getreg((3 << 11) | 20) & 0xFu; }
#define XB_SPIN(cond, bar) do { unsigned _sp = 0; while (cond) { __builtin_amdgcn_s_sleep(1); \
    if ((++_sp & 255u) == 0u) { if (xb_ld(&(bar)[XB_TMO])) break; if (_sp > XB_SPIN_CAP) { atomicAdd(&(bar)[XB_TMO], 1u); break; } } } } while (0)

struct XcdBarrier {
    unsigned* bar; unsigned x;
    volatile LAS unsigned* st;
};

__device__ __forceinline__ XcdBarrier xcd_barrier_post(unsigned* bar, volatile LAS unsigned* st) {
    XcdBarrier b; b.bar = bar; b.x = xb_xcc_id(); b.st = st;
    if (threadIdx.x == 0) (void)xb_add(&bar[XB_XCNT(b.x)], 1u);
    return b;
}
__device__ __forceinline__ void xcd_barrier_complete(unsigned* bar, unsigned x, unsigned& nloc, unsigned& nx) {
    const unsigned G = gridDim.x * gridDim.y * gridDim.z;
    unsigned sum, cnt, mine, sp = 0u;
    for (;;) {
        sum = 0u; cnt = 0u; mine = 0u;
#pragma unroll
        for (unsigned j = 0; j < 16; ++j) { const unsigned c = xb_ld(&bar[XB_XCNT(j)]); sum += c; cnt += (c > 0u) ? 1u : 0u; mine = (j == x) ? c : mine; }
        if (sum == G) break;
        __builtin_amdgcn_s_sleep(1);
        if ((++sp & 255u) == 0u) { if (xb_ld(&bar[XB_TMO])) break; if (sp > XB_SPIN_CAP) { atomicAdd(&bar[XB_TMO], 1u); break; } }
    }
    nloc = mine > 0u ? mine : 1u; nx = cnt > 0u ? cnt : 1u;
}

__device__ __forceinline__ void xcd_barrier(const XcdBarrier& b) {
    asm volatile("s_waitcnt vmcnt(0)" ::: "memory");
    __syncthreads();
    if (threadIdx.x == 0) {
        unsigned* bar = b.bar;
        __builtin_amdgcn_s_waitcnt(0);
        unsigned nloc = b.st[0], nx = b.st[1];
        if (nloc == 0u) { xcd_barrier_complete(bar, b.x, nloc, nx); b.st[0] = nloc; b.st[1] = nx; }
        const unsigned old = xb_add(&bar[XB_XSUB(b.x)], 1u);
        const unsigned gen = old / nloc;
        if (old + 1u == (gen + 1u) * nloc) {
            __builtin_amdgcn_fence(__ATOMIC_RELEASE, "agent");
            asm volatile("s_waitcnt vmcnt(0)" ::: "memory");
            const unsigned og = xb_add(&bar[XB_TOP], 1u);
            const unsigned tg = og / nx;
            if (og + 1u == (tg + 1u) * nx) xb_add(&bar[XB_TOPGEN], 1u);
            else XB_SPIN(xb_ld(&bar[XB_TOPGEN]) == tg, bar);
            __builtin_amdgcn_fence(__ATOMIC_ACQUIRE, "agent");
            xb_add(&bar[XB_XGEN(b.x)], 1u);
            asm volatile("s_waitcnt vmcnt(0)" ::: "memory");
        } else {
            XB_SPIN(xb_ld(&bar[XB_XGEN(b.x)]) == gen, bar);
            __builtin_amdgcn_fence(__ATOMIC_ACQUIRE, "agent");
            asm volatile("s_waitcnt vmcnt(0)" ::: "memory");
        }
    }
    __syncthreads();
}


#ifndef DUP_MASK
#define DUP_MASK 0
#endif
#define NREP(k) (1 + ((DUP_MASK >> (k)) & 1))
constexpr int LDS_BYTES = 147456;
constexpr int NPHASES = 12;

__global__ void __launch_bounds__(NTHREADS, 2) fwd_megakernel(Params P) {
    extern __shared__ __attribute__((aligned(16))) unsigned char lds_raw[];
    LAS unsigned char* lds = (LAS unsigned char*)lds_raw;
    cg::grid_group grid = cg::this_grid();
    const int tid = threadIdx.x, lane = tid & 63, wave = __builtin_amdgcn_readfirstlane(tid >> 6);
    const int G = gridDim.x, gw = blockIdx.x * 8 + wave, NGW = G * 8;
    unsigned* ctl = (unsigned*)(P.ws + WS_CTL);
    bf16_t* Y = (bf16_t*)(P.ws + WS_Y);
    float* H = (float*)(P.ws + WS_H);
    bf16_t* BIG = (bf16_t*)(P.ws + WS_BIG);
    const int lo = P.ph_lo, hi = P.ph_hi;
#define IN(k) (lo <= (k) && (k) < hi)
#define SEAM(k) do { if (IN(k) && IN((k) + 1)) xcd_barrier(xbar); } while (0)

    if (IN(0)) {
        if (blockIdx.x == 0) { if (tid < 64) ctl[tid] = 0u; for (int i = tid; i < XCD_BAR_WORDS; i += NTHREADS) ctl[1024 + i] = 0u; }
        { float* rz = (float*)(P.ws + WS_RSQ); for (int i = blockIdx.x * NTHREADS + tid; i < 4 * MROWS; i += G * NTHREADS) rz[i] = 0.f; }
        LAS float* scr = (LAS float*)(lds + wave * 16384);
        constexpr int I_IN0 = (DM / 64) * (AB_IN / 32);
        for (int it = gw; it < I_IN0; it += NGW) transpose_item(P.ab_w_in, DM, AB_IN, (bf16_t*)(P.ws + WS_WIN0), false, scr, it, lane);
        for (int m = gw; m < MROWS; m += NGW) {
            const int b = m / PP, p = m % PP;
            f32x4 v[4];
            if (p < NVALID0) {
#pragma unroll
                for (int j = 0; j < 4; ++j) v[j] = (f32x4){0.f, 0.f, 0.f, 0.f};
            } else {
                const float* src = (p < BLK) ? P.meta + (size_t)(p - NVALID0) * DM : P.x + ((size_t)b * SEQ + (p - BLK)) * DM;
#pragma unroll
                for (int j = 0; j < 4; ++j) v[j] = *(const f32x4*)(src + 4 * lane + 256 * j);
            }
            norm_store_bf16(v, P.mix_norm, Y + (size_t)m * DM, lane);
        }
    }
    XcdBarrier xbar; xbar.bar = ctl + 1024; xbar.x = 0; xbar.st = (volatile LAS unsigned*)(lds + 147456 - 32);
    if (IN(0) && IN(1)) {
        grid.sync();
        if (tid == 0) { xbar.st[0] = 0u; xbar.st[1] = 0u; }
        __syncthreads();
        xbar = xcd_barrier_post(ctl + 1024, (volatile LAS unsigned*)(lds + 147456 - 32));
    }
    float* RSQ = (float*)(P.ws + WS_RSQ);
    bf16_t* MIXB = (bf16_t*)P.out;
    if (IN(1)) {
        pg8::Gemm g{Y, (const bf16_t*)(P.ws + WS_WIN0), DM, 256}; pg8::StaticOrder S; S.init(MROWS / 256, AB_IN / 256, G, (int)blockIdx.x);
        EpiProj<0> E{BIG, AB_IN, nullptr, ctl + 16};
        for (int rep = 0; rep < NREP(1); ++rep) pg8::gemm_phase(lds, g, S, E);
        deferred_convert(P, lds, ctl + 8, 0, wave, lane);
    }
    SEAM(1);
    if (IN(2)) {
        float d1 = 0.f, d2 = 0.f;
        for (int i = 0; i < 64; ++i) { d1 += P.lq1[i] * P.lk1[i]; d2 += P.lq2[i] * P.lk2[i]; }
        const float lam = __expf(d1) - __expf(d2) + 0.2f;
        LAS int* itm = (LAS int*)(lds + 147456 - 64);
        for (int rep = 0; rep < NREP(2); ++rep) {
#define FETCH_ITEM(dst) do { __syncthreads(); if (tid == 0) itm[0] = (int)atomicAdd(&ctl[0 + 4 * rep], 1u); __syncthreads(); dst = itm[0]; } while (0)
            int it; FETCH_ITEM(it);
#ifdef PROBE_P2
            while (it < 128) { const int itq = it; { const int it = itq & 63; RET_CALL } FETCH_ITEM(it); }
            while (it < 128 + 2 * 32 * 65) { const int j = (it - 128) % (32 * 65); const int bh = j & 31; DIFF_CALL FETCH_ITEM(it); }
#else
            while (it < 64) { RET_CALL FETCH_ITEM(it); }
            while (it < 64 + 32 * 65) { const int j = it - 64; const int bh = j & 31; DIFF_CALL FETCH_ITEM(it); }
#endif
#undef FETCH_ITEM
        }
    }
    SEAM(2);
    if (IN(3)) {
        pg8::Gemm g{MIXB, (const bf16_t*)(P.ws + WS_WOUT0), DM, 256}; pg8::StaticOrder S; S.init(MROWS / 256, DM / 256, G, (int)blockIdx.x);
        EpiResidual<0> E{Y, nullptr, RSQ, P.x, P.meta};
        pg8::gemm_phase(lds, g, S, E);
    }
    SEAM(3);
    if (IN(4)) {
        pg8::Gemm g{Y - 2 * DM, (const bf16_t*)(P.ws + WS_WUP0), DM, 254}; pg8::StaticOrder S; S.init((MROWS + 253) / 254, DFF / 128, G, (int)blockIdx.x);
        EpiFfnUp E{BIG, P.ffn_conv, P.ffn_conv_b, RSQ};
        for (int rep = 0; rep < NREP(4); ++rep) pg8::gemm_phase(lds, g, S, E);
    }
    SEAM(4);
    if (IN(5)) {
        pg8::Gemm g{BIG, (const bf16_t*)(P.ws + WS_WDN0), DFF, 256}; pg8::StaticOrder S; S.init(MROWS / 256, DM / 256, G, (int)blockIdx.x);
        EpiResidual<1> E{Y, nullptr, RSQ + MROWS, nullptr, nullptr};
        pg8::gemm_phase(lds, g, S, E);
        deferred_convert(P, lds, ctl + 9, 1, wave, lane);
    }
    SEAM(5);
    if (IN(6)) {
        pg8::Gemm g{Y, (const bf16_t*)(P.ws + WS_WIN1), DM, 256}; pg8::StaticOrder S; S.init(MROWS / 256, C_IN / 256, G, (int)blockIdx.x);
        EpiProj<1> E{BIG, C_IN, RSQ + MROWS, nullptr};
        pg8::gemm_phase(lds, g, S, E);
    }
    SEAM(6);
    if (IN(7)) {
        LAS int* itm = (LAS int*)(lds + 147456 - 64);
        for (int rep = 0; rep < NREP(7); ++rep)
        for (;;) {
            __syncthreads();
            if (tid == 0) itm[0] = (int)atomicAdd(&ctl[1 + 4 * rep], 1u);
            __syncthreads();
            const int it = itm[0];
            if (it >= 32 * 65) break;
            const int bh = it & 31;
            SB_CALL
        }
    }
    SEAM(7);
    if (IN(8)) {
        pg8::Gemm g{MIXB, (const bf16_t*)(P.ws + WS_WOUT1), DM, 256}; pg8::StaticOrder S; S.init(MROWS / 256, DM / 256, G, (int)blockIdx.x);
        EpiResidual<1> E{Y, nullptr, RSQ + 2 * MROWS, nullptr, nullptr};
        pg8::gemm_phase(lds, g, S, E);
    }
    SEAM(8);
    if (IN(9)) {
        pg8::Gemm g{Y - 2 * DM, (const bf16_t*)(P.ws + WS_WUP1), DM, 254}; pg8::StaticOrder S; S.init((MROWS + 253) / 254, DFF / 128, G, (int)blockIdx.x);
        EpiFfnUp E{BIG, P.ffn_conv + 3 * DFF, P.ffn_conv_b + DFF, RSQ + 2 * MROWS};
        pg8::gemm_phase(lds, g, S, E);
    }
    SEAM(9);
    if (IN(10)) {
        pg8::Gemm g{BIG, (const bf16_t*)(P.ws + WS_WDN1), DFF, 256}; pg8::StaticOrder S; S.init(MROWS / 256, DM / 256, G, (int)blockIdx.x);
        EpiResidual<1> E{Y, nullptr, RSQ + 3 * MROWS, nullptr, nullptr};
        pg8::gemm_phase(lds, g, S, E);
    }
    SEAM(10);
    if (IN(11)) {
        for (int mo = gw; mo < BATCH * SEQ; mo += NGW) {
            const int b = mo / SEQ, sq = mo % SEQ; const size_t m = (size_t)b * PP + BLK + sq;
            const float rstd = __builtin_amdgcn_rsqf(RSQ[3 * MROWS + m] * (1.0f / DM) + EPS);
#pragma unroll
            for (int j = 0; j < 4; ++j) { const u32x2 q = *(const u32x2*)(Y + m * DM + 4 * lane + 256 * j); const f32x4 g = *(const f32x4*)(P.final_norm + 4 * lane + 256 * j);
                const f32x4 v = (f32x4){__uint_as_float(q.x << 16), __uint_as_float(q.x & 0xffff0000u), __uint_as_float(q.y << 16), __uint_as_float(q.y & 0xffff0000u)};
                *(f32x4*)(P.out + (size_t)mo * DM + 4 * lane + 256 * j) = v * rstd * g; }
        }
    }
#undef IN
#undef SEAM
#undef NORM_PHASE
}

#ifndef MK_ONE_LAUNCH
#define MK_ONE_LAUNCH 1
#endif
extern "C" void kernel_launch(void* const* d_in, const int* in_sizes, int n_in, void* d_out, int out_size, void* d_ws, size_t ws_size, hipStream_t stream) {
    static int grid = 0;
    if (grid == 0) {
        if (n_in != 19 || ws_size < WS_END) { fprintf(stderr, "kernel_launch: unexpected n_in %d or ws_size %zu (need %zu)\n", n_in, ws_size, (size_t)WS_END); grid = -1; return; }
        int dev = 0, cus = 0, per_cu = 0;
        hipGetDevice(&dev); hipDeviceGetAttribute(&cus, hipDeviceAttributeMultiprocessorCount, dev);
        if (hipFuncSetAttribute((const void*)fwd_megakernel, hipFuncAttributeMaxDynamicSharedMemorySize, LDS_BYTES) != hipSuccess) { fprintf(stderr, "kernel_launch: hipFuncSetAttribute failed\n"); grid = -1; return; }
        if (hipOccupancyMaxActiveBlocksPerMultiprocessor(&per_cu, (const void*)fwd_megakernel, NTHREADS, LDS_BYTES) != hipSuccess || per_cu < 1) { fprintf(stderr, "kernel_launch: occupancy query says %d\n", per_cu); per_cu = 1; }
        (void)hipGetLastError();
        grid = cus * 1;
        if (grid <= 0) grid = 256;
    }
    if (grid < 0) return;
    Params p{};
    p.x = (const float*)d_in[0]; p.meta = (const float*)d_in[1]; p.mix_norm = (const float*)d_in[2]; p.ffn_norm = (const float*)d_in[3];
    p.ffn_up = (const float*)d_in[4]; p.ffn_conv = (const float*)d_in[5]; p.ffn_conv_b = (const float*)d_in[6]; p.ffn_down = (const float*)d_in[7];
    p.ab_w_in = (const float*)d_in[8]; p.ab_ret_norm = (const float*)d_in[9]; p.ab_diff_norm = (const float*)d_in[10];
    p.lq1 = (const float*)d_in[11]; p.lk1 = (const float*)d_in[12]; p.lq2 = (const float*)d_in[13]; p.lk2 = (const float*)d_in[14]; p.ab_w_out = (const float*)d_in[15];
    p.c_w_in = (const float*)d_in[16]; p.c_w_out = (const float*)d_in[17]; p.final_norm = (const float*)d_in[18];
    p.out = (float*)d_out; p.ws = (unsigned char*)d_ws;
#if MK_ONE_LAUNCH
    p.ph_lo = 0; p.ph_hi = NPHASES;
    void* args[] = {&p};
    hipError_t e = hipLaunchCooperativeKernel((const void*)fwd_megakernel, dim3(grid), dim3(NTHREADS), args, LDS_BYTES, stream);
    if (e != hipSuccess) fprintf(stderr, "cooperative launch failed: %s (grid %d)\n", hipGetErrorString(e), grid);
#else
    for (int ph = 0; ph < NPHASES; ++ph) {
        p.ph_lo = ph; p.ph_hi = ph + 1;
        hipLaunchKernelGGL(fwd_megakernel, dim3(grid), dim3(NTHREADS), LDS_BYTES, stream, p);
    }
#endif
}
```

```cpp
#include <hip/hip_runtime.h>
#include <hip/hip_cooperative_groups.h>
#include <cstdio>
#include <cstdint>
namespace cg = cooperative_groups;

#define LAS __attribute__((address_space(3)))
#define DI __device__ __forceinline__
typedef unsigned short bf16_t;
typedef short bf16x8 __attribute__((ext_vector_type(8)));
typedef short s16x4 __attribute__((ext_vector_type(4)));
typedef float f32x2 __attribute__((ext_vector_type(2)));
typedef float f32x4 __attribute__((ext_vector_type(4)));
typedef float f32x16 __attribute__((ext_vector_type(16)));
typedef unsigned u32x2 __attribute__((ext_vector_type(2)));
typedef unsigned u32x4 __attribute__((ext_vector_type(4)));
typedef __bf16 bf16x2_t __attribute__((ext_vector_type(2)));

constexpr int BATCH = 8, SEQ = 8192, DM = 1024, BLK = 128, NMETA = 16;
constexpr int PP = SEQ + BLK;
constexpr int MROWS = BATCH * PP;
constexpr int NVALID0 = BLK - NMETA;
constexpr int DFF = 2816;
constexpr int AB_IN = 3584, C_IN = 3072;
constexpr float EPS = 1e-6f;
constexpr float LOG2E = 1.4426950408889634f;
constexpr int NTHREADS = 512;

constexpr size_t MiB = 1u << 20;
constexpr size_t WS_CTL = 0;
constexpr size_t WS_WIN0 = 1 * MiB, WS_WOUT0 = 8 * MiB, WS_WUP0 = 10 * MiB, WS_WDN0 = 21 * MiB;
constexpr size_t WS_WIN1 = 27 * MiB, WS_WOUT1 = 33 * MiB, WS_WUP1 = 35 * MiB, WS_WDN1 = 46 * MiB;
constexpr size_t WS_YPAD = 52 * MiB;
constexpr size_t WS_Y = WS_YPAD + 2 * 2048;
constexpr size_t WS_H = 184 * MiB;
constexpr size_t WS_BIG = 444 * MiB;
constexpr size_t WS_RSQ = 899 * MiB;
constexpr size_t WS_END = 901 * MiB;

struct Params {
    const float* x; const float* meta; const float* mix_norm; const float* ffn_norm;
    const float* ffn_up; const float* ffn_conv; const float* ffn_conv_b; const float* ffn_down;
    const float* ab_w_in; const float* ab_ret_norm; const float* ab_diff_norm;
    const float* lq1; const float* lk1; const float* lq2; const float* lk2; const float* ab_w_out;
    const float* c_w_in; const float* c_w_out; const float* final_norm;
    float* out; unsigned char* ws; int ph_lo, ph_hi;
};

DI unsigned cvtpk(float lo, float hi) { f32x2 v = {lo, hi}; bf16x2_t b = __builtin_convertvector(v, bf16x2_t); return __builtin_bit_cast(unsigned, b); }
DI float bf2f(unsigned short u) { return __uint_as_float(((unsigned)u) << 16); }
DI bf16x8 pack8(float a0, float a1, float a2, float a3, float a4, float a5, float a6, float a7) {
    u32x4 p; p.x = cvtpk(a0, a1); p.y = cvtpk(a2, a3); p.z = cvtpk(a4, a5); p.w = cvtpk(a6, a7); return __builtin_bit_cast(bf16x8, p);
}
#define MFMA32(a, b, c) __builtin_amdgcn_mfma_f32_32x32x16_bf16((a), (b), (c), 0, 0, 0)
DI float wave_sum(float v) {
#pragma unroll
    for (int o = 1; o < 64; o <<= 1) v += __shfl_xor(v, o);
    return v;
}
DI unsigned off_b(unsigned row, unsigned ch) { return 256u * row + 16u * (ch ^ (((row & 3u) << 2) | ((row >> 2) & 3u))); }
typedef short v4i16_t __attribute__((ext_vector_type(4)));
DI s16x4 trread(LAS const unsigned char* p) { return __builtin_bit_cast(s16x4, __builtin_amdgcn_ds_read_tr16_b64_v4i16((LAS v4i16_t*)p)); }
DI bf16x8 tr_nat(LAS const unsigned char* img, unsigned row16, unsigned c, unsigned lane) {
    const unsigned h = lane >> 5, blk = (lane >> 4) & 1, q = (lane & 15) >> 2, p = lane & 3;
    const s16x4 lo = trread(img + off_b(row16 + 8 * h + q, 4 * c + 2 * blk + (p >> 1)) + 8 * (p & 1));
    const s16x4 hi = trread(img + off_b(row16 + 8 * h + 4 + q, 4 * c + 2 * blk + (p >> 1)) + 8 * (p & 1));
    return __builtin_shufflevector(lo, hi, 0, 1, 2, 3, 4, 5, 6, 7);
}
DI bf16x8 tr_perm(LAS const unsigned char* img, unsigned row16, unsigned c, unsigned lane) {
    const unsigned h = lane >> 5, blk = (lane >> 4) & 1, q = (lane & 15) >> 2, p = lane & 3;
    const s16x4 lo = trread(img + off_b(row16 + 4 * h + q, 4 * c + 2 * blk + (p >> 1)) + 8 * (p & 1));
    const s16x4 hi = trread(img + off_b(row16 + 8 + 4 * h + q, 4 * c + 2 * blk + (p >> 1)) + 8 * (p & 1));
    return __builtin_shufflevector(lo, hi, 0, 1, 2, 3, 4, 5, 6, 7);
}
DI void tr_perm_offs(unsigned c, unsigned lane, unsigned& lo, unsigned& hi) {
    const unsigned h = lane >> 5, blk = (lane >> 4) & 1, q = (lane & 15) >> 2, p = lane & 3;
    lo = off_b(4 * h + q, 4 * c + 2 * blk + (p >> 1)) + 8 * (p & 1);
    hi = off_b(8 + 4 * h + q, 4 * c + 2 * blk + (p >> 1)) + 8 * (p & 1);
}
DI bf16x8 tr_at(LAS const unsigned char* img, unsigned lo, unsigned hi, unsigned byteoff) {
    const s16x4 a = trread(img + lo + byteoff), b = trread(img + hi + byteoff);
    return __builtin_shufflevector(a, b, 0, 1, 2, 3, 4, 5, 6, 7);
}
DI bf16x8 row_frag(LAS const unsigned char* img, unsigned row, unsigned ch) { return *(LAS const bf16x8*)(img + off_b(row, ch)); }
#define CROWC(i) (((i) & 3) + 8 * ((i) >> 2))

namespace pg8 {
constexpr int BM = 256, BK = 64, HALF = 128, HTB = HALF * BK * 2, STAGE_BYTES = 8 * HTB, NXCD = 8, WGM = 8;
DI int lds_byte(int r, int c) { const int st = (r >> 4) * 2 + (c >> 5), rr = r & 15, cc = c & 31, ob = rr * 64 + cc * 2; return st * 1024 + (ob ^ (((ob >> 9) & 1) << 5)); }
DI void stage_rc(int b, int& R, int& C) { const int st = b / 1024, sb = b % 1024, swz = sb ^ (((sb >> 9) & 1) << 5); R = (st >> 1) * 16 + swz / 64; C = (st & 1) * 32 + (swz % 64) / 2; }
DI int perm32(int rho) { const int n = rho >> 4, i = rho & 15; return 8 * (i >> 2) + 4 * n + (i & 3); }
struct Unit { int pm, pn; };
struct Gemm { const bf16_t* A; const bf16_t* Bt; int K; int a_rows; };
struct StaticOrder {
    int nM, nN, nwg, G, c;
    DI void init(int nM_, int nN_, int G_, int c_) { nM = nM_; nN = nN_; nwg = nM * nN; G = G_; c = c_; }
    DI bool next(int i, Unit& u) const {
        const long L = (long)i * G + c; if (L >= nwg) return false;
        int wgid = (int)L; { const int q = nwg / NXCD, r = nwg % NXCD, xcd = wgid % NXCD, off = wgid / NXCD; wgid = (xcd < r ? xcd * (q + 1) : r * (q + 1) + (xcd - r) * q) + off; }
        const int nig = WGM * nN, gid = wgid / nig, fm = gid * WGM, gsz = (nM - fm) < WGM ? (nM - fm) : WGM;
        u.pm = fm + ((wgid % nig) % gsz); u.pn = (wgid % nig) / gsz; return true;
    }
};

template <class Epi>
DI void gemm_phase(LAS unsigned char* lds, const Gemm g, const StaticOrder& S, const Epi& E) {
    const int tid = threadIdx.x, wid = __builtin_amdgcn_readfirstlane(tid >> 6), lane = tid & 63, wr = wid >> 2, wc = wid & 3, fr = lane & 15, fq = lane >> 4;
    const int K = g.K, nt = K / BK;
    unsigned voffA[2], voffB[2];
#pragma unroll
    for (int i = 0; i < 2; ++i) { int R, C; stage_rc(tid * 16 + i * 8192, R, C);
        const int Rb = Epi::BINTER ? (64 * (R >> 5) + perm32(R & 31)) : Epi::PERM ? ((R & ~31) + perm32(R & 31)) : R;
        voffA[i] = (unsigned)(R * K + C) * 2u; voffB[i] = (unsigned)(Rb * K + C) * 2u; }
    const size_t kstep = (size_t)(BK * 2);
    const size_t hstep = (size_t)HALF * K * 2;
    const size_t hstepB = Epi::BINTER ? (size_t)32 * K * 2 : hstep;
    const size_t tstepB = 2 * hstep;
    const size_t tstepA = (size_t)g.a_rows * K * 2;
    const unsigned ldsw = (unsigned)wid * 1024u;
    const int aoff = lds_byte(wr * 64 + fr, fq * 8), boff = lds_byte(wc * 32 + fr, fq * 8);
#define PG8_SA(b, h) (((b) * 2 + (h)) * HTB)
#define PG8_SB(b, h) ((4 + (b) * 2 + (h)) * HTB)
#define PG8_STAGE(bufoff, gbase, voff) do { _Pragma("unroll") for (int _i = 0; _i < 2; ++_i) \
        __builtin_amdgcn_global_load_lds((const unsigned*)((const char*)(gbase) + (voff)[_i]), (LAS unsigned*)(lds + (bufoff) + ldsw + _i * 8192), 16, 0, 0); } while (0)
#define PG8_LDA(dst, b, h) do { _Pragma("unroll") for (int m = 0; m < 4; ++m) _Pragma("unroll") for (int k = 0; k < 2; ++k) dst[m][k] = *(const LAS bf16x8*)(lds + PG8_SA(b, h) + aoff + m * 2048 + k * 1024); } while (0)
#define PG8_LDB(dst, b, h) do { _Pragma("unroll") for (int n = 0; n < 2; ++n) _Pragma("unroll") for (int k = 0; k < 2; ++k) dst[n][k] = *(const LAS bf16x8*)(lds + PG8_SB(b, h) + boff + n * 2048 + k * 1024); } while (0)
#define PG8_MMA(ai, bj, At, Bt) do { __builtin_amdgcn_s_setprio(1); _Pragma("unroll") for (int m = 0; m < 4; ++m) _Pragma("unroll") for (int n = 0; n < 2; ++n) _Pragma("unroll") for (int k = 0; k < 2; ++k) \
        acc[ai][bj][m][n] = __builtin_amdgcn_mfma_f32_16x16x32_bf16(Bt[n][k], At[m][k], acc[ai][bj][m][n], 0, 0, 0); __builtin_amdgcn_s_setprio(0); } while (0)
#define PG8_WAIT_V(n) asm volatile("s_waitcnt vmcnt(" #n ")" ::: "memory")
#define PG8_WAIT_L(n) asm volatile("s_waitcnt lgkmcnt(" #n ")" ::: "memory")
#define PG8_BAR __builtin_amdgcn_s_barrier()
#define PG8_SCHED __builtin_amdgcn_sched_barrier(0)
    Unit cur, nxt; int ui = 0;
    if (!S.next(0, cur)) return;
    f32x4 acc[2][2][4][2];
#pragma unroll
    for (int a = 0; a < 2; ++a)
#pragma unroll
        for (int b = 0; b < 2; ++b)
#pragma unroll
            for (int m = 0; m < 4; ++m)
#pragma unroll
                for (int n = 0; n < 2; ++n) acc[a][b][m][n] = (f32x4){0.f, 0.f, 0.f, 0.f};
    bf16x8 At[4][2], B0[2][2], B1[2][2];
    const char* cA = (const char*)g.A + (size_t)cur.pm * tstepA; const char* cB = (const char*)g.Bt + (size_t)cur.pn * tstepB;
    PG8_STAGE(PG8_SB(0, 0), cB, voffB); PG8_STAGE(PG8_SB(0, 1), cB + hstepB, voffB); PG8_STAGE(PG8_SA(0, 0), cA, voffA); PG8_STAGE(PG8_SA(0, 1), cA + hstep, voffA);
    if (wr == 1) PG8_BAR;
    PG8_WAIT_V(2); PG8_BAR;
    PG8_STAGE(PG8_SB(1, 0), cB + kstep, voffB); PG8_STAGE(PG8_SA(1, 0), cA + kstep, voffA); PG8_STAGE(PG8_SB(1, 1), cB + hstepB + kstep, voffB);
    PG8_WAIT_V(6); PG8_BAR;
    for (;;) {
        const bool has_next = S.next(ui + 1, nxt);
        const char* nA = has_next ? (const char*)g.A + (size_t)nxt.pm * tstepA : cA; const char* nB = has_next ? (const char*)g.Bt + (size_t)nxt.pn * tstepB : cB;
        for (int t = 0; t < nt; t += 2) {
            const bool last = (t == nt - 2);
            const char* a1 = cA + (size_t)(t + 1) * kstep;
            const char* a2 = last ? nA : cA + (size_t)(t + 2) * kstep; const char* b2 = last ? nB : cB + (size_t)(t + 2) * kstep;
            const char* a3 = a2 + kstep; const char* b3 = b2 + kstep;
            PG8_LDB(B0, 0, 0); PG8_LDB(B1, 0, 1); PG8_SCHED; PG8_LDA(At, 0, 0); PG8_STAGE(PG8_SA(1, 1), a1 + hstep, voffA);
            PG8_WAIT_V(8); PG8_WAIT_L(0); PG8_BAR; PG8_MMA(0, 0, At, B0); PG8_MMA(0, 1, At, B1); PG8_BAR; PG8_SCHED;
            PG8_LDA(At, 0, 1); PG8_STAGE(PG8_SB(0, 0), b2, voffB); PG8_STAGE(PG8_SB(0, 1), b2 + hstepB, voffB); PG8_STAGE(PG8_SA(0, 0), a2, voffA);
            PG8_WAIT_V(8); PG8_WAIT_L(0); PG8_BAR; PG8_MMA(1, 0, At, B0); PG8_MMA(1, 1, At, B1); PG8_BAR; PG8_SCHED;
            PG8_LDB(B0, 1, 0); PG8_LDB(B1, 1, 1); PG8_SCHED; PG8_LDA(At, 1, 0); PG8_STAGE(PG8_SA(0, 1), a2 + hstep, voffA);
            PG8_WAIT_V(8); PG8_WAIT_L(0); PG8_BAR; PG8_MMA(0, 0, At, B0); PG8_MMA(0, 1, At, B1); PG8_BAR; PG8_SCHED;
            PG8_LDA(At, 1, 1); PG8_STAGE(PG8_SB(1, 0), b3, voffB); PG8_STAGE(PG8_SB(1, 1), b3 + hstepB, voffB); PG8_STAGE(PG8_SA(1, 0), a3, voffA);
            PG8_WAIT_V(8); PG8_WAIT_L(0); PG8_BAR; PG8_MMA(1, 0, At, B0); PG8_MMA(1, 1, At, B1); PG8_BAR; PG8_SCHED;
        }
        if (wr == 0) PG8_BAR;
        E(acc, cur, wr, wc, fr, fq, lds);
        if (!has_next) break;
#pragma unroll
        for (int a = 0; a < 2; ++a)
#pragma unroll
            for (int b = 0; b < 2; ++b)
#pragma unroll
                for (int m = 0; m < 4; ++m)
#pragma unroll
                    for (int n = 0; n < 2; ++n) acc[a][b][m][n] = (f32x4){0.f, 0.f, 0.f, 0.f};
        cur = nxt; cA = nA; cB = nB; ++ui;
        if (wr == 1) PG8_BAR;
    }
    PG8_WAIT_V(0);
    PG8_BAR;
#undef PG8_SA
#undef PG8_SB
#undef PG8_STAGE
#undef PG8_LDA
#undef PG8_LDB
#undef PG8_MMA
#undef PG8_WAIT_V
#undef PG8_WAIT_L
#undef PG8_BAR
#undef PG8_SCHED
}
}

typedef f32x4 AccT[2][2][4][2];

template <int MODE> struct EpiProj {
    static constexpr bool PERM = true, BINTER = true;
    bf16_t* O; int ldc; const float* rsq; unsigned* kinf;
    DI void operator()(const AccT& acc, const pg8::Unit& u, int wr, int wc, int fr, int fq, LAS unsigned char*) const {
        const int row0 = u.pm * 256 + wr * 64 + fr;
        float rs[2][4];
#pragma unroll
        for (int ai = 0; ai < 2; ++ai)
#pragma unroll
            for (int m = 0; m < 4; ++m) rs[ai][m] = rsq ? __builtin_amdgcn_rsqf(rsq[row0 + ai * 128 + m * 16] * (1.0f / DM) + EPS) : 1.0f;
        const int seg = 2 * u.pn + (wc >> 1), type = seg >> 2, hd = seg & 3;
        const float lg = __builtin_log2f(1.0f - __builtin_exp2f(-5.0f - (float)hd));
        float amax = 0.f;
#pragma unroll
        for (int ai = 0; ai < 2; ++ai)
#pragma unroll
            for (int m = 0; m < 4; ++m) {
                const int row = row0 + ai * 128 + m * 16;
                float f = rs[ai][m];
                if (MODE == 1 && seg < 8) f *= 0.08838834764831845f * LOG2E;
                if (MODE == 0) {
                    const int p = row % PP, pc = p & 127; const bool valid = p >= NVALID0;
                    if (type == 0) f = __builtin_amdgcn_exp2f(lg * (float)pc);
                    else if (type == 1) f = valid ? 0.08838834764831845f * __builtin_amdgcn_exp2f(-lg * (float)pc) : 0.f;
                    else if (type == 2) f = valid ? 1.f : 0.f;
                    else if (type == 4) f = 0.125f * LOG2E;
                }
#pragma unroll
                for (int bj = 0; bj < 2; ++bj) {
                    const int col0 = u.pn * 256 + wc * 64 + bj * 32 + 8 * fq;
                    const f32x4 v0 = acc[ai][bj][m][0] * f, v1 = acc[ai][bj][m][1] * f;
                    u32x4 w; w.x = cvtpk(v0[0], v0[1]); w.y = cvtpk(v0[2], v0[3]); w.z = cvtpk(v1[0], v1[1]); w.w = cvtpk(v1[2], v1[3]);
                    *(u32x4*)(O + (size_t)row * ldc + col0) = w;
                    if (MODE == 0 && type == 5) amax = fmaxf(amax, fmaxf(fmaxf(fmaxf(fabsf(v0[0]), fabsf(v0[1])), fmaxf(fabsf(v0[2]), fabsf(v0[3]))), fmaxf(fmaxf(fabsf(v1[0]), fabsf(v1[1])), fmaxf(fabsf(v1[2]), fabsf(v1[3])))));
                }
            }
        if (MODE == 0 && type == 5) {
#pragma unroll
            for (int o = 1; o < 64; o <<= 1) amax = fmaxf(amax, __shfl_xor(amax, o));
            if ((threadIdx.x & 63) == 0) atomicMax(kinf + hd * 2 + (wc & 1), __float_as_uint(amax));
        }
    }
};

template <int MODE> struct EpiResidual {
    static constexpr bool PERM = true, BINTER = true;
    bf16_t* HB; float* H32; float* rowsq; const float* x0; const float* meta0;
    DI void operator()(const AccT& acc, const pg8::Unit& u, int wr, int wc, int fr, int fq, LAS unsigned char*) const {
        const int row0 = u.pm * 256 + wr * 64 + fr, col0 = u.pn * 256 + wc * 64 + 8 * fq;
#pragma unroll
        for (int ai = 0; ai < 2; ++ai)
#pragma unroll
            for (int m = 0; m < 4; ++m) {
                const int row = row0 + ai * 128 + m * 16;
                bf16_t* hp = HB + (size_t)row * DM + col0;
                const float* sp = nullptr;
                if (MODE == 0) { const int b = row / PP, p = row % PP; sp = (p < NVALID0) ? nullptr : (p < BLK) ? meta0 + (size_t)(p - NVALID0) * DM + col0 : x0 + ((size_t)b * SEQ + (p - BLK)) * DM + col0; }
                f32x4 v[2][2];
#pragma unroll
                for (int bj = 0; bj < 2; ++bj) {
                    if (MODE == 0) { v[bj][0] = sp ? *(const f32x4*)(sp + bj * 32) : (f32x4){0.f, 0.f, 0.f, 0.f}; v[bj][1] = sp ? *(const f32x4*)(sp + bj * 32 + 4) : (f32x4){0.f, 0.f, 0.f, 0.f}; }
                    else { const u32x4 q = *(const u32x4*)(hp + bj * 32);
                        v[bj][0] = (f32x4){__uint_as_float(q.x << 16), __uint_as_float(q.x & 0xffff0000u), __uint_as_float(q.y << 16), __uint_as_float(q.y & 0xffff0000u)};
                        v[bj][1] = (f32x4){__uint_as_float(q.z << 16), __uint_as_float(q.z & 0xffff0000u), __uint_as_float(q.w << 16), __uint_as_float(q.w & 0xffff0000u)}; }
                }
                float ss = 0.f;
#pragma unroll
                for (int bj = 0; bj < 2; ++bj) {
                    const f32x4 h0 = v[bj][0] + acc[ai][bj][m][0], h1 = v[bj][1] + acc[ai][bj][m][1];
                    ss += (h0[0] * h0[0] + h0[1] * h0[1]) + (h0[2] * h0[2] + h0[3] * h0[3]) + (h1[0] * h1[0] + h1[1] * h1[1]) + (h1[2] * h1[2] + h1[3] * h1[3]);
                    if (MODE == 2) { *(f32x4*)(H32 + (size_t)row * DM + col0 + bj * 32) = h0; *(f32x4*)(H32 + (size_t)row * DM + col0 + bj * 32 + 4) = h1; }
                    else { u32x4 w; w.x = cvtpk(h0[0], h0[1]); w.y = cvtpk(h0[2], h0[3]); w.z = cvtpk(h1[0], h1[1]); w.w = cvtpk(h1[2], h1[3]); *(u32x4*)(hp + bj * 32) = w; }
                }
                ss += __shfl_xor(ss, 16); ss += __shfl_xor(ss, 32);
                if (fq == 0) atomicAdd(rowsq + row, ss);
            }
    }
};

#define DPP_SHR1(old, src) __builtin_bit_cast(float, __builtin_amdgcn_update_dpp(__builtin_bit_cast(int, (old)), __builtin_bit_cast(int, (src)), 0x111, 0xF, 0xF, false))
#define DPP_SHR2(old, src) __builtin_bit_cast(float, __builtin_amdgcn_update_dpp(__builtin_bit_cast(int, (old)), __builtin_bit_cast(int, (src)), 0x112, 0xF, 0xF, false))
#define DPP_ROR1(src) __builtin_bit_cast(float, __builtin_amdgcn_update_dpp(0, __builtin_bit_cast(int, (src)), 0x121, 0xF, 0xF, false))
#define DPP_ROR2(src) __builtin_bit_cast(float, __builtin_amdgcn_update_dpp(0, __builtin_bit_cast(int, (src)), 0x122, 0xF, 0xF, false))
struct EpiFfnUp {
    static constexpr bool PERM = true, BINTER = false;
    bf16_t* ACT; const float* wconv; const float* bconv; const float* rsq;
    DI void operator()(const AccT& acc, const pg8::Unit& u, int wr, int wc, int fr, int fq, LAS unsigned char* lds) const {
        LAS float* halo = (LAS float*)(lds + 131072);
        const int vbase = 254 * u.pm - 2;
        const int cl = wc * 32 + 8 * fq;
        const int cg0 = u.pn * 128 + cl;
        float rv[2][4], rg[2][4];
#pragma unroll
        for (int ai = 0; ai < 2; ++ai)
#pragma unroll
            for (int m = 0; m < 4; ++m) { const int v = vbase + ai * 128 + wr * 64 + m * 16 + fr; const bool inr = v >= 0 && v < MROWS;
                const float r = inr ? __builtin_amdgcn_rsqf(rsq[inr ? v : 0] * (1.0f / DM) + EPS) : 0.f;
                rv[ai][m] = r * -0.6931471805599453f; rg[ai][m] = (inr && (v % PP) >= NVALID0) ? r : 0.f; }
        f32x4 w0[2], w1[2], w2[2], bb[2];
#pragma unroll
        for (int n = 0; n < 2; ++n) {
            w0[n] = *(const f32x4*)(wconv + cg0 + 4 * n) * -LOG2E; w1[n] = *(const f32x4*)(wconv + DFF + cg0 + 4 * n) * -LOG2E; w2[n] = *(const f32x4*)(wconv + 2 * DFF + cg0 + 4 * n) * -LOG2E; bb[n] = *(const f32x4*)(bconv + cg0 + 4 * n) * -LOG2E; }
        if (fr >= 14) {
#pragma unroll
            for (int ai = 0; ai < 2; ++ai)
#pragma unroll
                for (int n = 0; n < 2; ++n) *(LAS f32x4*)(halo + ((2 * ai + wr) * 2 + (fr - 14)) * 128 + cl + 4 * n) = acc[ai][0][3][n] * rg[ai][3];
        }
        asm volatile("s_waitcnt lgkmcnt(0)" ::: "memory"); __builtin_amdgcn_s_barrier(); asm volatile("" ::: "memory");
#pragma unroll
        for (int ai = 0; ai < 2; ++ai) {
            const int grp = 2 * ai + wr;
            f32x4 pa[2], pb[2];
#pragma unroll
            for (int n = 0; n < 2; ++n) {
                if (grp > 0) {
                    const f32x4 h0 = *(LAS const f32x4*)(halo + ((grp - 1) * 2 + 0) * 128 + cl + 4 * n);
                    const f32x4 h1 = *(LAS const f32x4*)(halo + ((grp - 1) * 2 + 1) * 128 + cl + 4 * n);
                    pa[n] = h1; pb[n] = (fr == 0) ? h0 : h1;
                } else { pa[n] = (f32x4){0.f, 0.f, 0.f, 0.f}; pb[n] = pa[n]; }
            }
#pragma unroll
            for (int m = 0; m < 4; ++m) {
                const int lr = ai * 128 + wr * 64 + m * 16 + fr; const int v = vbase + lr;
                u32x4 w;
#pragma unroll
                for (int n = 0; n < 2; ++n) {
                    const f32x4 gv = acc[ai][0][m][n] * rg[ai][m];
                    f32x4 g1, g2;
#pragma unroll
                    for (int j = 0; j < 4; ++j) { float t = gv[j]; asm volatile("" : "+v"(t));
                        const float r1 = DPP_ROR1(t), r2 = DPP_ROR2(t); g1[j] = (fr >= 1) ? r1 : pa[n][j]; g2[j] = (fr >= 2) ? r2 : pb[n][j]; pa[n][j] = r1; pb[n][j] = r2; }
                    const f32x4 cv = bb[n] + w0[n] * g2 + w1[n] * g1 + w2[n] * gv;
                    const f32x4 vv = acc[ai][1][m][n] * rv[ai][m];
                    f32x4 o;
#pragma unroll
                    for (int j = 0; j < 4; ++j) o[j] = cv[j] * __builtin_amdgcn_rcpf(1.0f + __builtin_amdgcn_exp2f(cv[j])) * vv[j];
                    if (n == 0) { w.x = cvtpk(o[0], o[1]); w.y = cvtpk(o[2], o[3]); } else { w.z = cvtpk(o[0], o[1]); w.w = cvtpk(o[2], o[3]); }
                }
                if (lr >= 2 && v < MROWS) *(u32x4*)(ACT + (size_t)v * DFF + cg0) = w;
            }
        }
    }
};

template <int NCH> DI void tile_load(const bf16_t* src, int ld, u32x4 (&v)[NCH], int tid) {
#pragma unroll
    for (int i = 0; i < NCH; ++i) { const int c = tid + NTHREADS * i, row = c >> 4, ch = c & 15; v[i] = *(const u32x4*)(src + (size_t)row * ld + ch * 8); }
}
template <int NCH> DI void tile_store(LAS unsigned char* img, const u32x4 (&v)[NCH], int tid) {
#pragma unroll
    for (int i = 0; i < NCH; ++i) { const int c = tid + NTHREADS * i, row = c >> 4, ch = c & 15; *(LAS u32x4*)(img + off_b(row, ch)) = v[i]; }
}

DI void tile_dma64(const bf16_t* src, int ld, LAS unsigned char* img, int wave, int lane) {
#pragma unroll
    for (int i = 0; i < 2; ++i) {
        const unsigned L = (unsigned)((wave * 2 + i) * 64 + lane), row = L >> 4, cpos = L & 15;
        const unsigned ch = cpos ^ (((row & 3u) << 2) | ((row >> 2) & 3u));
        __builtin_amdgcn_global_load_lds((const unsigned*)(src + (size_t)row * ld + ch * 8), (LAS unsigned*)(img + (wave * 2 + i) * 1024), 16, 0, 0);
    }
}
DI void glds16(const void* gsrc, unsigned lds_dst) { unsigned keep;
    asm volatile("s_mov_b32 %0, m0\n\ts_mov_b32 m0, %2\n\ts_nop 0\n\tglobal_load_lds_dwordx4 %1, off\n\ts_mov_b32 m0, %0" : "=&s"(keep) : "v"(gsrc), "s"(lds_dst) : "memory"); }
DI void tile_dma64_asm(const bf16_t* src, int ld, LAS unsigned char* img, int wave, int lane) {
#pragma unroll
    for (int i = 0; i < 2; ++i) {
        const unsigned L = (unsigned)((wave * 2 + i) * 64 + lane), row = L >> 4, cpos = L & 15;
        const unsigned ch = cpos ^ (((row & 3u) << 2) | ((row >> 2) & 3u));
        glds16(src + (size_t)row * ld + ch * 8, (unsigned)__builtin_amdgcn_readfirstlane((int)((unsigned)(uintptr_t)img + (unsigned)(wave * 2 + i) * 1024u)));
    }
}

DI void retention_item(const Params& P, LAS unsigned char* lds, int b, int hd, int nfull0, int nend) {
    const int tid = threadIdx.x, lane = tid & 63, w = __builtin_amdgcn_readfirstlane(tid >> 6), r = lane & 31, h = lane >> 5, ib = w & 3, eh = w >> 2;
    LAS unsigned char* Qimg = lds; LAS unsigned char* Kimg = lds + 32768; LAS unsigned char* Vimg = lds + 65536; LAS unsigned char* Timg = lds + 98304;
    LAS f32x2* X = (LAS f32x2*)(lds + 131072);
    const bf16_t* proj = (const bf16_t*)(P.ws + WS_BIG) + (size_t)(b * PP) * AB_IN;
    bf16_t* MIX = (bf16_t*)P.out;
    const float lg = __builtin_log2f(1.0f - __builtin_exp2f(-5.0f - (float)hd));
    const float g128 = __builtin_exp2f(128.0f * lg);
    __syncthreads();
    for (int i = tid; i < 2048; i += NTHREADS) ((LAS u32x4*)Timg)[i] = (u32x4){0u, 0u, 0u, 0u};
    f32x16 st[2];
#pragma unroll
    for (int i = 0; i < 16; ++i) { st[0][i] = 0.f; st[1][i] = 0.f; }
    u32x4 pq[4], pk[4], pv[4];
    if (nfull0 == 0) tile_load<4>(proj + hd * 128, AB_IN, pq, tid);
    tile_load<4>(proj + 512 + hd * 128, AB_IN, pk, tid); tile_load<4>(proj + 1024 + hd * 128, AB_IN, pv, tid);
    const float* rn = P.ab_ret_norm + hd * 128;
    for (int n = 0; n < nend; ++n) {
        const bool full = n >= nfull0;
        __syncthreads();
        if (full) tile_store<4>(Qimg, pq, tid);
        tile_store<4>(Kimg, pk, tid); tile_store<4>(Vimg, pv, tid);
        __syncthreads();
        if (n + 1 < nend) { const bf16_t* s = proj + (size_t)(n + 1) * 128 * AB_IN;
            if (n + 1 >= nfull0) tile_load<4>(s + hd * 128, AB_IN, pq, tid);
            tile_load<4>(s + 512 + hd * 128, AB_IN, pk, tid); tile_load<4>(s + 1024 + hd * 128, AB_IN, pv, tid); }
        f32x16 o[2];
#pragma unroll
        for (int i = 0; i < 16; ++i) { o[0][i] = 0.f; o[1][i] = 0.f; }
        if (full) {
#pragma unroll 2
        for (int s = 0; s < 8; ++s) { const bf16x8 qv = row_frag(Qimg, 32 * ib + r, 2 * s + h);
#pragma unroll
            for (int ec = 0; ec < 2; ++ec) { const bf16x8 a = tr_nat(Timg, 16 * s, 2 * eh + ec, lane); o[ec] = MFMA32(a, qv, o[ec]); } }
        for (int jb = 0; jb <= ib; ++jb) {
            f32x16 S;
#pragma unroll
            for (int i = 0; i < 16; ++i) S[i] = 0.f;
#pragma unroll 1
            for (int s = 0; s < 8; ++s) { const bf16x8 a = row_frag(Kimg, 32 * jb + r, 2 * s + h); const bf16x8 qv = row_frag(Qimg, 32 * ib + r, 2 * s + h); S = MFMA32(a, qv, S); }
            if (jb == ib) {
#pragma unroll
                for (int i = 0; i < 16; ++i) if (CROWC(i) + 4 * h > r) S[i] = 0.f;
            }
            const bf16x8 p0 = pack8(S[0], S[1], S[2], S[3], S[4], S[5], S[6], S[7]), p1 = pack8(S[8], S[9], S[10], S[11], S[12], S[13], S[14], S[15]);
#pragma unroll
            for (int ec = 0; ec < 2; ++ec) {
                const bf16x8 a0 = tr_perm(Vimg, 32 * jb, 2 * eh + ec, lane); o[ec] = MFMA32(a0, p0, o[ec]);
                const bf16x8 a1 = tr_perm(Vimg, 32 * jb + 16, 2 * eh + ec, lane); o[ec] = MFMA32(a1, p1, o[ec]);
            }
        }
        }
#pragma unroll 1
        for (int s = 0; s < 8; ++s) {
            const bf16x8 bk = tr_nat(Kimg, 16 * s, ib, lane);
#pragma unroll
            for (int ec = 0; ec < 2; ++ec) { const bf16x8 av = tr_nat(Vimg, 16 * s, 2 * eh + ec, lane); st[ec] = MFMA32(av, bk, st[ec]); }
        }
#pragma unroll
        for (int i = 0; i < 16; ++i) { st[0][i] *= g128; st[1][i] *= g128; }
        float s1 = 0.f, s2 = 0.f;
#pragma unroll
        for (int ec = 0; ec < 2; ++ec)
#pragma unroll
            for (int i = 0; i < 16; ++i) { s1 += o[ec][i]; s2 += o[ec][i] * o[ec][i]; }
        s1 += __shfl_xor(s1, 32); s2 += __shfl_xor(s2, 32);
        if (h == 0) X[(eh * 4 + ib) * 32 + r] = (f32x2){s1, s2};
        __syncthreads();
#pragma unroll
        for (int ec = 0; ec < 2; ++ec)
#pragma unroll
            for (int g = 0; g < 4; ++g) { u32x2 wv; wv.x = cvtpk(st[ec][4 * g], st[ec][4 * g + 1]); wv.y = cvtpk(st[ec][4 * g + 2], st[ec][4 * g + 3]);
                *(LAS u32x2*)(Timg + off_b(32 * ib + r, 4 * (2 * eh + ec) + g) + 8 * h) = wv; }
        if (!full) continue;
        const f32x2 xo = X[((1 - eh) * 4 + ib) * 32 + r];
        const float mean = (s1 + xo.x) * (1.0f / 128.0f);
        const float var = (s2 + xo.y) * (1.0f / 128.0f) - mean * mean;
        const float rstd = __builtin_amdgcn_rsqf(fmaxf(var, 0.f) + EPS);
        const size_t m = (size_t)(b * PP) + n * 128 + 32 * ib + r;
        const bf16_t* rg = (const bf16_t*)(P.ws + WS_BIG) + m * AB_IN + 1536 + hd * 128;
        bf16_t* op = MIX + m * DM + hd * 128;
#pragma unroll
        for (int ec = 0; ec < 2; ++ec)
#pragma unroll
            for (int g = 0; g < 4; ++g) {
                const int e = 32 * (2 * eh + ec) + 8 * g + 4 * h;
                const u32x2 gr = *(const u32x2*)(rg + e);
                const f32x4 nw = *(const f32x4*)(rn + e);
                float gate[4] = {__uint_as_float(gr.x << 16), __uint_as_float(gr.x & 0xffff0000u), __uint_as_float(gr.y << 16), __uint_as_float(gr.y & 0xffff0000u)};
                float y[4];
#pragma unroll
                for (int j = 0; j < 4; ++j) { const float sg = gate[j] * __builtin_amdgcn_rcpf(1.0f + __builtin_amdgcn_exp2f(-LOG2E * gate[j])); y[j] = (o[ec][4 * g + j] - mean) * rstd * nw[j] * sg; }
                u32x2 wv; wv.x = cvtpk(y[0], y[1]); wv.y = cvtpk(y[2], y[3]);
                *(u32x2*)(op + e) = wv;
            }
    }
}

DI void diffattn_item(const Params& P, LAS unsigned char* lds, int b, int hd, int qb, float lam, const float* kinf) {
    const int tid = threadIdx.x, lane = tid & 63, w = __builtin_amdgcn_readfirstlane(tid >> 6), r = lane & 31, h = lane >> 5, wq = w & 3, mp = w >> 2;
    LAS float* XO = (LAS float*)lds;
    LAS unsigned* flags = (LAS unsigned*)(lds + 131072);
    const bf16_t* proj = (const bf16_t*)(P.ws + WS_BIG) + (size_t)(b * PP) * AB_IN;
    bf16_t* MIX = (bf16_t*)P.out;
    const int qpos = 128 * qb + 32 * wq + r;
    const float slope = __builtin_exp2f(-2.0f * (float)(hd + 1));
    const float c2 = slope * LOG2E;
    bf16x8 qf[4];
    float q1 = 0.f;
    { const bf16_t* qp = proj + (size_t)qpos * AB_IN + 2048 + hd * 128 + mp * 64 + 8 * h;
#pragma unroll
      for (int s = 0; s < 4; ++s) { qf[s] = *(const bf16x8*)(qp + 16 * s);
#pragma unroll
          for (int j = 0; j < 8; ++j) q1 += fabsf(bf2f((unsigned short)qf[s][j])); } }
    q1 += __shfl_xor(q1, 32);
    const float sbound = q1 * kinf[hd * 2 + mp] * 1.01f + 1.0f;
    f32x16 O[4];
#pragma unroll
    for (int c = 0; c < 4; ++c)
#pragma unroll
        for (int i = 0; i < 16; ++i) O[c][i] = 0.f;
    float mrun = -1e30f, lrun = 0.f;
    const int ktop = 2 * qb + 1;
    unsigned vlo0, vhi0; tr_perm_offs(0, lane, vlo0, vhi0);
    const unsigned kof0 = off_b(r, 8 * mp + h);
#define DF_DMA(kt_, slot_) do { LAS unsigned char* nb_ = lds + (slot_) * 32768; \
        tile_dma64_asm(proj + (size_t)(64 * (kt_)) * AB_IN + 2560 + hd * 128, AB_IN, nb_, w, lane); \
        tile_dma64_asm(proj + (size_t)(64 * (kt_)) * AB_IN + 3072 + hd * 128, AB_IN, nb_ + 16384, w, lane); } while (0)
#define DF_QK(Sa, Sb, slot_) do { LAS unsigned char* kb_ = lds + (slot_) * 32768; \
        _Pragma("unroll") for (int i = 0; i < 16; ++i) { Sa[i] = 0.f; Sb[i] = 0.f; } \
        bf16x8 ka_[8]; \
        _Pragma("unroll") for (int s = 0; s < 4; ++s) { ka_[2 * s] = *(LAS const bf16x8*)(kb_ + (kof0 ^ (32u * s))); ka_[2 * s + 1] = *(LAS const bf16x8*)(kb_ + (kof0 ^ (32u * s)) + 8192); } \
        __builtin_amdgcn_sched_barrier(0); \
        _Pragma("unroll") for (int s = 0; s < 4; ++s) { Sa = MFMA32(ka_[2 * s], qf[s], Sa); Sb = MFMA32(ka_[2 * s + 1], qf[s], Sb); } } while (0)
    __syncthreads();
    DF_DMA(ktop, 0); DF_DMA(ktop - 1, 1);
    if (tid < 16) flags[tid] = 0u;
    asm volatile("s_waitcnt vmcnt(0)" ::: "memory");
    __syncthreads();
    f32x16 S0, S1;
    DF_QK(S0, S1, 0);
    int slot = 0;
    bf16x8 pp0 = {0, 0, 0, 0, 0, 0, 0, 0}, pp1 = pp0, pp2 = pp0, pp3 = pp0;
    LAS unsigned char* vprev = lds + 16384;
#define DF_LDV(c_, dst_, Vimg_) do { const unsigned vl_ = vlo0 ^ (64u * (c_)), vh_ = vhi0 ^ (64u * (c_)); \
        dst_[0] = tr_at(Vimg_, vl_, vh_, 0); dst_[1] = tr_at(Vimg_, vl_, vh_, 4096); dst_[2] = tr_at(Vimg_, vl_, vh_, 8192); dst_[3] = tr_at(Vimg_, vl_, vh_, 12288); } while (0)
#define DF_EXP4(S_, b_) do { _Pragma("unroll") for (int i_ = 0; i_ < 4; ++i_) { float e_ = __builtin_amdgcn_exp2f(S_[(b_) + i_] + dl); asm volatile("" : "+v"(e_));   S_[(b_) + i_] = e_; ps += e_; } } while (0)
    for (int kt = ktop; kt >= 0; --kt) {
        asm volatile("s_waitcnt vmcnt(0) lgkmcnt(0)\n\ts_barrier" ::: "memory");
        { LAS const unsigned* fr_ = flags + ((kt + 1) & 1) * 8;
          const u32x4 f0 = *(LAS const u32x4*)fr_, f1 = *(LAS const u32x4*)(fr_ + 4);
          if ((f0.x & f0.y & f0.z & f0.w & f1.x & f1.y & f1.z & f1.w) != 0u) break; }
        const int slot1 = (slot + 1) & 3;
        if (kt >= 2) DF_DMA(kt - 2, (slot + 2) & 3);
        LAS unsigned char* Vimg = lds + slot * 32768 + 16384;
        const bool boundary = (kt >= 2 * qb) || (kt < 2);
        const int k0 = 64 * kt + 4 * h;
        const float u0 = c2 * (float)(k0 - qpos);
        float amax = -3.0e38f;
        if (boundary) {
#pragma unroll
            for (int i = 0; i < 16; ++i) {
                float t0 = fmaf(c2, (float)CROWC(i), S0[i]), t1 = fmaf(c2, (float)(32 + CROWC(i)), S1[i]);
                const int kp = k0 + CROWC(i); if (kp > qpos || kp < NVALID0) t0 = -1e30f; if (kp + 32 > qpos || kp + 32 < NVALID0) t1 = -1e30f;
                S0[i] = t0; S1[i] = t1; amax = fmaxf(amax, fmaxf(t0, t1));
            }
        } else {
#pragma unroll
            for (int i = 0; i < 16; ++i) {
                const float t0 = fmaf(c2, (float)CROWC(i), S0[i]), t1 = fmaf(c2, (float)(32 + CROWC(i)), S1[i]);
                S0[i] = t0; S1[i] = t1; amax = fmaxf(amax, fmaxf(t0, t1));
            }
        }
        amax = fmaxf(amax + u0, -1e30f);
        const float bmax = fmaxf(amax, __shfl_xor(amax, 32));
        const float mold = mrun;
        mrun = fmaxf(mrun, bmax);
        const float dl = u0 - mrun;
        float ps = 0.f;
        {
            bf16x8 va[2][4];
            DF_LDV(0, va[0], vprev);
            DF_LDV(1, va[1], vprev);
            __builtin_amdgcn_sched_barrier(0);
            O[0] = MFMA32(va[0][0], pp0, O[0]); O[0] = MFMA32(va[0][1], pp1, O[0]); O[0] = MFMA32(va[0][2], pp2, O[0]); O[0] = MFMA32(va[0][3], pp3, O[0]);
            DF_EXP4(S0, 0); DF_EXP4(S1, 0);
            __builtin_amdgcn_sched_barrier(0);
            DF_LDV(2, va[0], vprev);
            O[1] = MFMA32(va[1][0], pp0, O[1]); O[1] = MFMA32(va[1][1], pp1, O[1]); O[1] = MFMA32(va[1][2], pp2, O[1]); O[1] = MFMA32(va[1][3], pp3, O[1]);
            DF_EXP4(S0, 4); DF_EXP4(S1, 4);
            __builtin_amdgcn_sched_barrier(0);
            DF_LDV(3, va[1], vprev);
            O[2] = MFMA32(va[0][0], pp0, O[2]); O[2] = MFMA32(va[0][1], pp1, O[2]); O[2] = MFMA32(va[0][2], pp2, O[2]); O[2] = MFMA32(va[0][3], pp3, O[2]);
            DF_EXP4(S0, 8); DF_EXP4(S1, 8);
            __builtin_amdgcn_sched_barrier(0);
            O[3] = MFMA32(va[1][0], pp0, O[3]); O[3] = MFMA32(va[1][1], pp1, O[3]); O[3] = MFMA32(va[1][2], pp2, O[3]); O[3] = MFMA32(va[1][3], pp3, O[3]);
            DF_EXP4(S0, 12); DF_EXP4(S1, 12);
            __builtin_amdgcn_sched_barrier(0);
        }
        if (__any(mrun > mold)) {
            const float al = __builtin_amdgcn_exp2f(mold - mrun);
            lrun *= al;
#pragma unroll
            for (int c = 0; c < 4; ++c)
#pragma unroll
                for (int i = 0; i < 16; ++i) O[c][i] *= al;
        }
        lrun += ps;
        pp0 = pack8(S0[0], S0[1], S0[2], S0[3], S0[4], S0[5], S0[6], S0[7]); pp1 = pack8(S0[8], S0[9], S0[10], S0[11], S0[12], S0[13], S0[14], S0[15]);
        pp2 = pack8(S1[0], S1[1], S1[2], S1[3], S1[4], S1[5], S1[6], S1[7]); pp3 = pack8(S1[8], S1[9], S1[10], S1[11], S1[12], S1[13], S1[14], S1[15]);
        vprev = Vimg;
        const bool okw = __all(sbound + c2 * (float)(64 * kt - 1 - qpos) - mrun < -150.0f);
        if (lane == 0) flags[(kt & 1) * 8 + w] = okw ? 1u : 0u;
        if (kt >= 1) DF_QK(S0, S1, slot1);
        slot = slot1;
    }
    {
        bf16x8 va[2][4];
        DF_LDV(0, va[0], vprev);
#pragma unroll
        for (int c = 0; c < 4; ++c) { if (c < 3) DF_LDV(c + 1, va[(c + 1) & 1], vprev); __builtin_amdgcn_sched_barrier(0);
            O[c] = MFMA32(va[c & 1][0], pp0, O[c]); O[c] = MFMA32(va[c & 1][1], pp1, O[c]); O[c] = MFMA32(va[c & 1][2], pp2, O[c]); O[c] = MFMA32(va[c & 1][3], pp3, O[c]);
            __builtin_amdgcn_sched_barrier(0); }
    }
#undef DF_EXP4
#undef DF_LDV
#undef DF_DMA
#undef DF_QK
    asm volatile("s_waitcnt vmcnt(0)" ::: "memory");
    __syncthreads();
    lrun += __shfl_xor(lrun, 32);
    const float inv = 1.0f / lrun;
    if (mp == 1) {
#pragma unroll
        for (int c = 0; c < 4; ++c)
#pragma unroll
            for (int i = 0; i < 16; ++i) XO[(wq * 64 + c * 16 + i) * 64 + lane] = O[c][i] * inv;
    }
    __syncthreads();
    if (mp == 0) {
        float ss = 0.f;
#pragma unroll
        for (int c = 0; c < 4; ++c)
#pragma unroll
            for (int i = 0; i < 16; ++i) { const float d = O[c][i] * inv - lam * XO[(wq * 64 + c * 16 + i) * 64 + lane]; O[c][i] = d; ss += d * d; }
        ss += __shfl_xor(ss, 32);
        const float rs = __builtin_amdgcn_rsqf(ss * (1.0f / 128.0f) + EPS) * 0.8f;
        const float* dn = P.ab_diff_norm + hd * 128;
        bf16_t* op = MIX + (size_t)(b * PP + qpos) * DM + 512 + hd * 128;
#pragma unroll
        for (int c = 0; c < 4; ++c)
#pragma unroll
            for (int g = 0; g < 4; ++g) {
                const int e = 32 * c + 8 * g + 4 * h;
                const f32x4 nw = *(const f32x4*)(dn + e);
                u32x2 wv; wv.x = cvtpk(O[c][4 * g] * rs * nw[0], O[c][4 * g + 1] * rs * nw[1]); wv.y = cvtpk(O[c][4 * g + 2] * rs * nw[2], O[c][4 * g + 3] * rs * nw[3]);
                *(u32x2*)(op + e) = wv;
            }
    }
}

DI void sb_block(f32x16& S, float& C, int k0, int qpos, int h, bool boundary) {
    float L[16]; float seg[4];
#pragma unroll
    for (int g = 0; g < 4; ++g) seg[g] = 0.f;
#pragma unroll
    for (int i = 0; i < 16; ++i) {
        const float z = S[i];
        const float e = __builtin_amdgcn_exp2f(-fabsf(z));
        const float sp = fmaxf(z, 0.f) + __builtin_amdgcn_logf(1.0f + e);
        bool ok = true;
        if (boundary) { const int kp = k0 + CROWC(i); ok = (kp < qpos) && (kp >= NVALID0); }
        L[i] = ok ? -sp : 0.f;
        S[i] = ok ? (z - sp) : -1e30f;
        seg[i >> 2] += L[i];
    }
    float oseg[4];
#pragma unroll
    for (int g = 0; g < 4; ++g) oseg[g] = __shfl_xor(seg[g], 32);
    float R = 0.f;
#pragma unroll
    for (int gi = 0; gi < 4; ++gi) {
        const int g = 3 - gi;
        float lat = C + R + (h == 0 ? oseg[g] : 0.f);
        S[4 * g + 3] = __builtin_amdgcn_exp2f(S[4 * g + 3] + lat); lat += L[4 * g + 3];
        S[4 * g + 2] = __builtin_amdgcn_exp2f(S[4 * g + 2] + lat); lat += L[4 * g + 2];
        S[4 * g + 1] = __builtin_amdgcn_exp2f(S[4 * g + 1] + lat); lat += L[4 * g + 1];
        S[4 * g + 0] = __builtin_amdgcn_exp2f(S[4 * g + 0] + lat);
        R += seg[g] + oseg[g];
    }
    C += R;
}
DI void stickbreak_item(const Params& P, LAS unsigned char* lds, int b, int hp, int qb) {
    const int tid = threadIdx.x, lane = tid & 63, w = __builtin_amdgcn_readfirstlane(tid >> 6), r = lane & 31, h = lane >> 5, wq = w & 3, hs = w >> 2;
    const int hd = 2 * hp + hs;
    LAS unsigned* flags = (LAS unsigned*)(lds + 131072);
    const bf16_t* proj = (const bf16_t*)(P.ws + WS_BIG) + (size_t)(b * PP) * C_IN;
    bf16_t* MIX = (bf16_t*)P.out;
    const int qpos = 128 * qb + 32 * wq + r;
    bf16x8 qf[8];
    { const bf16_t* qp = proj + (size_t)qpos * C_IN + hd * 128 + 8 * h;
#pragma unroll
      for (int s = 0; s < 8; ++s) qf[s] = *(const bf16x8*)(qp + 16 * s); }
    f32x16 O[4];
#pragma unroll
    for (int c = 0; c < 4; ++c)
#pragma unroll
        for (int i = 0; i < 16; ++i) O[c][i] = 0.f;
    float C = 0.f;
    const int ktop = 2 * qb + 1;
    unsigned vlo0, vhi0; tr_perm_offs(0, lane, vlo0, vhi0);
    const unsigned kof0 = off_b(r, h);
    __syncthreads();
#define SB_DMA(kt_, base_) do { const bf16_t* s_ = proj + (size_t)(64 * (kt_)) * C_IN + hp * 256; \
        tile_dma64_asm(s_ + 1024, C_IN, (base_), w, lane); tile_dma64_asm(s_ + 1024 + 128, C_IN, (base_) + 16384, w, lane); \
        tile_dma64_asm(s_ + 2048, C_IN, (base_) + 32768, w, lane); tile_dma64_asm(s_ + 2048 + 128, C_IN, (base_) + 49152, w, lane); } while (0)
    SB_DMA(ktop, lds);
    if (tid < 16) flags[tid] = 0u;
    int cur = 0;
    for (int kt = ktop; kt >= 0; --kt) {
        asm volatile("s_waitcnt vmcnt(0)" ::: "memory");
        __syncthreads();
        { LAS const unsigned* fr_ = flags + ((kt + 1) & 1) * 8;
          const u32x4 f0 = *(LAS const u32x4*)fr_, f1 = *(LAS const u32x4*)(fr_ + 4);
          if ((f0.x & f0.y & f0.z & f0.w & f1.x & f1.y & f1.z & f1.w) != 0u) break; }
        LAS unsigned char* Kimg = lds + cur * 65536 + hs * 16384; LAS unsigned char* Vimg = Kimg + 32768;
        if (kt > 0) SB_DMA(kt - 1, lds + (cur ^ 1) * 65536);
        cur ^= 1;
        const bool boundary = (kt >= 2 * qb) || (kt < 2);
        const bool skip = (64 * kt >= 128 * qb + 32 * wq + 32);
        if (!skip) {
            f32x16 S0, S1;
#pragma unroll
            for (int i = 0; i < 16; ++i) { S0[i] = 0.f; S1[i] = 0.f; }
#pragma unroll
            for (int s = 0; s < 8; ++s) { const bf16x8 a0 = *(LAS const bf16x8*)(Kimg + (kof0 ^ (32u * s))), a1 = *(LAS const bf16x8*)(Kimg + (kof0 ^ (32u * s)) + 8192);
                S0 = MFMA32(a0, qf[s], S0); S1 = MFMA32(a1, qf[s], S1); }
            sb_block(S1, C, 64 * kt + 32 + 4 * h, qpos, h, boundary);
            sb_block(S0, C, 64 * kt + 4 * h, qpos, h, boundary);
            const bf16x8 p0 = pack8(S0[0], S0[1], S0[2], S0[3], S0[4], S0[5], S0[6], S0[7]), p1 = pack8(S0[8], S0[9], S0[10], S0[11], S0[12], S0[13], S0[14], S0[15]);
            const bf16x8 p2 = pack8(S1[0], S1[1], S1[2], S1[3], S1[4], S1[5], S1[6], S1[7]), p3 = pack8(S1[8], S1[9], S1[10], S1[11], S1[12], S1[13], S1[14], S1[15]);
#pragma unroll
            for (int c = 0; c < 4; ++c) {
                const unsigned vl = vlo0 ^ (64u * c), vh = vhi0 ^ (64u * c);
                const bf16x8 a0 = tr_at(Vimg, vl, vh, 0), a1 = tr_at(Vimg, vl, vh, 4096), a2 = tr_at(Vimg, vl, vh, 8192), a3 = tr_at(Vimg, vl, vh, 12288);
                O[c] = MFMA32(a0, p0, O[c]); O[c] = MFMA32(a1, p1, O[c]); O[c] = MFMA32(a2, p2, O[c]); O[c] = MFMA32(a3, p3, O[c]);
            }
        }
        const bool okw = __all(C < -160.0f);
        if (lane == 0) flags[(kt & 1) * 8 + w] = okw ? 1u : 0u;
    }
#undef SB_DMA
    bf16_t* op = MIX + (size_t)(b * PP + qpos) * DM + hd * 128;
#pragma unroll
    for (int c = 0; c < 4; ++c)
#pragma unroll
        for (int g = 0; g < 4; ++g) {
            const int e = 32 * c + 8 * g + 4 * h;
            u32x2 wv; wv.x = cvtpk(O[c][4 * g], O[c][4 * g + 1]); wv.y = cvtpk(O[c][4 * g + 2], O[c][4 * g + 3]);
            *(u32x2*)(op + e) = wv;
        }
}

DI unsigned f2bf(float f) { unsigned u = __builtin_bit_cast(unsigned, f); return (u + 0x7fffu + ((u >> 16) & 1u)) >> 16; }
DI unsigned pk2(float lo, float hi) { return f2bf(lo) | (f2bf(hi) << 16); }
DI void transpose_item(const float* W, int K, int N, bf16_t* WT, bool ffn_perm, LAS float* scr, int item, int lane, const float* kgain = nullptr) {
    const int nblk = N / 32, kb = item / nblk, nb = item % nblk, k0 = 64 * kb, n0 = 32 * nb;
#pragma unroll 8
    for (int i = 0; i < 32; ++i) { const int kk = 2 * i + (lane >> 5); const float gk = kgain ? kgain[k0 + kk] : 1.0f; scr[kk * 33 + (lane & 31)] = W[(size_t)(k0 + kk) * N + n0 + (lane & 31)] * gk; }
    asm volatile("s_waitcnt lgkmcnt(0)" ::: "memory");
    const int c = lane & 7;
#pragma unroll
    for (int j = 0; j < 4; ++j) { const int n = (lane >> 3) + 8 * j; const LAS float* s = scr + (8 * c) * 33 + n;
        u32x4 o; o.x = pk2(s[0 * 33], s[1 * 33]); o.y = pk2(s[2 * 33], s[3 * 33]); o.z = pk2(s[4 * 33], s[5 * 33]); o.w = pk2(s[6 * 33], s[7 * 33]);
        int col = n0 + n, drow = col;
        if (ffn_perm) { const int isval = col >= DFF; const int cc = isval ? col - DFF : col; drow = (cc >> 7) * 256 + isval * 128 + (cc & 127); }
        *(u32x4*)(WT + (size_t)drow * K + k0 + 8 * c) = o; }
    asm volatile("s_waitcnt lgkmcnt(0)" ::: "memory");
}
DI void norm_store_bf16(const f32x4 (&v)[4], const float* gain, bf16_t* orow, int lane) {
    float s = 0.f;
#pragma unroll
    for (int j = 0; j < 4; ++j) s += (v[j].x * v[j].x + v[j].y * v[j].y) + (v[j].z * v[j].z + v[j].w * v[j].w);
    const float rstd = __builtin_amdgcn_rsqf(wave_sum(s) * (1.0f / DM) + EPS);
#pragma unroll
    for (int j = 0; j < 4; ++j) { const f32x4 g = *(const f32x4*)(gain + 4 * lane + 256 * j);
        u32x2 wv; wv.x = cvtpk(v[j].x * rstd * g.x, v[j].y * rstd * g.y); wv.y = cvtpk(v[j].z * rstd * g.z, v[j].w * rstd * g.w);
        *(u32x2*)(orow + 4 * lane + 256 * j) = wv; }
}

#ifdef NO_RET
#define RET_CALL
#else
#define RET_CALL retention_item(P, lds, (it & 31) >> 2, it & 3, (it < 32) ? 36 : 0, (it < 32) ? 65 : 36);
#endif
#ifdef NO_DIFF
#define DIFF_CALL
#else
#define DIFF_CALL diffattn_item(P, lds, bh >> 2, bh & 3, 64 - (j >> 5), lam, (const float*)(ctl + 16));
#endif
#ifdef NO_SB
#define SB_CALL
#else
#define SB_CALL stickbreak_item(P, lds, bh >> 2, bh & 3, 64 - (it >> 5));
#endif
constexpr int I_OUT = (DM / 64) * (DM / 32), I_UP = (DM / 64) * (2 * DFF / 32), I_DN = (DFF / 64) * (DM / 32), I_IN1 = (DM / 64) * (C_IN / 32);
DI void deferred_convert(const Params& P, LAS unsigned char* lds, unsigned* ctr, int group, int wave, int lane) {
    LAS float* scr = (LAS float*)(lds + wave * 16384);
    const int total = group == 0 ? (I_OUT + I_UP + I_DN) : (I_IN1 + I_OUT + I_UP + I_DN);
    for (;;) {
        int it = 0; if (lane == 0) it = (int)atomicAdd(ctr, 1u);
        it = __builtin_amdgcn_readfirstlane(it);
        if (it >= total) break;
        int q = it;
        if (group == 0) {
            if (q < I_UP) { transpose_item(P.ffn_up, DM, 2 * DFF, (bf16_t*)(P.ws + WS_WUP0), true, scr, q, lane, P.ffn_norm); continue; } q -= I_UP;
            if (q < I_DN) { transpose_item(P.ffn_down, DFF, DM, (bf16_t*)(P.ws + WS_WDN0), false, scr, q, lane); continue; } q -= I_DN;
            transpose_item(P.ab_w_out, DM, DM, (bf16_t*)(P.ws + WS_WOUT0), false, scr, q, lane);
        } else {
            if (q < I_UP) { transpose_item(P.ffn_up + (size_t)DM * 2 * DFF, DM, 2 * DFF, (bf16_t*)(P.ws + WS_WUP1), true, scr, q, lane, P.ffn_norm + DM); continue; } q -= I_UP;
            if (q < I_DN) { transpose_item(P.ffn_down + (size_t)DFF * DM, DFF, DM, (bf16_t*)(P.ws + WS_WDN1), false, scr, q, lane); continue; } q -= I_DN;
            if (q < I_IN1) { transpose_item(P.c_w_in, DM, C_IN, (bf16_t*)(P.ws + WS_WIN1), false, scr, q, lane, P.mix_norm + DM); continue; } q -= I_IN1;
            transpose_item(P.c_w_out, DM, DM, (bf16_t*)(P.ws + WS_WOUT1), false, scr, q, lane);
        }
    }
}


#define XB_TMO      128
#define XB_XCNT(j)  (256  + 64 * (j))
#define XB_XSUB(j)  (1280 + 64 * (j))
#define XB_XGEN(j)  (2304 + 64 * (j))
#define XB_TOP      3328
#define XB_TOPGEN   3392
#define XCD_BAR_WORDS 3456
#define XB_SPIN_CAP (1u << 18)

__device__ __forceinline__ unsigned xb_ld(unsigned* p)              { return __hip_atomic_load(p, __ATOMIC_RELAXED, __HIP_MEMORY_SCOPE_AGENT); }
__device__ __forceinline__ unsigned xb_add(unsigned* p, unsigned v) { return __hip_atomic_fetch_add(p, v, __ATOMIC_RELAXED, __HIP_MEMORY_SCOPE_AGENT); }
__device__ __forceinline__ unsigned xb_xcc_id() { return (unsigned)__builtin_amdgcn_s_getreg((3 << 11) | 20) & 0xFu; }
#define XB_SPIN(cond, bar) do { unsigned _sp = 0; while (cond) { __builtin_amdgcn_s_sleep(1); \
    if ((++_sp & 255u) == 0u) { if (xb_ld(&(bar)[XB_TMO])) break; if (_sp > XB_SPIN_CAP) { atomicAdd(&(bar)[XB_TMO], 1u); break; } } } } while (0)

struct XcdBarrier {
    unsigned* bar; unsigned x;
    volatile LAS unsigned* st;
};

__device__ __forceinline__ XcdBarrier xcd_barrier_post(unsigned* bar, volatile LAS unsigned* st) {
    XcdBarrier b; b.bar = bar; b.x = xb_xcc_id(); b.st = st;
    if (threadIdx.x == 0) (void)xb_add(&bar[XB_XCNT(b.x)], 1u);
    return b;
}
__device__ __forceinline__ void xcd_barrier_complete(unsigned* bar, unsigned x, unsigned& nloc, unsigned& nx) {
    const unsigned G = gridDim.x * gridDim.y * gridDim.z;
    unsigned sum, cnt, mine, sp = 0u;
    for (;;) {
        sum = 0u; cnt = 0u; mine = 0u;
#pragma unroll
        for (unsigned j = 0; j < 16; ++j) { const unsigned c = xb_ld(&bar[XB_XCNT(j)]); sum += c; cnt += (c > 0u) ? 1u : 0u; mine = (j == x) ? c : mine; }
        if (sum == G) break;
        __builtin_amdgcn_s_sleep(1);
        if ((++sp & 255u) == 0u) { if (xb_ld(&bar[XB_TMO])) break; if (sp > XB_SPIN_CAP) { atomicAdd(&bar[XB_TMO], 1u); break; } }
    }
    nloc = mine > 0u ? mine : 1u; nx = cnt > 0u ? cnt : 1u;
}

__device__ __forceinline__ void xcd_barrier(const XcdBarrier& b) {
    asm volatile("s_waitcnt vmcnt(0)" ::: "memory");
    __syncthreads();
    if (threadIdx.x == 0) {
        unsigned* bar = b.bar;
        __builtin_amdgcn_s_waitcnt(0);
        unsigned nloc = b.st[0], nx = b.st[1];
        if (nloc == 0u) { xcd_barrier_complete(bar, b.x, nloc, nx); b.st[0] = nloc; b.st[1] = nx; }
        const unsigned old = xb_add(&bar[XB_XSUB(b.x)], 1u);
        const unsigned gen = old / nloc;
        if (old + 1u == (gen + 1u) * nloc) {
            __builtin_amdgcn_fence(__ATOMIC_RELEASE, "agent");
            asm volatile("s_waitcnt vmcnt(0)" ::: "memory");
            const unsigned og = xb_add(&bar[XB_TOP], 1u);
            const unsigned tg = og / nx;
            if (og + 1u == (tg + 1u) * nx) xb_add(&bar[XB_TOPGEN], 1u);
            else XB_SPIN(xb_ld(&bar[XB_TOPGEN]) == tg, bar);
            __builtin_amdgcn_fence(__ATOMIC_ACQUIRE, "agent");
            xb_add(&bar[XB_XGEN(b.x)], 1u);
            asm volatile("s_waitcnt vmcnt(0)" ::: "memory");
        } else {
            XB_SPIN(xb_ld(&bar[XB_XGEN(b.x)]) == gen, bar);
            __builtin_amdgcn_fence(__ATOMIC_ACQUIRE, "agent");
            asm volatile("s_waitcnt vmcnt(0)" ::: "memory");
        }
    }
    __syncthreads();
}


#ifndef DUP_MASK
#define DUP_MASK 0
#endif
#define NREP(k) (1 + ((DUP_MASK >> (k)) & 1))
constexpr int LDS_BYTES = 147456;
constexpr int NPHASES = 12;

__global__ void __launch_bounds__(NTHREADS, 2) fwd_megakernel(Params P) {
    extern __shared__ __attribute__((aligned(16))) unsigned char lds_raw[];
    LAS unsigned char* lds = (LAS unsigned char*)lds_raw;
    cg::grid_group grid = cg::this_grid();
    const int tid = threadIdx.x, lane = tid & 63, wave = __builtin_amdgcn_readfirstlane(tid >> 6);
    const int G = gridDim.x, gw = blockIdx.x * 8 + wave, NGW = G * 8;
    unsigned* ctl = (unsigned*)(P.ws + WS_CTL);
    bf16_t* Y = (bf16_t*)(P.ws + WS_Y);
    float* H = (float*)(P.ws + WS_H);
    bf16_t* BIG = (bf16_t*)(P.ws + WS_BIG);
    const int lo = P.ph_lo, hi = P.ph_hi;
#define IN(k) (lo <= (k) && (k) < hi)
#define SEAM(k) do { if (IN(k) && IN((k) + 1)) xcd_barrier(xbar); } while (0)

    if (IN(0)) {
        if (blockIdx.x == 0) { if (tid < 64) ctl[tid] = 0u; for (int i = tid; i < XCD_BAR_WORDS; i += NTHREADS) ctl[1024 + i] = 0u; }
        { float* rz = (float*)(P.ws + WS_RSQ); for (int i = blockIdx.x * NTHREADS + tid; i < 4 * MROWS; i += G * NTHREADS) rz[i] = 0.f; }
        LAS float* scr = (LAS float*)(lds + wave * 16384);
        constexpr int I_IN0 = (DM / 64) * (AB_IN / 32);
        for (int it = gw; it < I_IN0; it += NGW) transpose_item(P.ab_w_in, DM, AB_IN, (bf16_t*)(P.ws + WS_WIN0), false, scr, it, lane);
        for (int m = gw; m < MROWS; m += NGW) {
            const int b = m / PP, p = m % PP;
            f32x4 v[4];
            if (p < NVALID0) {
#pragma unroll
                for (int j = 0; j < 4; ++j) v[j] = (f32x4){0.f, 0.f, 0.f, 0.f};
            } else {
                const float* src = (p < BLK) ? P.meta + (size_t)(p - NVALID0) * DM : P.x + ((size_t)b * SEQ + (p - BLK)) * DM;
#pragma unroll
                for (int j = 0; j < 4; ++j) v[j] = *(const f32x4*)(src + 4 * lane + 256 * j);
            }
            norm_store_bf16(v, P.mix_norm, Y + (size_t)m * DM, lane);
        }
    }
    XcdBarrier xbar; xbar.bar = ctl + 1024; xbar.x = 0; xbar.st = (volatile LAS unsigned*)(lds + 147456 - 32);
    if (IN(0) && IN(1)) {
        grid.sync();
        if (tid == 0) { xbar.st[0] = 0u; xbar.st[1] = 0u; }
        __syncthreads();
        xbar = xcd_barrier_post(ctl + 1024, (volatile LAS unsigned*)(lds + 147456 - 32));
    }
    float* RSQ = (float*)(P.ws + WS_RSQ);
    bf16_t* MIXB = (bf16_t*)P.out;
    if (IN(1)) {
        pg8::Gemm g{Y, (const bf16_t*)(P.ws + WS_WIN0), DM, 256}; pg8::StaticOrder S; S.init(MROWS / 256, AB_IN / 256, G, (int)blockIdx.x);
        EpiProj<0> E{BIG, AB_IN, nullptr, ctl + 16};
        for (int rep = 0; rep < NREP(1); ++rep) pg8::gemm_phase(lds, g, S, E);
        deferred_convert(P, lds, ctl + 8, 0, wave, lane);
    }
    SEAM(1);
    if (IN(2)) {
        float d1 = 0.f, d2 = 0.f;
        for (int i = 0; i < 64; ++i) { d1 += P.lq1[i] * P.lk1[i]; d2 += P.lq2[i] * P.lk2[i]; }
        const float lam = __expf(d1) - __expf(d2) + 0.2f;
        LAS int* itm = (LAS int*)(lds + 147456 - 64);
        for (int rep = 0; rep < NREP(2); ++rep) {
#define FETCH_ITEM(dst) do { __syncthreads(); if (tid == 0) itm[0] = (int)atomicAdd(&ctl[0 + 4 * rep], 1u); __syncthreads(); dst = itm[0]; } while (0)
            int it; FETCH_ITEM(it);
#ifdef PROBE_P2
            while (it < 128) { const int itq = it; { const int it = itq & 63; RET_CALL } FETCH_ITEM(it); }
            while (it < 128 + 2 * 32 * 65) { const int j = (it - 128) % (32 * 65); const int bh = j & 31; DIFF_CALL FETCH_ITEM(it); }
#else
            while (it < 64) { RET_CALL FETCH_ITEM(it); }
            while (it < 64 + 32 * 65) { const int j = it - 64; const int bh = j & 31; DIFF_CALL FETCH_ITEM(it); }
#endif
#undef FETCH_ITEM
        }
    }
    SEAM(2);
    if (IN(3)) {
        pg8::Gemm g{MIXB, (const bf16_t*)(P.ws + WS_WOUT0), DM, 256}; pg8::StaticOrder S; S.init(MROWS / 256, DM / 256, G, (int)blockIdx.x);
        EpiResidual<0> E{Y, nullptr, RSQ, P.x, P.meta};
        pg8::gemm_phase(lds, g, S, E);
    }
    SEAM(3);
    if (IN(4)) {
        pg8::Gemm g{Y - 2 * DM, (const bf16_t*)(P.ws + WS_WUP0), DM, 254}; pg8::StaticOrder S; S.init((MROWS + 253) / 254, DFF / 128, G, (int)blockIdx.x);
        EpiFfnUp E{BIG, P.ffn_conv, P.ffn_conv_b, RSQ};
        for (int rep = 0; rep < NREP(4); ++rep) pg8::gemm_phase(lds, g, S, E);
    }
    SEAM(4);
    if (IN(5)) {
        pg8::Gemm g{BIG, (const bf16_t*)(P.ws + WS_WDN0), DFF, 256}; pg8::StaticOrder S; S.init(MROWS / 256, DM / 256, G, (int)blockIdx.x);
        EpiResidual<1> E{Y, nullptr, RSQ + MROWS, nullptr, nullptr};
        pg8::gemm_phase(lds, g, S, E);
        deferred_convert(P, lds, ctl + 9, 1, wave, lane);
    }
    SEAM(5);
    if (IN(6)) {
        pg8::Gemm g{Y, (const bf16_t*)(P.ws + WS_WIN1), DM, 256}; pg8::StaticOrder S; S.init(MROWS / 256, C_IN / 256, G, (int)blockIdx.x);
        EpiProj<1> E{BIG, C_IN, RSQ + MROWS, nullptr};
        pg8::gemm_phase(lds, g, S, E);
    }
    SEAM(6);
    if (IN(7)) {
        LAS int* itm = (LAS int*)(lds + 147456 - 64);
        for (int rep = 0; rep < NREP(7); ++rep)
        for (;;) {
            __syncthreads();
            if (tid == 0) itm[0] = (int)atomicAdd(&ctl[1 + 4 * rep], 1u);
            __syncthreads();
            const int it = itm[0];
            if (it >= 32 * 65) break;
            const int bh = it & 31;
            SB_CALL
        }
    }
    SEAM(7);
    if (IN(8)) {
        pg8::Gemm g{MIXB, (const bf16_t*)(P.ws + WS_WOUT1), DM, 256}; pg8::StaticOrder S; S.init(MROWS / 256, DM / 256, G, (int)blockIdx.x);
        EpiResidual<1> E{Y, nullptr, RSQ + 2 * MROWS, nullptr, nullptr};
        pg8::gemm_phase(lds, g, S, E);
    }
    SEAM(8);
    if (IN(9)) {
        pg8::Gemm g{Y - 2 * DM, (const bf16_t*)(P.ws + WS_WUP1), DM, 254}; pg8::StaticOrder S; S.init((MROWS + 253) / 254, DFF / 128, G, (int)blockIdx.x);
        EpiFfnUp E{BIG, P.ffn_conv + 3 * DFF, P.ffn_conv_b + DFF, RSQ + 2 * MROWS};
        pg8::gemm_phase(lds, g, S, E);
    }
    SEAM(9);
    if (IN(10)) {
        pg8::Gemm g{BIG, (const bf16_t*)(P.ws + WS_WDN1), DFF, 256}; pg8::StaticOrder S; S.init(MROWS / 256, DM / 256, G, (int)blockIdx.x);
        EpiResidual<1> E{Y, nullptr, RSQ + 3 * MROWS, nullptr, nullptr};
        pg8::gemm_phase(lds, g, S, E);
    }
    SEAM(10);
    if (IN(11)) {
        for (int mo = gw; mo < BATCH * SEQ; mo += NGW) {
            const int b = mo / SEQ, sq = mo % SEQ; const size_t m = (size_t)b * PP + BLK + sq;
            const float rstd = __builtin_amdgcn_rsqf(RSQ[3 * MROWS + m] * (1.0f / DM) + EPS);
#pragma unroll
            for (int j = 0; j < 4; ++j) { const u32x2 q = *(const u32x2*)(Y + m * DM + 4 * lane + 256 * j); const f32x4 g = *(const f32x4*)(P.final_norm + 4 * lane + 256 * j);
                const f32x4 v = (f32x4){__uint_as_float(q.x << 16), __uint_as_float(q.x & 0xffff0000u), __uint_as_float(q.y << 16), __uint_as_float(q.y & 0xffff0000u)};
                *(f32x4*)(P.out + (size_t)mo * DM + 4 * lane + 256 * j) = v * rstd * g; }
        }
    }
#undef IN
#undef SEAM
#undef NORM_PHASE
}

#ifndef MK_ONE_LAUNCH
#define MK_ONE_LAUNCH 1
#endif
extern "C" void kernel_launch(void* const* d_in, const int* in_sizes, int n_in, void* d_out, int out_size, void* d_ws, size_t ws_size, hipStream_t stream) {
    static int grid = 0;
    if (grid == 0) {
        if (n_in != 19 || ws_size < WS_END) { fprintf(stderr, "kernel_launch: unexpected n_in %d or ws_size %zu (need %zu)\n", n_in, ws_size, (size_t)WS_END); grid = -1; return; }
        int dev = 0, cus = 0, per_cu = 0;
        hipGetDevice(&dev); hipDeviceGetAttribute(&cus, hipDeviceAttributeMultiprocessorCount, dev);
        if (hipFuncSetAttribute((const void*)fwd_megakernel, hipFuncAttributeMaxDynamicSharedMemorySize, LDS_BYTES) != hipSuccess) { fprintf(stderr, "kernel_launch: hipFuncSetAttribute failed\n"); grid = -1; return; }
        if (hipOccupancyMaxActiveBlocksPerMultiprocessor(&per_cu, (const void*)fwd_megakernel, NTHREADS, LDS_BYTES) != hipSuccess || per_cu < 1) { fprintf(stderr, "kernel_launch: occupancy query says %d\n", per_cu); per_cu = 1; }
        (void)hipGetLastError();
        grid = cus * 1;
        if (grid <= 0) grid = 256;
    }
    if (grid < 0) return;
    Params p{};
    p.x = (const float*)d_in[0]; p.meta = (const float*)d_in[1]; p.mix_norm = (const float*)d_in[2]; p.ffn_norm = (const float*)d_in[3];
    p.ffn_up = (const float*)d_in[4]; p.ffn_conv = (const float*)d_in[5]; p.ffn_conv_b = (const float*)d_in[6]; p.ffn_down = (const float*)d_in[7];
    p.ab_w_in = (const float*)d_in[8]; p.ab_ret_norm = (const float*)d_in[9]; p.ab_diff_norm = (const float*)d_in[10];
    p.lq1 = (const float*)d_in[11]; p.lk1 = (const float*)d_in[12]; p.lq2 = (const float*)d_in[13]; p.lk2 = (const float*)d_in[14]; p.ab_w_out = (const float*)d_in[15];
    p.c_w_in = (const float*)d_in[16]; p.c_w_out = (const float*)d_in[17]; p.final_norm = (const float*)d_in[18];
    p.out = (float*)d_out; p.ws = (unsigned char*)d_ws;
#if MK_ONE_LAUNCH
    p.ph_lo = 0; p.ph_hi = NPHASES;
    void* args[] = {&p};
    hipError_t e = hipLaunchCooperativeKernel((const void*)fwd_megakernel, dim3(grid), dim3(NTHREADS), args, LDS_BYTES, stream);
    if (e != hipSuccess) fprintf(stderr, "cooperative launch failed: %s (grid %d)\n", hipGetErrorString(e), grid);
#else
    for (int ph = 0; ph < NPHASES; ++ph) {
        p.ph_lo = ph; p.ph_hi = ph + 1;
        hipLaunchKernelGGL(fwd_megakernel, dim3(grid), dim3(NTHREADS), LDS_BYTES, stream, p);
    }
#endif
}
```

```cpp
#include <hip/hip_runtime.h>
#include <hip/hip_cooperative_groups.h>
#include <cstdio>
#include <cstdint>
namespace cg = cooperative_groups;

#define LAS __attribute__((address_space(3)))
#define DI __device__ __forceinline__
typedef unsigned short bf16_t;
typedef short bf16x8 __attribute__((ext_vector_type(8)));
typedef short s16x4 __attribute__((ext_vector_type(4)));
typedef float f32x2 __attribute__((ext_vector_type(2)));
typedef float f32x4 __attribute__((ext_vector_type(4)));
typedef float f32x16 __attribute__((ext_vector_type(16)));
typedef unsigned u32x2 __attribute__((ext_vector_type(2)));
typedef unsigned u32x4 __attribute__((ext_vector_type(4)));
typedef __bf16 bf16x2_t __attribute__((ext_vector_type(2)));

constexpr int BATCH = 8, SEQ = 8192, DM = 1024, BLK = 128, NMETA = 16;
constexpr int PP = SEQ + BLK;
constexpr int MROWS = BATCH * PP;
constexpr int NVALID0 = BLK - NMETA;
constexpr int DFF = 2816;
constexpr int AB_IN = 3584, C_IN = 3072;
constexpr float EPS = 1e-6f;
constexpr float LOG2E = 1.4426950408889634f;
constexpr int NTHREADS = 512;

constexpr size_t MiB = 1u << 20;
constexpr size_t WS_CTL = 0;
constexpr size_t WS_WIN0 = 1 * MiB, WS_WOUT0 = 8 * MiB, WS_WUP0 = 10 * MiB, WS_WDN0 = 21 * MiB;
constexpr size_t WS_WIN1 = 27 * MiB, WS_WOUT1 = 33 * MiB, WS_WUP1 = 35 * MiB, WS_WDN1 = 46 * MiB;
constexpr size_t WS_YPAD = 52 * MiB;
constexpr size_t WS_Y = WS_YPAD + 2 * 2048;
constexpr size_t WS_H = 184 * MiB;
constexpr size_t WS_BIG = 444 * MiB;
constexpr size_t WS_RSQ = 899 * MiB;
constexpr size_t WS_END = 901 * MiB;

struct Params {
    const float* x; const float* meta; const float* mix_norm; const float* ffn_norm;
    const float* ffn_up; const float* ffn_conv; const float* ffn_conv_b; const float* ffn_down;
    const float* ab_w_in; const float* ab_ret_norm; const float* ab_diff_norm;
    const float* lq1; const float* lk1; const float* lq2; const float* lk2; const float* ab_w_out;
    const float* c_w_in; const float* c_w_out; const float* final_norm;
    float* out; unsigned char* ws; int ph_lo, ph_hi;
};

DI unsigned cvtpk(float lo, float hi) { f32x2 v = {lo, hi}; bf16x2_t b = __builtin_convertvector(v, bf16x2_t); return __builtin_bit_cast(unsigned, b); }
DI float bf2f(unsigned short u) { return __uint_as_float(((unsigned)u) << 16); }
DI bf16x8 pack8(float a0, float a1, float a2, float a3, float a4, float a5, float a6, float a7) {
    u32x4 p; p.x = cvtpk(a0, a1); p.y = cvtpk(a2, a3); p.z = cvtpk(a4, a5); p.w = cvtpk(a6, a7); return __builtin_bit_cast(bf16x8, p);
}
#define MFMA32(a, b, c) __builtin_amdgcn_mfma_f32_32x32x16_bf16((a), (b), (c), 0, 0, 0)
DI float wave_sum(float v) {
#pragma unroll
    for (int o = 1; o < 64; o <<= 1) v += __shfl_xor(v, o);
    return v;
}
DI unsigned off_b(unsigned row, unsigned ch) { return 256u * row + 16u * (ch ^ (((row & 3u) << 2) | ((row >> 2) & 3u))); }
typedef short v4i16_t __attribute__((ext_vector_type(4)));
DI s16x4 trread(LAS const unsigned char* p) { return __builtin_bit_cast(s16x4, __builtin_amdgcn_ds_read_tr16_b64_v4i16((LAS v4i16_t*)p)); }
DI bf16x8 tr_nat(LAS const unsigned char* img, unsigned row16, unsigned c, unsigned lane) {
    const unsigned h = lane >> 5, blk = (lane >> 4) & 1, q = (lane & 15) >> 2, p = lane & 3;
    const s16x4 lo = trread(img + off_b(row16 + 8 * h + q, 4 * c + 2 * blk + (p >> 1)) + 8 * (p & 1));
    const s16x4 hi = trread(img + off_b(row16 + 8 * h + 4 + q, 4 * c + 2 * blk + (p >> 1)) + 8 * (p & 1));
    return __builtin_shufflevector(lo, hi, 0, 1, 2, 3, 4, 5, 6, 7);
}
DI bf16x8 tr_perm(LAS const unsigned char* img, unsigned row16, unsigned c, unsigned lane) {
    const unsigned h = lane >> 5, blk = (lane >> 4) & 1, q = (lane & 15) >> 2, p = lane & 3;
    const s16x4 lo = trread(img + off_b(row16 + 4 * h + q, 4 * c + 2 * blk + (p >> 1)) + 8 * (p & 1));
    const s16x4 hi = trread(img + off_b(row16 + 8 + 4 * h + q, 4 * c + 2 * blk + (p >> 1)) + 8 * (p & 1));
    return __builtin_shufflevector(lo, hi, 0, 1, 2, 3, 4, 5, 6, 7);
}
DI void tr_perm_offs(unsigned c, unsigned lane, unsigned& lo, unsigned& hi) {
    const unsigned h = lane >> 5, blk = (lane >> 4) & 1, q = (lane & 15) >> 2, p = lane & 3;
    lo = off_b(4 * h + q, 4 * c + 2 * blk + (p >> 1)) + 8 * (p & 1);
    hi = off_b(8 + 4 * h + q, 4 * c + 2 * blk + (p >> 1)) + 8 * (p & 1);
}
DI bf16x8 tr_at(LAS const unsigned char* img, unsigned lo, unsigned hi, unsigned byteoff) {
    const s16x4 a = trread(img + lo + byteoff), b = trread(img + hi + byteoff);
    return __builtin_shufflevector(a, b, 0, 1, 2, 3, 4, 5, 6, 7);
}
DI bf16x8 row_frag(LAS const unsigned char* img, unsigned row, unsigned ch) { return *(LAS const bf16x8*)(img + off_b(row, ch)); }
#define CROWC(i) (((i) & 3) + 8 * ((i) >> 2))

namespace pg8 {
constexpr int BM = 256, BK = 64, HALF = 128, HTB = HALF * BK * 2, STAGE_BYTES = 8 * HTB, NXCD = 8, WGM = 8;
DI int lds_byte(int r, int c) { const int st = (r >> 4) * 2 + (c >> 5), rr = r & 15, cc = c & 31, ob = rr * 64 + cc * 2; return st * 1024 + (ob ^ (((ob >> 9) & 1) << 5)); }
DI void stage_rc(int b, int& R, int& C) { const int st = b / 1024, sb = b % 1024, swz = sb ^ (((sb >> 9) & 1) << 5); R = (st >> 1) * 16 + swz / 64; C = (st & 1) * 32 + (swz % 64) / 2; }
DI int perm32(int rho) { const int n = rho >> 4, i = rho & 15; return 8 * (i >> 2) + 4 * n + (i & 3); }
struct Unit { int pm, pn; };
struct Gemm { const bf16_t* A; const bf16_t* Bt; int K; int a_rows; };
struct StaticOrder {
    int nM, nN, nwg, G, c;
    DI void init(int nM_, int nN_, int G_, int c_) { nM = nM_; nN = nN_; nwg = nM * nN; G = G_; c = c_; }
    DI bool next(int i, Unit& u) const {
        const long L = (long)i * G + c; if (L >= nwg) return false;
        int wgid = (int)L; { const int q = nwg / NXCD, r = nwg % NXCD, xcd = wgid % NXCD, off = wgid / NXCD; wgid = (xcd < r ? xcd * (q + 1) : r * (q + 1) + (xcd - r) * q) + off; }
        const int nig = WGM * nN, gid = wgid / nig, fm = gid * WGM, gsz = (nM - fm) < WGM ? (nM - fm) : WGM;
        u.pm = fm + ((wgid % nig) % gsz); u.pn = (wgid % nig) / gsz; return true;
    }
};

template <class Epi>
DI void gemm_phase(LAS unsigned char* lds, const Gemm g, const StaticOrder& S, const Epi& E) {
    const int tid = threadIdx.x, wid = __builtin_amdgcn_readfirstlane(tid >> 6), lane = tid & 63, wr = wid >> 2, wc = wid & 3, fr = lane & 15, fq = lane >> 4;
    const int K = g.K, nt = K / BK;
    unsigned voffA[2], voffB[2];
#pragma unroll
    for (int i = 0; i < 2; ++i) { int R, C; stage_rc(tid * 16 + i * 8192, R, C);
        const int Rb = Epi::BINTER ? (64 * (R >> 5) + perm32(R & 31)) : Epi::PERM ? ((R & ~31) + perm32(R & 31)) : R;
        voffA[i] = (unsigned)(R * K + C) * 2u; voffB[i] = (unsigned)(Rb * K + C) * 2u; }
    const size_t kstep = (size_t)(BK * 2);
    const size_t hstep = (size_t)HALF * K * 2;
    const size_t hstepB = Epi::BINTER ? (size_t)32 * K * 2 : hstep;
    const size_t tstepB = 2 * hstep;
    const size_t tstepA = (size_t)g.a_rows * K * 2;
    const unsigned ldsw = (unsigned)wid * 1024u;
    const int aoff = lds_byte(wr * 64 + fr, fq * 8), boff = lds_byte(wc * 32 + fr, fq * 8);
#define PG8_SA(b, h) (((b) * 2 + (h)) * HTB)
#define PG8_SB(b, h) ((4 + (b) * 2 + (h)) * HTB)
#define PG8_STAGE(bufoff, gbase, voff) do { _Pragma("unroll") for (int _i = 0; _i < 2; ++_i) \
        __builtin_amdgcn_global_load_lds((const unsigned*)((const char*)(gbase) + (voff)[_i]), (LAS unsigned*)(lds + (bufoff) + ldsw + _i * 8192), 16, 0, 0); } while (0)
#define PG8_LDA(dst, b, h) do { _Pragma("unroll") for (int m = 0; m < 4; ++m) _Pragma("unroll") for (int k = 0; k < 2; ++k) dst[m][k] = *(const LAS bf16x8*)(lds + PG8_SA(b, h) + aoff + m * 2048 + k * 1024); } while (0)
#define PG8_LDB(dst, b, h) do { _Pragma("unroll") for (int n = 0; n < 2; ++n) _Pragma("unroll") for (int k = 0; k < 2; ++k) dst[n][k] = *(const LAS bf16x8*)(lds + PG8_SB(b, h) + boff + n * 2048 + k * 1024); } while (0)
#define PG8_MMA(ai, bj, At, Bt) do { __builtin_amdgcn_s_setprio(1); _Pragma("unroll") for (int m = 0; m < 4; ++m) _Pragma("unroll") for (int n = 0; n < 2; ++n) _Pragma("unroll") for (int k = 0; k < 2; ++k) \
        acc[ai][bj][m][n] = __builtin_amdgcn_mfma_f32_16x16x32_bf16(Bt[n][k], At[m][k], acc[ai][bj][m][n], 0, 0, 0); __builtin_amdgcn_s_setprio(0); } while (0)
#define PG8_WAIT_V(n) asm volatile("s_waitcnt vmcnt(" #n ")" ::: "memory")
#define PG8_WAIT_L(n) asm volatile("s_waitcnt lgkmcnt(" #n ")" ::: "memory")
#define PG8_BAR __builtin_amdgcn_s_barrier()
#define PG8_SCHED __builtin_amdgcn_sched_barrier(0)
    Unit cur, nxt; int ui = 0;
    if (!S.next(0, cur)) return;
    f32x4 acc[2][2][4][2];
#pragma unroll
    for (int a = 0; a < 2; ++a)
#pragma unroll
        for (int b = 0; b < 2; ++b)
#pragma unroll
            for (int m = 0; m < 4; ++m)
#pragma unroll
                for (int n = 0; n < 2; ++n) acc[a][b][m][n] = (f32x4){0.f, 0.f, 0.f, 0.f};
    bf16x8 At[4][2], B0[2][2], B1[2][2];
    const char* cA = (const char*)g.A + (size_t)cur.pm * tstepA; const char* cB = (const char*)g.Bt + (size_t)cur.pn * tstepB;
    PG8_STAGE(PG8_SB(0, 0), cB, voffB); PG8_STAGE(PG8_SB(0, 1), cB + hstepB, voffB); PG8_STAGE(PG8_SA(0, 0), cA, voffA); PG8_STAGE(PG8_SA(0, 1), cA + hstep, voffA);
    if (wr == 1) PG8_BAR;
    PG8_WAIT_V(2); PG8_BAR;
    PG8_STAGE(PG8_SB(1, 0), cB + kstep, voffB); PG8_STAGE(PG8_SA(1, 0), cA + kstep, voffA); PG8_STAGE(PG8_SB(1, 1), cB + hstepB + kstep, voffB);
    PG8_WAIT_V(6); PG8_BAR;
    for (;;) {
        const bool has_next = S.next(ui + 1, nxt);
        const char* nA = has_next ? (const char*)g.A + (size_t)nxt.pm * tstepA : cA; const char* nB = has_next ? (const char*)g.Bt + (size_t)nxt.pn * tstepB : cB;
        for (int t = 0; t < nt; t += 2) {
            const bool last = (t == nt - 2);
            const char* a1 = cA + (size_t)(t + 1) * kstep;
            const char* a2 = last ? nA : cA + (size_t)(t + 2) * kstep; const char* b2 = last ? nB : cB + (size_t)(t + 2) * kstep;
            const char* a3 = a2 + kstep; const char* b3 = b2 + kstep;
            PG8_LDB(B0, 0, 0); PG8_LDB(B1, 0, 1); PG8_SCHED; PG8_LDA(At, 0, 0); PG8_STAGE(PG8_SA(1, 1), a1 + hstep, voffA);
            PG8_WAIT_V(8); PG8_WAIT_L(0); PG8_BAR; PG8_MMA(0, 0, At, B0); PG8_MMA(0, 1, At, B1); PG8_BAR; PG8_SCHED;
            PG8_LDA(At, 0, 1); PG8_STAGE(PG8_SB(0, 0), b2, voffB); PG8_STAGE(PG8_SB(0, 1), b2 + hstepB, voffB); PG8_STAGE(PG8_SA(0, 0), a2, voffA);
            PG8_WAIT_V(8); PG8_WAIT_L(0); PG8_BAR; PG8_MMA(1, 0, At, B0); PG8_MMA(1, 1, At, B1); PG8_BAR; PG8_SCHED;
            PG8_LDB(B0, 1, 0); PG8_LDB(B1, 1, 1); PG8_SCHED; PG8_LDA(At, 1, 0); PG8_STAGE(PG8_SA(0, 1), a2 + hstep, voffA);
            PG8_WAIT_V(8); PG8_WAIT_L(0); PG8_BAR; PG8_MMA(0, 0, At, B0); PG8_MMA(0, 1, At, B1); PG8_BAR; PG8_SCHED;
            PG8_LDA(At, 1, 1); PG8_STAGE(PG8_SB(1, 0), b3, voffB); PG8_STAGE(PG8_SB(1, 1), b3 + hstepB, voffB); PG8_STAGE(PG8_SA(1, 0), a3, voffA);
            PG8_WAIT_V(8); PG8_WAIT_L(0); PG8_BAR; PG8_MMA(1, 0, At, B0); PG8_MMA(1, 1, At, B1); PG8_BAR; PG8_SCHED;
        }
        if (wr == 0) PG8_BAR;
        E(acc, cur, wr, wc, fr, fq, lds);
        if (!has_next) break;
#pragma unroll
        for (int a = 0; a < 2; ++a)
#pragma unroll
            for (int b = 0; b < 2; ++b)
#pragma unroll
                for (int m = 0; m < 4; ++m)
#pragma unroll
                    for (int n = 0; n < 2; ++n) acc[a][b][m][n] = (f32x4){0.f, 0.f, 0.f, 0.f};
        cur = nxt; cA = nA; cB = nB; ++ui;
        if (wr == 1) PG8_BAR;
    }
    PG8_WAIT_V(0);
    PG8_BAR;
#undef PG8_SA
#undef PG8_SB
#undef PG8_STAGE
#undef PG8_LDA
#undef PG8_LDB
#undef PG8_MMA
#undef PG8_WAIT_V
#undef PG8_WAIT_L
#undef PG8_BAR
#undef PG8_SCHED
}
}

typedef f32x4 AccT[2][2][4][2];

template <int MODE> struct EpiProj {
    static constexpr bool PERM = true, BINTER = true;
    bf16_t* O; int ldc; const float* rsq; unsigned* kinf;
    DI void operator()(const AccT& acc, const pg8::Unit& u, int wr, int wc, int fr, int fq, LAS unsigned char*) const {
        const int row0 = u.pm * 256 + wr * 64 + fr;
        float rs[2][4];
#pragma unroll
        for (int ai = 0; ai < 2; ++ai)
#pragma unroll
            for (int m = 0; m < 4; ++m) rs[ai][m] = rsq ? __builtin_amdgcn_rsqf(rsq[row0 + ai * 128 + m * 16] * (1.0f / DM) + EPS) : 1.0f;
        const int seg = 2 * u.pn + (wc >> 1), type = seg >> 2, hd = seg & 3;
        const float lg = __builtin_log2f(1.0f - __builtin_exp2f(-5.0f - (float)hd));
        float amax = 0.f;
#pragma unroll
        for (int ai = 0; ai < 2; ++ai)
#pragma unroll
            for (int m = 0; m < 4; ++m) {
                const int row = row0 + ai * 128 + m * 16;
                float f = rs[ai][m];
                if (MODE == 1 && seg < 8) f *= 0.08838834764831845f * LOG2E;
                if (MODE == 0) {
                    const int p = row % PP, pc = p & 127; const bool valid = p >= NVALID0;
                    if (type == 0) f = __builtin_amdgcn_exp2f(lg * (float)pc);
                    else if (type == 1) f = valid ? 0.08838834764831845f * __builtin_amdgcn_exp2f(-lg * (float)pc) : 0.f;
                    else if (type == 2) f = valid ? 1.f : 0.f;
                    else if (type == 4) f = 0.125f * LOG2E;
                }
#pragma unroll
                for (int bj = 0; bj < 2; ++bj) {
                    const int col0 = u.pn * 256 + wc * 64 + bj * 32 + 8 * fq;
                    const f32x4 v0 = acc[ai][bj][m][0] * f, v1 = acc[ai][bj][m][1] * f;
                    u32x4 w; w.x = cvtpk(v0[0], v0[1]); w.y = cvtpk(v0[2], v0[3]); w.z = cvtpk(v1[0], v1[1]); w.w = cvtpk(v1[2], v1[3]);
                    *(u32x4*)(O + (size_t)row * ldc + col0) = w;
                    if (MODE == 0 && type == 5) amax = fmaxf(amax, fmaxf(fmaxf(fmaxf(fabsf(v0[0]), fabsf(v0[1])), fmaxf(fabsf(v0[2]), fabsf(v0[3]))), fmaxf(fmaxf(fabsf(v1[0]), fabsf(v1[1])), fmaxf(fabsf(v1[2]), fabsf(v1[3])))));
                }
            }
        if (MODE == 0 && type == 5) {
#pragma unroll
            for (int o = 1; o < 64; o <<= 1) amax = fmaxf(amax, __shfl_xor(amax, o));
            if ((threadIdx.x & 63) == 0) atomicMax(kinf + hd * 2 + (wc & 1), __float_as_uint(amax));
        }
    }
};

template <int MODE> struct EpiResidual {
    static constexpr bool PERM = true, BINTER = true;
    bf16_t* HB; float* H32; float* rowsq; const float* x0; const float* meta0;
    DI void operator()(const AccT& acc, const pg8::Unit& u, int wr, int wc, int fr, int fq, LAS unsigned char*) const {
        const int row0 = u.pm * 256 + wr * 64 + fr, col0 = u.pn * 256 + wc * 64 + 8 * fq;
#pragma unroll
        for (int ai = 0; ai < 2; ++ai)
#pragma unroll
            for (int m = 0; m < 4; ++m) {
                const int row = row0 + ai * 128 + m * 16;
                bf16_t* hp = HB + (size_t)row * DM + col0;
                const float* sp = nullptr;
                if (MODE == 0) { const int b = row / PP, p = row % PP; sp = (p < NVALID0) ? nullptr : (p < BLK) ? meta0 + (size_t)(p - NVALID0) * DM + col0 : x0 + ((size_t)b * SEQ + (p - BLK)) * DM + col0; }
                f32x4 v[2][2];
#pragma unroll
                for (int bj = 0; bj < 2; ++bj) {
                    if (MODE == 0) { v[bj][0] = sp ? *(const f32x4*)(sp + bj * 32) : (f32x4){0.f, 0.f, 0.f, 0.f}; v[bj][1] = sp ? *(const f32x4*)(sp + bj * 32 + 4) : (f32x4){0.f, 0.f, 0.f, 0.f}; }
                    else { const u32x4 q = *(const u32x4*)(hp + bj * 32);
                        v[bj][0] = (f32x4){__uint_as_float(q.x << 16), __uint_as_float(q.x & 0xffff0000u), __uint_as_float(q.y << 16), __uint_as_float(q.y & 0xffff0000u)};
                        v[bj][1] = (f32x4){__uint_as_float(q.z << 16), __uint_as_float(q.z & 0xffff0000u), __uint_as_float(q.w << 16), __uint_as_float(q.w & 0xffff0000u)}; }
                }
                float ss = 0.f;
#pragma unroll
                for (int bj = 0; bj < 2; ++bj) {
                    const f32x4 h0 = v[bj][0] + acc[ai][bj][m][0], h1 = v[bj][1] + acc[ai][bj][m][1];
                    ss += (h0[0] * h0[0] + h0[1] * h0[1]) + (h0[2] * h0[2] + h0[3] * h0[3]) + (h1[0] * h1[0] + h1[1] * h1[1]) + (h1[2] * h1[2] + h1[3] * h1[3]);
                    if (MODE == 2) { *(f32x4*)(H32 + (size_t)row * DM + col0 + bj * 32) = h0; *(f32x4*)(H32 + (size_t)row * DM + col0 + bj * 32 + 4) = h1; }
                    else { u32x4 w; w.x = cvtpk(h0[0], h0[1]); w.y = cvtpk(h0[2], h0[3]); w.z = cvtpk(h1[0], h1[1]); w.w = cvtpk(h1[2], h1[3]); *(u32x4*)(hp + bj * 32) = w; }
                }
                ss += __shfl_xor(ss, 16); ss += __shfl_xor(ss, 32);
                if (fq == 0) atomicAdd(rowsq + row, ss);
            }
    }
};

#define DPP_SHR1(old, src) __builtin_bit_cast(float, __builtin_amdgcn_update_dpp(__builtin_bit_cast(int, (old)), __builtin_bit_cast(int, (src)), 0x111, 0xF, 0xF, false))
#define DPP_SHR2(old, src) __builtin_bit_cast(float, __builtin_amdgcn_update_dpp(__builtin_bit_cast(int, (old)), __builtin_bit_cast(int, (src)), 0x112, 0xF, 0xF, false))
#define DPP_ROR1(src) __builtin_bit_cast(float, __builtin_amdgcn_update_dpp(0, __builtin_bit_cast(int, (src)), 0x121, 0xF, 0xF, false))
#define DPP_ROR2(src) __builtin_bit_cast(float, __builtin_amdgcn_update_dpp(0, __builtin_bit_cast(int, (src)), 0x122, 0xF, 0xF, false))
struct EpiFfnUp {
    static constexpr bool PERM = true, BINTER = false;
    bf16_t* ACT; const float* wconv; const float* bconv; const float* rsq;
    DI void operator()(const AccT& acc, const pg8::Unit& u, int wr, int wc, int fr, int fq, LAS unsigned char* lds) const {
        LAS float* halo = (LAS float*)(lds + 131072);
        const int vbase = 254 * u.pm - 2;
        const int cl = wc * 32 + 8 * fq;
        const int cg0 = u.pn * 128 + cl;
        float rv[2][4], rg[2][4];
#pragma unroll
        for (int ai = 0; ai < 2; ++ai)
#pragma unroll
            for (int m = 0; m < 4; ++m) { const int v = vbase + ai * 128 + wr * 64 + m * 16 + fr; const bool inr = v >= 0 && v < MROWS;
                const float r = inr ? __builtin_amdgcn_rsqf(rsq[inr ? v : 0] * (1.0f / DM) + EPS) : 0.f;
                rv[ai][m] = r * -0.6931471805599453f; rg[ai][m] = (inr && (v % PP) >= NVALID0) ? r : 0.f; }
        f32x4 w0[2], w1[2], w2[2], bb[2];
#pragma unroll
        for (int n = 0; n < 2; ++n) {
            w0[n] = *(const f32x4*)(wconv + cg0 + 4 * n) * -LOG2E; w1[n] = *(const f32x4*)(wconv + DFF + cg0 + 4 * n) * -LOG2E; w2[n] = *(const f32x4*)(wconv + 2 * DFF + cg0 + 4 * n) * -LOG2E; bb[n] = *(const f32x4*)(bconv + cg0 + 4 * n) * -LOG2E; }
        if (fr >= 14) {
#pragma unroll
            for (int ai = 0; ai < 2; ++ai)
#pragma unroll
                for (int n = 0; n < 2; ++n) *(LAS f32x4*)(halo + ((2 * ai + wr) * 2 + (fr - 14)) * 128 + cl + 4 * n) = acc[ai][0][3][n] * rg[ai][3];
        }
        asm volatile("s_waitcnt lgkmcnt(0)" ::: "memory"); __builtin_amdgcn_s_barrier(); asm volatile("" ::: "memory");
#pragma unroll
        for (int ai = 0; ai < 2; ++ai) {
            const int grp = 2 * ai + wr;
            f32x4 pa[2], pb[2];
#pragma unroll
            for (int n = 0; n < 2; ++n) {
                if (grp > 0) {
                    const f32x4 h0 = *(LAS const f32x4*)(halo + ((grp - 1) * 2 + 0) * 128 + cl + 4 * n);
                    const f32x4 h1 = *(LAS const f32x4*)(halo + ((grp - 1) * 2 + 1) * 128 + cl + 4 * n);
                    pa[n] = h1; pb[n] = (fr == 0) ? h0 : h1;
                } else { pa[n] = (f32x4){0.f, 0.f, 0.f, 0.f}; pb[n] = pa[n]; }
            }
#pragma unroll
            for (int m = 0; m < 4; ++m) {
                const int lr = ai * 128 + wr * 64 + m * 16 + fr; const int v = vbase + lr;
                u32x4 w;
#pragma unroll
                for (int n = 0; n < 2; ++n) {
                    const f32x4 gv = acc[ai][0][m][n] * rg[ai][m];
                    f32x4 g1, g2;
#pragma unroll
                    for (int j = 0; j < 4; ++j) { float t = gv[j]; asm volatile("" : "+v"(t));
                        const float r1 = DPP_ROR1(t), r2 = DPP_ROR2(t); g1[j] = (fr >= 1) ? r1 : pa[n][j]; g2[j] = (fr >= 2) ? r2 : pb[n][j]; pa[n][j] = r1; pb[n][j] = r2; }
                    const f32x4 cv = bb[n] + w0[n] * g2 + w1[n] * g1 + w2[n] * gv;
                    const f32x4 vv = acc[ai][1][m][n] * rv[ai][m];
                    f32x4 o;
#pragma unroll
                    for (int j = 0; j < 4; ++j) o[j] = cv[j] * __builtin_amdgcn_rcpf(1.0f + __builtin_amdgcn_exp2f(cv[j])) * vv[j];
                    if (n == 0) { w.x = cvtpk(o[0], o[1]); w.y = cvtpk(o[2], o[3]); } else { w.z = cvtpk(o[0], o[1]); w.w = cvtpk(o[2], o[3]); }
                }
                if (lr >= 2 && v < MROWS) *(u32x4*)(ACT + (size_t)v * DFF + cg0) = w;
            }
        }
    }
};

template <int NCH> DI void tile_load(const bf16_t* src, int ld, u32x4 (&v)[NCH], int tid) {
#pragma unroll
    for (int i = 0; i < NCH; ++i) { const int c = tid + NTHREADS * i, row = c >> 4, ch = c & 15; v[i] = *(const u32x4*)(src + (size_t)row * ld + ch * 8); }
}
template <int NCH> DI void tile_store(LAS unsigned char* img, const u32x4 (&v)[NCH], int tid) {
#pragma unroll
    for (int i = 0; i < NCH; ++i) { const int c = tid + NTHREADS * i, row = c >> 4, ch = c & 15; *(LAS u32x4*)(img + off_b(row, ch)) = v[i]; }
}

DI void tile_dma64(const bf16_t* src, int ld, LAS unsigned char* img, int wave, int lane) {
#pragma unroll
    for (int i = 0; i < 2; ++i) {
        const unsigned L = (unsigned)((wave * 2 + i) * 64 + lane), row = L >> 4, cpos = L & 15;
        const unsigned ch = cpos ^ (((row & 3u) << 2) | ((row >> 2) & 3u));
        __builtin_amdgcn_global_load_lds((const unsigned*)(src + (size_t)row * ld + ch * 8), (LAS unsigned*)(img + (wave * 2 + i) * 1024), 16, 0, 0);
    }
}
DI void glds16(const void* gsrc, unsigned lds_dst) { unsigned keep;
    asm volatile("s_mov_b32 %0, m0\n\ts_mov_b32 m0, %2\n\ts_nop 0\n\tglobal_load_lds_dwordx4 %1, off\n\ts_mov_b32 m0, %0" : "=&s"(keep) : "v"(gsrc), "s"(lds_dst) : "memory"); }
DI void tile_dma64_asm(const bf16_t* src, int ld, LAS unsigned char* img, int wave, int lane) {
#pragma unroll
    for (int i = 0; i < 2; ++i) {
        const unsigned L = (unsigned)((wave * 2 + i) * 64 + lane), row = L >> 4, cpos = L & 15;
        const unsigned ch = cpos ^ (((row & 3u) << 2) | ((row >> 2) & 3u));
        glds16(src + (size_t)row * ld + ch * 8, (unsigned)__builtin_amdgcn_readfirstlane((int)((unsigned)(uintptr_t)img + (unsigned)(wave * 2 + i) * 1024u)));
    }
}

DI void retention_item(const Params& P, LAS unsigned char* lds, int b, int hd, int nfull0, int nend) {
    const int tid = threadIdx.x, lane = tid & 63, w = __builtin_amdgcn_readfirstlane(tid >> 6), r = lane & 31, h = lane >> 5, ib = w & 3, eh = w >> 2;
    LAS unsigned char* Qimg = lds; LAS unsigned char* Kimg = lds + 32768; LAS unsigned char* Vimg = lds + 65536; LAS unsigned char* Timg = lds + 98304;
    LAS f32x2* X = (LAS f32x2*)(lds + 131072);
    const bf16_t* proj = (const bf16_t*)(P.ws + WS_BIG) + (size_t)(b * PP) * AB_IN;
    bf16_t* MIX = (bf16_t*)P.out;
    const float lg = __builtin_log2f(1.0f - __builtin_exp2f(-5.0f - (float)hd));
    const float g128 = __builtin_exp2f(128.0f * lg);
    __syncthreads();
    for (int i = tid; i < 2048; i += NTHREADS) ((LAS u32x4*)Timg)[i] = (u32x4){0u, 0u, 0u, 0u};
    f32x16 st[2];
#pragma unroll
    for (int i = 0; i < 16; ++i) { st[0][i] = 0.f; st[1][i] = 0.f; }
    u32x4 pq[4], pk[4], pv[4];
    if (nfull0 == 0) tile_load<4>(proj + hd * 128, AB_IN, pq, tid);
    tile_load<4>(proj + 512 + hd * 128, AB_IN, pk, tid); tile_load<4>(proj + 1024 + hd * 128, AB_IN, pv, tid);
    const float* rn = P.ab_ret_norm + hd * 128;
    for (int n = 0; n < nend; ++n) {
        const bool full = n >= nfull0;
        __syncthreads();
        if (full) tile_store<4>(Qimg, pq, tid);
        tile_store<4>(Kimg, pk, tid); tile_store<4>(Vimg, pv, tid);
        __syncthreads();
        if (n + 1 < nend) { const bf16_t* s = proj + (size_t)(n + 1) * 128 * AB_IN;
            if (n + 1 >= nfull0) tile_load<4>(s + hd * 128, AB_IN, pq, tid);
            tile_load<4>(s + 512 + hd * 128, AB_IN, pk, tid); tile_load<4>(s + 1024 + hd * 128, AB_IN, pv, tid); }
        f32x16 o[2];
#pragma unroll
        for (int i = 0; i < 16; ++i) { o[0][i] = 0.f; o[1][i] = 0.f; }
        if (full) {
#pragma unroll 2
        for (int s = 0; s < 8; ++s) { const bf16x8 qv = row_frag(Qimg, 32 * ib + r, 2 * s + h);
#pragma unroll
            for (int ec = 0; ec < 2; ++ec) { const bf16x8 a = tr_nat(Timg, 16 * s, 2 * eh + ec, lane); o[ec] = MFMA32(a, qv, o[ec]); } }
        for (int jb = 0; jb <= ib; ++jb) {
            f32x16 S;
#pragma unroll
            for (int i = 0; i < 16; ++i) S[i] = 0.f;
#pragma unroll 1
            for (int s = 0; s < 8; ++s) { const bf16x8 a = row_frag(Kimg, 32 * jb + r, 2 * s + h); const bf16x8 qv = row_frag(Qimg, 32 * ib + r, 2 * s + h); S = MFMA32(a, qv, S); }
            if (jb == ib) {
#pragma unroll
                for (int i = 0; i < 16; ++i) if (CROWC(i) + 4 * h > r) S[i] = 0.f;
            }
            const bf16x8 p0 = pack8(S[0], S[1], S[2], S[3], S[4], S[5], S[6], S[7]), p1 = pack8(S[8], S[9], S[10], S[11], S[12], S[13], S[14], S[15]);
#pragma unroll
            for (int ec = 0; ec < 2; ++ec) {
                const bf16x8 a0 = tr_perm(Vimg, 32 * jb, 2 * eh + ec, lane); o[ec] = MFMA32(a0, p0, o[ec]);
                const bf16x8 a1 = tr_perm(Vimg, 32 * jb + 16, 2 * eh + ec, lane); o[ec] = MFMA32(a1, p1, o[ec]);
            }
        }
        }
#pragma unroll 1
        for (int s = 0; s < 8; ++s) {
            const bf16x8 bk = tr_nat(Kimg, 16 * s, ib, lane);
#pragma unroll
            for (int ec = 0; ec < 2; ++ec) { const bf16x8 av = tr_nat(Vimg, 16 * s, 2 * eh + ec, lane); st[ec] = MFMA32(av, bk, st[ec]); }
        }
#pragma unroll
        for (int i = 0; i < 16; ++i) { st[0][i] *= g128; st[1][i] *= g128; }
        float s1 = 0.f, s2 = 0.f;
#pragma unroll
        for (int ec = 0; ec < 2; ++ec)
#pragma unroll
            for (int i = 0; i < 16; ++i) { s1 += o[ec][i]; s2 += o[ec][i] * o[ec][i]; }
        s1 += __shfl_xor(s1, 32); s2 += __shfl_xor(s2, 32);
        if (h == 0) X[(eh * 4 + ib) * 32 + r] = (f32x2){s1, s2};
        __syncthreads();
#pragma unroll
        for (int ec = 0; ec < 2; ++ec)
#pragma unroll
            for (int g = 0; g < 4; ++g) { u32x2 wv; wv.x = cvtpk(st[ec][4 * g], st[ec][4 * g + 1]); wv.y = cvtpk(st[ec][4 * g + 2], st[ec][4 * g + 3]);
                *(LAS u32x2*)(Timg + off_b(32 * ib + r, 4 * (2 * eh + ec) + g) + 8 * h) = wv; }
        if (!full) continue;
        const f32x2 xo = X[((1 - eh) * 4 + ib) * 32 + r];
        const float mean = (s1 + xo.x) * (1.0f / 128.0f);
        const float var = (s2 + xo.y) * (1.0f / 128.0f) - mean * mean;
        const float rstd = __builtin_amdgcn_rsqf(fmaxf(var, 0.f) + EPS);
        const size_t m = (size_t)(b * PP) + n * 128 + 32 * ib + r;
        const bf16_t* rg = (const bf16_t*)(P.ws + WS_BIG) + m * AB_IN + 1536 + hd * 128;
        bf16_t* op = MIX + m * DM + hd * 128;
#pragma unroll
        for (int ec = 0; ec < 2; ++ec)
#pragma unroll
            for (int g = 0; g < 4; ++g) {
                const int e = 32 * (2 * eh + ec) + 8 * g + 4 * h;
                const u32x2 gr = *(const u32x2*)(rg + e);
                const f32x4 nw = *(const f32x4*)(rn + e);
                float gate[4] = {__uint_as_float(gr.x << 16), __uint_as_float(gr.x & 0xffff0000u), __uint_as_float(gr.y << 16), __uint_as_float(gr.y & 0xffff0000u)};
                float y[4];
#pragma unroll
                for (int j = 0; j < 4; ++j) { const float sg = gate[j] * __builtin_amdgcn_rcpf(1.0f + __builtin_amdgcn_exp2f(-LOG2E * gate[j])); y[j] = (o[ec][4 * g + j] - mean) * rstd * nw[j] * sg; }
                u32x2 wv; wv.x = cvtpk(y[0], y[1]); wv.y = cvtpk(y[2], y[3]);
                *(u32x2*)(op + e) = wv;
            }
    }
}

DI void diffattn_item(const Params& P, LAS unsigned char* lds, int b, int hd, int qb, float lam, const float* kinf) {
    const int tid = threadIdx.x, lane = tid & 63, w = __builtin_amdgcn_readfirstlane(tid >> 6), r = lane & 31, h = lane >> 5, wq = w & 3, mp = w >> 2;
    LAS float* XO = (LAS float*)lds;
    LAS unsigned* flags = (LAS unsigned*)(lds + 131072);
    const bf16_t* proj = (const bf16_t*)(P.ws + WS_BIG) + (size_t)(b * PP) * AB_IN;
    bf16_t* MIX = (bf16_t*)P.out;
    const int qpos = 128 * qb + 32 * wq + r;
    const float slope = __builtin_exp2f(-2.0f * (float)(hd + 1));
    const float c2 = slope * LOG2E;
    bf16x8 qf[4];
    float q1 = 0.f;
    { const bf16_t* qp = proj + (size_t)qpos * AB_IN + 2048 + hd * 128 + mp * 64 + 8 * h;
#pragma unroll
      for (int s = 0; s < 4; ++s) { qf[s] = *(const bf16x8*)(qp + 16 * s);
#pragma unroll
          for (int j = 0; j < 8; ++j) q1 += fabsf(bf2f((unsigned short)qf[s][j])); } }
    q1 += __shfl_xor(q1, 32);
    const float sbound = q1 * kinf[hd * 2 + mp] * 1.01f + 1.0f;
    f32x16 O[4];
#pragma unroll
    for (int c = 0; c < 4; ++c)
#pragma unroll
        for (int i = 0; i < 16; ++i) O[c][i] = 0.f;
    float mrun = -1e30f, lrun = 0.f;
    const int ktop = 2 * qb + 1;
    unsigned vlo0, vhi0; tr_perm_offs(0, lane, vlo0, vhi0);
    const unsigned kof0 = off_b(r, 8 * mp + h);
#define DF_DMA(kt_, slot_) do { LAS unsigned char* nb_ = lds + (slot_) * 32768; \
        tile_dma64_asm(proj + (size_t)(64 * (kt_)) * AB_IN + 2560 + hd * 128, AB_IN, nb_, w, lane); \
        tile_dma64_asm(proj + (size_t)(64 * (kt_)) * AB_IN + 3072 + hd * 128, AB_IN, nb_ + 16384, w, lane); } while (0)
#define DF_QK(Sa, Sb, slot_) do { LAS unsigned char* kb_ = lds + (slot_) * 32768; \
        _Pragma("unroll") for (int i = 0; i < 16; ++i) { Sa[i] = 0.f; Sb[i] = 0.f; } \
        bf16x8 ka_[8]; \
        _Pragma("unroll") for (int s = 0; s < 4; ++s) { ka_[2 * s] = *(LAS const bf16x8*)(kb_ + (kof0 ^ (32u * s))); ka_[2 * s + 1] = *(LAS const bf16x8*)(kb_ + (kof0 ^ (32u * s)) + 8192); } \
        __builtin_amdgcn_sched_barrier(0); \
        _Pragma("unroll") for (int s = 0; s < 4; ++s) { Sa = MFMA32(ka_[2 * s], qf[s], Sa); Sb = MFMA32(ka_[2 * s + 1], qf[s], Sb); } } while (0)
    __syncthreads();
    DF_DMA(ktop, 0); DF_DMA(ktop - 1, 1);
    if (tid < 16) flags[tid] = 0u;
    asm volatile("s_waitcnt vmcnt(0)" ::: "memory");
    __syncthreads();
    f32x16 S0, S1;
    DF_QK(S0, S1, 0);
    int slot = 0;
    bf16x8 pp0 = {0, 0, 0, 0, 0, 0, 0, 0}, pp1 = pp0, pp2 = pp0, pp3 = pp0;
    LAS unsigned char* vprev = lds + 16384;
#define DF_LDV(c_, dst_, Vimg_) do { const unsigned vl_ = vlo0 ^ (64u * (c_)), vh_ = vhi0 ^ (64u * (c_)); \
        dst_[0] = tr_at(Vimg_, vl_, vh_, 0); dst_[1] = tr_at(Vimg_, vl_, vh_, 4096); dst_[2] = tr_at(Vimg_, vl_, vh_, 8192); dst_[3] = tr_at(Vimg_, vl_, vh_, 12288); } while (0)
#define DF_EXP4(S_, b_) do { _Pragma("unroll") for (int i_ = 0; i_ < 4; ++i_) { float e_ = __builtin_amdgcn_exp2f(S_[(b_) + i_] + dl); asm volatile("" : "+v"(e_));   S_[(b_) + i_] = e_; ps += e_; } } while (0)
    for (int kt = ktop; kt >= 0; --kt) {
        asm volatile("s_waitcnt vmcnt(0) lgkmcnt(0)\n\ts_barrier" ::: "memory");
        { LAS const unsigned* fr_ = flags + ((kt + 1) & 1) * 8;
          const u32x4 f0 = *(LAS const u32x4*)fr_, f1 = *(LAS const u32x4*)(fr_ + 4);
          if ((f0.x & f0.y & f0.z & f0.w & f1.x & f1.y & f1.z & f1.w) != 0u) break; }
        const int slot1 = (slot + 1) & 3;
        if (kt >= 2) DF_DMA(kt - 2, (slot + 2) & 3);
        LAS unsigned char* Vimg = lds + slot * 32768 + 16384;
        const bool boundary = (kt >= 2 * qb) || (kt < 2);
        const int k0 = 64 * kt + 4 * h;
        const float u0 = c2 * (float)(k0 - qpos);
        float amax = -3.0e38f;
        if (boundary) {
#pragma unroll
            for (int i = 0; i < 16; ++i) {
                float t0 = fmaf(c2, (float)CROWC(i), S0[i]), t1 = fmaf(c2, (float)(32 + CROWC(i)), S1[i]);
                const int kp = k0 + CROWC(i); if (kp > qpos || kp < NVALID0) t0 = -1e30f; if (kp + 32 > qpos || kp + 32 < NVALID0) t1 = -1e30f;
                S0[i] = t0; S1[i] = t1; amax = fmaxf(amax, fmaxf(t0, t1));
            }
        } else {
#pragma unroll
            for (int i = 0; i < 16; ++i) {
                const float t0 = fmaf(c2, (float)CROWC(i), S0[i]), t1 = fmaf(c2, (float)(32 + CROWC(i)), S1[i]);
                S0[i] = t0; S1[i] = t1; amax = fmaxf(amax, fmaxf(t0, t1));
            }
        }
        amax = fmaxf(amax + u0, -1e30f);
        const float bmax = fmaxf(amax, __shfl_xor(amax, 32));
        const float mold = mrun;
        mrun = fmaxf(mrun, bmax);
        const float dl = u0 - mrun;
        float ps = 0.f;
        {
            bf16x8 va[2][4];
            DF_LDV(0, va[0], vprev);
            DF_LDV(1, va[1], vprev);
            __builtin_amdgcn_sched_barrier(0);
            O[0] = MFMA32(va[0][0], pp0, O[0]); O[0] = MFMA32(va[0][1], pp1, O[0]); O[0] = MFMA32(va[0][2], pp2, O[0]); O[0] = MFMA32(va[0][3], pp3, O[0]);
            DF_EXP4(S0, 0); DF_EXP4(S1, 0);
            __builtin_amdgcn_sched_barrier(0);
            DF_LDV(2, va[0], vprev);
            O[1] = MFMA32(va[1][0], pp0, O[1]); O[1] = MFMA32(va[1][1], pp1, O[1]); O[1] = MFMA32(va[1][2], pp2, O[1]); O[1] = MFMA32(va[1][3], pp3, O[1]);
            DF_EXP4(S0, 4); DF_EXP4(S1, 4);
            __builtin_amdgcn_sched_barrier(0);
            DF_LDV(3, va[1], vprev);
            O[2] = MFMA32(va[0][0], pp0, O[2]); O[2] = MFMA32(va[0][1], pp1, O[2]); O[2] = MFMA32(va[0][2], pp2, O[2]); O[2] = MFMA32(va[0][3], pp3, O[2]);
            DF_EXP4(S0, 8); DF_EXP4(S1, 8);
            __builtin_amdgcn_sched_barrier(0);
            O[3] = MFMA32(va[1][0], pp0, O[3]); O[3] = MFMA32(va[1][1], pp1, O[3]); O[3] = MFMA32(va[1][2], pp2, O[3]); O[3] = MFMA32(va[1][3], pp3, O[3]);
            DF_EXP4(S0, 12); DF_EXP4(S1, 12);
            __builtin_amdgcn_sched_barrier(0);
        }
        if (__any(mrun > mold)) {
            const float al = __builtin_amdgcn_exp2f(mold - mrun);
            lrun *= al;
#pragma unroll
            for (int c = 0; c < 4; ++c)
#pragma unroll
                for (int i = 0; i < 16; ++i) O[c][i] *= al;
        }
        lrun += ps;
        pp0 = pack8(S0[0], S0[1], S0[2], S0[3], S0[4], S0[5], S0[6], S0[7]); pp1 = pack8(S0[8], S0[9], S0[10], S0[11], S0[12], S0[13], S0[14], S0[15]);
        pp2 = pack8(S1[0], S1[1], S1[2], S1[3], S1[4], S1[5], S1[6], S1[7]); pp3 = pack8(S1[8], S1[9], S1[10], S1[11], S1[12], S1[13], S1[14], S1[15]);
        vprev = Vimg;
        const bool okw = __all(sbound + c2 * (float)(64 * kt - 1 - qpos) - mrun < -150.0f);
        if (lane == 0) flags[(kt & 1) * 8 + w] = okw ? 1u : 0u;
        if (kt >= 1) DF_QK(S0, S1, slot1);
        slot = slot1;
    }
    {
        bf16x8 va[2][4];
        DF_LDV(0, va[0], vprev);
#pragma unroll
        for (int c = 0; c < 4; ++c) { if (c < 3) DF_LDV(c + 1, va[(c + 1) & 1], vprev); __builtin_amdgcn_sched_barrier(0);
            O[c] = MFMA32(va[c & 1][0], pp0, O[c]); O[c] = MFMA32(va[c & 1][1], pp1, O[c]); O[c] = MFMA32(va[c & 1][2], pp2, O[c]); O[c] = MFMA32(va[c & 1][3], pp3, O[c]);
            __builtin_amdgcn_sched_barrier(0); }
    }
#undef DF_EXP4
#undef DF_LDV
#undef DF_DMA
#undef DF_QK
    asm volatile("s_waitcnt vmcnt(0)" ::: "memory");
    __syncthreads();
    lrun += __shfl_xor(lrun, 32);
    const float inv = 1.0f / lrun;
    if (mp == 1) {
#pragma unroll
        for (int c = 0; c < 4; ++c)
#pragma unroll
            for (int i = 0; i < 16; ++i) XO[(wq * 64 + c * 16 + i) * 64 + lane] = O[c][i] * inv;
    }
    __syncthreads();
    if (mp == 0) {
        float ss = 0.f;
#pragma unroll
        for (int c = 0; c < 4; ++c)
#pragma unroll
            for (int i = 0; i < 16; ++i) { const float d = O[c][i] * inv - lam * XO[(wq * 64 + c * 16 + i) * 64 + lane]; O[c][i] = d; ss += d * d; }
        ss += __shfl_xor(ss, 32);
        const float rs = __builtin_amdgcn_rsqf(ss * (1.0f / 128.0f) + EPS) * 0.8f;
        const float* dn = P.ab_diff_norm + hd * 128;
        bf16_t* op = MIX + (size_t)(b * PP + qpos) * DM + 512 + hd * 128;
#pragma unroll
        for (int c = 0; c < 4; ++c)
#pragma unroll
            for (int g = 0; g < 4; ++g) {
                const int e = 32 * c + 8 * g + 4 * h;
                const f32x4 nw = *(const f32x4*)(dn + e);
                u32x2 wv; wv.x = cvtpk(O[c][4 * g] * rs * nw[0], O[c][4 * g + 1] * rs * nw[1]); wv.y = cvtpk(O[c][4 * g + 2] * rs * nw[2], O[c][4 * g + 3] * rs * nw[3]);
                *(u32x2*)(op + e) = wv;
            }
    }
}

DI void sb_block(f32x16& S, float& C, int k0, int qpos, int h, bool boundary) {
    float L[16]; float seg[4];
#pragma unroll
    for (int g = 0; g < 4; ++g) seg[g] = 0.f;
#pragma unroll
    for (int i = 0; i < 16; ++i) {
        const float z = S[i];
        const float e = __builtin_amdgcn_exp2f(-fabsf(z));
        const float sp = fmaxf(z, 0.f) + __builtin_amdgcn_logf(1.0f + e);
        bool ok = true;
        if (boundary) { const int kp = k0 + CROWC(i); ok = (kp < qpos) && (kp >= NVALID0); }
        L[i] = ok ? -sp : 0.f;
        S[i] = ok ? (z - sp) : -1e30f;
        seg[i >> 2] += L[i];
    }
    float oseg[4];
#pragma unroll
    for (int g = 0; g < 4; ++g) oseg[g] = __shfl_xor(seg[g], 32);
    float R = 0.f;
#pragma unroll
    for (int gi = 0; gi < 4; ++gi) {
        const int g = 3 - gi;
        float lat = C + R + (h == 0 ? oseg[g] : 0.f);
        S[4 * g + 3] = __builtin_amdgcn_exp2f(S[4 * g + 3] + lat); lat += L[4 * g + 3];
        S[4 * g + 2] = __builtin_amdgcn_exp2f(S[4 * g + 2] + lat); lat += L[4 * g + 2];
        S[4 * g + 1] = __builtin_amdgcn_exp2f(S[4 * g + 1] + lat); lat += L[4 * g + 1];
        S[4 * g + 0] = __builtin_amdgcn_exp2f(S[4 * g + 0] + lat);
        R += seg[g] + oseg[g];
    }
    C += R;
}
DI void stickbreak_item(const Params& P, LAS unsigned char* lds, int b, int hp, int qb) {
    const int tid = threadIdx.x, lane = tid & 63, w = __builtin_amdgcn_readfirstlane(tid >> 6), r = lane & 31, h = lane >> 5, wq = w & 3, hs = w >> 2;
    const int hd = 2 * hp + hs;
    LAS unsigned* flags = (LAS unsigned*)(lds + 131072);
    const bf16_t* proj = (const bf16_t*)(P.ws + WS_BIG) + (size_t)(b * PP) * C_IN;
    bf16_t* MIX = (bf16_t*)P.out;
    const int qpos = 128 * qb + 32 * wq + r;
    bf16x8 qf[8];
    { const bf16_t* qp = proj + (size_t)qpos * C_IN + hd * 128 + 8 * h;
#pragma unroll
      for (int s = 0; s < 8; ++s) qf[s] = *(const bf16x8*)(qp + 16 * s); }
    f32x16 O[4];
#pragma unroll
    for (int c = 0; c < 4; ++c)
#pragma unroll
        for (int i = 0; i < 16; ++i) O[c][i] = 0.f;
    float C = 0.f;
    const int ktop = 2 * qb + 1;
    unsigned vlo0, vhi0; tr_perm_offs(0, lane, vlo0, vhi0);
    const unsigned kof0 = off_b(r, h);
    __syncthreads();
#define SB_DMA(kt_, base_) do { const bf16_t* s_ = proj + (size_t)(64 * (kt_)) * C_IN + hp * 256; \
        tile_dma64_asm(s_ + 1024, C_IN, (base_), w, lane); tile_dma64_asm(s_ + 1024 + 128, C_IN, (base_) + 16384, w, lane); \
        tile_dma64_asm(s_ + 2048, C_IN, (base_) + 32768, w, lane); tile_dma64_asm(s_ + 2048 + 128, C_IN, (base_) + 49152, w, lane); } while (0)
    SB_DMA(ktop, lds);
    if (tid < 16) flags[tid] = 0u;
    int cur = 0;
    for (int kt = ktop; kt >= 0; --kt) {
        asm volatile("s_waitcnt vmcnt(0)" ::: "memory");
        __syncthreads();
        { LAS const unsigned* fr_ = flags + ((kt + 1) & 1) * 8;
          const u32x4 f0 = *(LAS const u32x4*)fr_, f1 = *(LAS const u32x4*)(fr_ + 4);
          if ((f0.x & f0.y & f0.z & f0.w & f1.x & f1.y & f1.z & f1.w) != 0u) break; }
        LAS unsigned char* Kimg = lds + cur * 65536 + hs * 16384; LAS unsigned char* Vimg = Kimg + 32768;
        if (kt > 0) SB_DMA(kt - 1, lds + (cur ^ 1) * 65536);
        cur ^= 1;
        const bool boundary = (kt >= 2 * qb) || (kt < 2);
        const bool skip = (64 * kt >= 128 * qb + 32 * wq + 32);
        if (!skip) {
            f32x16 S0, S1;
#pragma unroll
            for (int i = 0; i < 16; ++i) { S0[i] = 0.f; S1[i] = 0.f; }
#pragma unroll
            for (int s = 0; s < 8; ++s) { const bf16x8 a0 = *(LAS const bf16x8*)(Kimg + (kof0 ^ (32u * s))), a1 = *(LAS const bf16x8*)(Kimg + (kof0 ^ (32u * s)) + 8192);
                S0 = MFMA32(a0, qf[s], S0); S1 = MFMA32(a1, qf[s], S1); }
            sb_block(S1, C, 64 * kt + 32 + 4 * h, qpos, h, boundary);
            sb_block(S0, C, 64 * kt + 4 * h, qpos, h, boundary);
            const bf16x8 p0 = pack8(S0[0], S0[1], S0[2], S0[3], S0[4], S0[5], S0[6], S0[7]), p1 = pack8(S0[8], S0[9], S0[10], S0[11], S0[12], S0[13], S0[14], S0[15]);
            const bf16x8 p2 = pack8(S1[0], S1[1], S1[2], S1[3], S1[4], S1[5], S1[6], S1[7]), p3 = pack8(S1[8], S1[9], S1[10], S1[11], S1[12], S1[13], S1[14], S1[15]);
#pragma unroll
            for (int c = 0; c < 4; ++c) {
                const unsigned vl = vlo0 ^ (64u * c), vh = vhi0 ^ (64u * c);
                const bf16x8 a0 = tr_at(Vimg, vl, vh, 0), a1 = tr_at(Vimg, vl, vh, 4096), a2 = tr_at(Vimg, vl, vh, 8192), a3 = tr_at(Vimg, vl, vh, 12288);
                O[c] = MFMA32(a0, p0, O[c]); O[c] = MFMA32(a1, p1, O[c]); O[c] = MFMA32(a2, p2, O[c]); O[c] = MFMA32(a3, p3, O[c]);
            }
        }
        const bool okw = __all(C < -160.0f);
        if (lane == 0) flags[(kt & 1) * 8 + w] = okw ? 1u : 0u;
    }
#undef SB_DMA
    bf16_t* op = MIX + (size_t)(b * PP + qpos) * DM + hd * 128;
#pragma unroll
    for (int c = 0; c < 4; ++c)
#pragma unroll
        for (int g = 0; g < 4; ++g) {
            const int e = 32 * c + 8 * g + 4 * h;
            u32x2 wv; wv.x = cvtpk(O[c][4 * g], O[c][4 * g + 1]); wv.y = cvtpk(O[c][4 * g + 2], O[c][4 * g + 3]);
            *(u32x2*)(op + e) = wv;
        }
}

DI unsigned f2bf(float f) { unsigned u = __builtin_bit_cast(unsigned, f); return (u + 0x7fffu + ((u >> 16) & 1u)) >> 16; }
DI unsigned pk2(float lo, float hi) { return f2bf(lo) | (f2bf(hi) << 16); }
DI void transpose_item(const float* W, int K, int N, bf16_t* WT, bool ffn_perm, LAS float* scr, int item, int lane, const float* kgain = nullptr) {
    const int nblk = N / 32, kb = item / nblk, nb = item % nblk, k0 = 64 * kb, n0 = 32 * nb;
#pragma unroll 8
    for (int i = 0; i < 32; ++i) { const int kk = 2 * i + (lane >> 5); const float gk = kgain ? kgain[k0 + kk] : 1.0f; scr[kk * 33 + (lane & 31)] = W[(size_t)(k0 + kk) * N + n0 + (lane & 31)] * gk; }
    asm volatile("s_waitcnt lgkmcnt(0)" ::: "memory");
    const int c = lane & 7;
#pragma unroll
    for (int j = 0; j < 4; ++j) { const int n = (lane >> 3) + 8 * j; const LAS float* s = scr + (8 * c) * 33 + n;
        u32x4 o; o.x = pk2(s[0 * 33], s[1 * 33]); o.y = pk2(s[2 * 33], s[3 * 33]); o.z = pk2(s[4 * 33], s[5 * 33]); o.w = pk2(s[6 * 33], s[7 * 33]);
        int col = n0 + n, drow = col;
        if (ffn_perm) { const int isval = col >= DFF; const int cc = isval ? col - DFF : col; drow = (cc >> 7) * 256 + isval * 128 + (cc & 127); }
        *(u32x4*)(WT + (size_t)drow * K + k0 + 8 * c) = o; }
    asm volatile("s_waitcnt lgkmcnt(0)" ::: "memory");
}
DI void norm_store_bf16(const f32x4 (&v)[4], const float* gain, bf16_t* orow, int lane) {
    float s = 0.f;
#pragma unroll
    for (int j = 0; j < 4; ++j) s += (v[j].x * v[j].x + v[j].y * v[j].y) + (v[j].z * v[j].z + v[j].w * v[j].w);
    const float rstd = __builtin_amdgcn_rsqf(wave_sum(s) * (1.0f / DM) + EPS);
#pragma unroll
    for (int j = 0; j < 4; ++j) { const f32x4 g = *(const f32x4*)(gain + 4 * lane + 256 * j);
        u32x2 wv; wv.x = cvtpk(v[j].x * rstd * g.x, v[j].y * rstd * g.y); wv.y = cvtpk(v[j].z * rstd * g.z, v[j].w * rstd * g.w);
        *(u32x2*)(orow + 4 * lane + 256 * j) = wv; }
}

#ifdef NO_RET
#define RET_CALL
#else
#define RET_CALL retention_item(P, lds, (it & 31) >> 2, it & 3, (it < 32) ? 36 : 0, (it < 32) ? 65 : 36);
#endif
#ifdef NO_DIFF
#define DIFF_CALL
#else
#define DIFF_CALL diffattn_item(P, lds, bh >> 2, bh & 3, 64 - (j >> 5), lam, (const float*)(ctl + 16));
#endif
#ifdef NO_SB
#define SB_CALL
#else
#define SB_CALL stickbreak_item(P, lds, bh >> 2, bh & 3, 64 - (it >> 5));
#endif
constexpr int I_OUT = (DM / 64) * (DM / 32), I_UP = (DM / 64) * (2 * DFF / 32), I_DN = (DFF / 64) * (DM / 32), I_IN1 = (DM / 64) * (C_IN / 32);
DI void deferred_convert(const Params& P, LAS unsigned char* lds, unsigned* ctr, int group, int wave, int lane) {
    LAS float* scr = (LAS float*)(lds + wave * 16384);
    const int total = group == 0 ? (I_OUT + I_UP + I_DN) : (I_IN1 + I_OUT + I_UP + I_DN);
    for (;;) {
        int it = 0; if (lane == 0) it = (int)atomicAdd(ctr, 1u);
        it = __builtin_amdgcn_readfirstlane(it);
        if (it >= total) break;
        int q = it;
        if (group == 0) {
            if (q < I_UP) { transpose_item(P.ffn_up, DM, 2 * DFF, (bf16_t*)(P.ws + WS_WUP0), true, scr, q, lane, P.ffn_norm); continue; } q -= I_UP;
            if (q < I_DN) { transpose_item(P.ffn_down, DFF, DM, (bf16_t*)(P.ws + WS_WDN0), false, scr, q, lane); continue; } q -= I_DN;
            transpose_item(P.ab_w_out, DM, DM, (bf16_t*)(P.ws + WS_WOUT0), false, scr, q, lane);
        } else {
            if (q < I_UP) { transpose_item(P.ffn_up + (size_t)DM * 2 * DFF, DM, 2 * DFF, (bf16_t*)(P.ws + WS_WUP1), true, scr, q, lane, P.ffn_norm + DM); continue; } q -= I_UP;
            if (q < I_DN) { transpose_item(P.ffn_down + (size_t)DFF * DM, DFF, DM, (bf16_t*)(P.ws + WS_WDN1), false, scr, q, lane); continue; } q -= I_DN;
            if (q < I_IN1) { transpose_item(P.c_w_in, DM, C_IN, (bf16_t*)(P.ws + WS_WIN1), false, scr, q, lane, P.mix_norm + DM); continue; } q -= I_IN1;
            transpose_item(P.c_w_out, DM, DM, (bf16_t*)(P.ws + WS_WOUT1), false, scr, q, lane);
        }
    }
}


#define XB_TMO      128
#define XB_XCNT(j)  (256  + 64 * (j))
#define XB_XSUB(j)  (1280 + 64 * (j))
#define XB_XGEN(j)  (2304 + 64 * (j))
#define XB_TOP      3328
#define XB_TOPGEN   3392
#define XCD_BAR_WORDS 3456
#define XB_SPIN_CAP (1u << 18)

__device__ __forceinline__ unsigned xb_ld(unsigned* p)              { return __hip_atomic_load(p, __ATOMIC_RELAXED, __HIP_MEMORY_SCOPE_AGENT); }
__device__ __forceinline__ unsigned xb_add(unsigned* p, unsigned v) { return __hip_atomic_fetch_add(p, v, __ATOMIC_RELAXED, __HIP_MEMORY_SCOPE_AGENT); }
__device__ __forceinline__ unsigned xb_xcc_id() { return (unsigned)__builtin_amdgcn_s_getreg((3 << 11) | 20) & 0xFu; }
#define XB_SPIN(cond, bar) do { unsigned _sp = 0; while (cond) { __builtin_amdgcn_s_sleep(1); \
    if ((++_sp & 255u) == 0u) { if (xb_ld(&(bar)[XB_TMO])) break; if (_sp > XB_SPIN_CAP) { atomicAdd(&(bar)[XB_TMO], 1u); break; } } } } while (0)

struct XcdBarrier {
    unsigned* bar; unsigned x;
    volatile LAS unsigned* st;
};

__device__ __forceinline__ XcdBarrier xcd_barrier_post(unsigned* bar, volatile LAS unsigned* st) {
    XcdBarrier b; b.bar = bar; b.x = xb_xcc_id(); b.st = st;
    if (threadIdx.x == 0) (void)xb_add(&bar[XB_XCNT(b.x)], 1u);
    return b;
}
__device__ __forceinline__ void xcd_barrier_complete(unsigned* bar, unsigned x, unsigned& nloc, unsigned& nx) {
    const unsigned G = gridDim.x * gridDim.y * gridDim.z;
    unsigned sum, cnt, mine, sp = 0u;
    for (;;) {
        sum = 0u; cnt = 0u; mine = 0u;
#pragma unroll
        for (unsigned j = 0; j < 16; ++j) { const unsigned c = xb_ld(&bar[XB_XCNT(j)]); sum += c; cnt += (c > 0u) ? 1u : 0u; mine = (j == x) ? c : mine; }
        if (sum == G) break;
        __builtin_amdgcn_s_sleep(1);
        if ((++sp & 255u) == 0u) { if (xb_ld(&bar[XB_TMO])) break; if (sp > XB_SPIN_CAP) { atomicAdd(&bar[XB_TMO], 1u); break; } }
    }
    nloc = mine > 0u ? mine : 1u; nx = cnt > 0u ? cnt : 1u;
}

__device__ __forceinline__ void xcd_barrier(const XcdBarrier& b) {
    asm volatile("s_waitcnt vmcnt(0)" ::: "memory");
    __syncthreads();
    if (threadIdx.x == 0) {
        unsigned* bar = b.bar;
        __builtin_amdgcn_s_waitcnt(0);
        unsigned nloc = b.st[0], nx = b.st[1];
        if (nloc == 0u) { xcd_barrier_complete(bar, b.x, nloc, nx); b.st[0] = nloc; b.st[1] = nx; }
        const unsigned old = xb_add(&bar[XB_XSUB(b.x)], 1u);
        const unsigned gen = old / nloc;
        if (old + 1u == (gen + 1u) * nloc) {
            __builtin_amdgcn_fence(__ATOMIC_RELEASE, "agent");
            asm volatile("s_waitcnt vmcnt(0)" ::: "memory");
            const unsigned og = xb_add(&bar[XB_TOP], 1u);
            const unsigned tg = og / nx;
            if (og + 1u == (tg + 1u) * nx) xb_add(&bar[XB_TOPGEN], 1u);
            else XB_SPIN(xb_ld(&bar[XB_TOPGEN]) == tg, bar);
            __builtin_amdgcn_fence(__ATOMIC_ACQUIRE, "agent");
            xb_add(&bar[XB_XGEN(b.x)], 1u);
            asm volatile("s_waitcnt vmcnt(0)" ::: "memory");
        } else {
            XB_SPIN(xb_ld(&bar[XB_XGEN(b.x)]) == gen, bar);
            __builtin_amdgcn_fence(__ATOMIC_ACQUIRE, "agent");
            asm volatile("s_waitcnt vmcnt(0)" ::: "memory");
        }
    }
    __syncthreads();
}


#ifndef DUP_MASK
#define DUP_MASK 0
#endif
#define NREP(k) (1 + ((DUP_MASK >> (k)) & 1))
constexpr int LDS_BYTES = 147456;
constexpr int NPHASES = 12;

__global__ void __launch_bounds__(NTHREADS, 2) fwd_megakernel(Params P) {
    extern __shared__ __attribute__((aligned(16))) unsigned char lds_raw[];
    LAS unsigned char* lds = (LAS unsigned char*)lds_raw;
    cg::grid_group grid = cg::this_grid();
    const int tid = threadIdx.x, lane = tid & 63, wave = __builtin_amdgcn_readfirstlane(tid >> 6);
    const int G = gridDim.x, gw = blockIdx.x * 8 + wave, NGW = G * 8;
    unsigned* ctl = (unsigned*)(P.ws + WS_CTL);
    bf16_t* Y = (bf16_t*)(P.ws + WS_Y);
    float* H = (float*)(P.ws + WS_H);
    bf16_t* BIG = (bf16_t*)(P.ws + WS_BIG);
    const int lo = P.ph_lo, hi = P.ph_hi;
#define IN(k) (lo <= (k) && (k) < hi)
#define SEAM(k) do { if (IN(k) && IN((k) + 1)) xcd_barrier(xbar); } while (0)

    if (IN(0)) {
        if (blockIdx.x == 0) { if (tid < 64) ctl[tid] = 0u; for (int i = tid; i < XCD_BAR_WORDS; i += NTHREADS) ctl[1024 + i] = 0u; }
        { float* rz = (float*)(P.ws + WS_RSQ); for (int i = blockIdx.x * NTHREADS + tid; i < 4 * MROWS; i += G * NTHREADS) rz[i] = 0.f; }
        LAS float* scr = (LAS float*)(lds + wave * 16384);
        constexpr int I_IN0 = (DM / 64) * (AB_IN / 32);
        for (int it = gw; it < I_IN0; it += NGW) transpose_item(P.ab_w_in, DM, AB_IN, (bf16_t*)(P.ws + WS_WIN0), false, scr, it, lane);
        for (int m = gw; m < MROWS; m += NGW) {
            const int b = m / PP, p = m % PP;
            f32x4 v[4];
            if (p < NVALID0) {
#pragma unroll
                for (int j = 0; j < 4; ++j) v[j] = (f32x4){0.f, 0.f, 0.f, 0.f};
            } else {
                const float* src = (p < BLK) ? P.meta + (size_t)(p - NVALID0) * DM : P.x + ((size_t)b * SEQ + (p - BLK)) * DM;
#pragma unroll
                for (int j = 0; j < 4; ++j) v[j] = *(const f32x4*)(src + 4 * lane + 256 * j);
            }
            norm_store_bf16(v, P.mix_norm, Y + (size_t)m * DM, lane);
        }
    }
    XcdBarrier xbar; xbar.bar = ctl + 1024; xbar.x = 0; xbar.st = (volatile LAS unsigned*)(lds + 147456 - 32);
    if (IN(0) && IN(1)) {
        grid.sync();
        if (tid == 0) { xbar.st[0] = 0u; xbar.st[1] = 0u; }
        __syncthreads();
        xbar = xcd_barrier_post(ctl + 1024, (volatile LAS unsigned*)(lds + 147456 - 32));
    }
    float* RSQ = (float*)(P.ws + WS_RSQ);
    bf16_t* MIXB = (bf16_t*)P.out;
    if (IN(1)) {
        pg8::Gemm g{Y, (const bf16_t*)(P.ws + WS_WIN0), DM, 256}; pg8::StaticOrder S; S.init(MROWS / 256, AB_IN / 256, G, (int)blockIdx.x);
        EpiProj<0> E{BIG, AB_IN, nullptr, ctl + 16};
        for (int rep = 0; rep < NREP(1); ++rep) pg8::gemm_phase(lds, g, S, E);
        deferred_convert(P, lds, ctl + 8, 0, wave, lane);
    }
    SEAM(1);
    if (IN(2)) {
        float d1 = 0.f, d2 = 0.f;
        for (int i = 0; i < 64; ++i) { d1 += P.lq1[i] * P.lk1[i]; d2 += P.lq2[i] * P.lk2[i]; }
        const float lam = __expf(d1) - __expf(d2) + 0.2f;
        LAS int* itm = (LAS int*)(lds + 147456 - 64);
        for (int rep = 0; rep < NREP(2); ++rep) {
#define FETCH_ITEM(dst) do { __syncthreads(); if (tid == 0) itm[0] = (int)atomicAdd(&ctl[0 + 4 * rep], 1u); __syncthreads(); dst = itm[0]; } while (0)
            int it; FETCH_ITEM(it);
#ifdef PROBE_P2
            while (it < 128) { const int itq = it; { const int it = itq & 63; RET_CALL } FETCH_ITEM(it); }
            while (it < 128 + 2 * 32 * 65) { const int j = (it - 128) % (32 * 65); const int bh = j & 31; DIFF_CALL FETCH_ITEM(it); }
#else
            while (it < 64) { RET_CALL FETCH_ITEM(it); }
            while (it < 64 + 32 * 65) { const int j = it - 64; const int bh = j & 31; DIFF_CALL FETCH_ITEM(it); }
#endif
#undef FETCH_ITEM
        }
    }
    SEAM(2);
    if (IN(3)) {
        pg8::Gemm g{MIXB, (const bf16_t*)(P.ws + WS_WOUT0), DM, 256}; pg8::StaticOrder S; S.init(MROWS / 256, DM / 256, G, (int)blockIdx.x);
        EpiResidual<0> E{Y, nullptr, RSQ, P.x, P.meta};
        pg8::gemm_phase(lds, g, S, E);
    }
    SEAM(3);
    if (IN(4)) {
        pg8::Gemm g{Y - 2 * DM, (const bf16_t*)(P.ws + WS_WUP0), DM, 254}; pg8::StaticOrder S; S.init((MROWS + 253) / 254, DFF / 128, G, (int)blockIdx.x);
        EpiFfnUp E{BIG, P.ffn_conv, P.ffn_conv_b, RSQ};
        for (int rep = 0; rep < NREP(4); ++rep) pg8::gemm_phase(lds, g, S, E);
    }
    SEAM(4);
    if (IN(5)) {
        pg8::Gemm g{BIG, (const bf16_t*)(P.ws + WS_WDN0), DFF, 256}; pg8::StaticOrder S; S.init(MROWS / 256, DM / 256, G, (int)blockIdx.x);
        EpiResidual<1> E{Y, nullptr, RSQ + MROWS, nullptr, nullptr};
        pg8::gemm_phase(lds, g, S, E);
        deferred_convert(P, lds, ctl + 9, 1, wave, lane);
    }
    SEAM(5);
    if (IN(6)) {
        pg8::Gemm g{Y, (const bf16_t*)(P.ws + WS_WIN1), DM, 256}; pg8::StaticOrder S; S.init(MROWS / 256, C_IN / 256, G, (int)blockIdx.x);
        EpiProj<1> E{BIG, C_IN, RSQ + MROWS, nullptr};
        pg8::gemm_phase(lds, g, S, E);
    }
    SEAM(6);
    if (IN(7)) {
        LAS int* itm = (LAS int*)(lds + 147456 - 64);
        for (int rep = 0; rep < NREP(7); ++rep)
        for (;;) {
            __syncthreads();
            if (tid == 0) itm[0] = (int)atomicAdd(&ctl[1 + 4 * rep], 1u);
            __syncthreads();
            const int it = itm[0];
            if (it >= 32 * 65) break;
            const int bh = it & 31;
            SB_CALL
        }
    }
    SEAM(7);
    if (IN(8)) {
        pg8::Gemm g{MIXB, (const bf16_t*)(P.ws + WS_WOUT1), DM, 256}; pg8::StaticOrder S; S.init(MROWS / 256, DM / 256, G, (int)blockIdx.x);
        EpiResidual<1> E{Y, nullptr, RSQ + 2 * MROWS, nullptr, nullptr};
        pg8::gemm_phase(lds, g, S, E);
    }
    SEAM(8);
    if (IN(9)) {
        pg8::Gemm g{Y - 2 * DM, (const bf16_t*)(P.ws + WS_WUP1), DM, 254}; pg8::StaticOrder S; S.init((MROWS + 253) / 254, DFF / 128, G, (int)blockIdx.x);
        EpiFfnUp E{BIG, P.ffn_conv + 3 * DFF, P.ffn_conv_b + DFF, RSQ + 2 * MROWS};
        pg8::gemm_phase(lds, g, S, E);
    }
    SEAM(9);
    if (IN(10)) {
        pg8::Gemm g{BIG, (const bf16_t*)(P.ws + WS_WDN1), DFF, 256}; pg8::StaticOrder S; S.init(MROWS / 256, DM / 256, G, (int)blockIdx.x);
        EpiResidual<1> E{Y, nullptr, RSQ + 3 * MROWS, nullptr, nullptr};
        pg8::gemm_phase(lds, g, S, E);
    }
    SEAM(10);
    if (IN(11)) {
        for (int mo = gw; mo < BATCH * SEQ; mo += NGW) {
            const int b = mo / SEQ, sq = mo % SEQ; const size_t m = (size_t)b * PP + BLK + sq;
            const float rstd = __builtin_amdgcn_rsqf(RSQ[3 * MROWS + m] * (1.0f / DM) + EPS);
#pragma unroll
            for (int j = 0; j < 2; ++j) {
                const u32x4 q = *(const u32x4*)(Y + m * DM + 8 * lane + 512 * j);
                const f32x4 g0 = *(const f32x4*)(P.final_norm + 8 * lane + 512 * j), g1 = *(const f32x4*)(P.final_norm + 8 * lane + 512 * j + 4);
                const f32x4 v0 = (f32x4){__uint_as_float(q.x << 16), __uint_as_float(q.x & 0xffff0000u), __uint_as_float(q.y << 16), __uint_as_float(q.y & 0xffff0000u)};
                const f32x4 v1 = (f32x4){__uint_as_float(q.z << 16), __uint_as_float(q.z & 0xffff0000u), __uint_as_float(q.w << 16), __uint_as_float(q.w & 0xffff0000u)};
                *(f32x4*)(P.out + (size_t)mo * DM + 8 * lane + 512 * j) = v0 * rstd * g0;
                *(f32x4*)(P.out + (size_t)mo * DM + 8 * lane + 512 * j + 4) = v1 * rstd * g1; }
        }
    }
#undef IN
#undef SEAM
#undef NORM_PHASE
}

#ifndef MK_ONE_LAUNCH
#define MK_ONE_LAUNCH 1
#endif
extern "C" void kernel_launch(void* const* d_in, const int* in_sizes, int n_in, void* d_out, int out_size, void* d_ws, size_t ws_size, hipStream_t stream) {
    static int grid = 0;
    if (grid == 0) {
        if (n_in != 19 || ws_size < WS_END) { fprintf(stderr, "kernel_launch: unexpected n_in %d or ws_size %zu (need %zu)\n", n_in, ws_size, (size_t)WS_END); grid = -1; return; }
        int dev = 0, cus = 0, per_cu = 0;
        hipGetDevice(&dev); hipDeviceGetAttribute(&cus, hipDeviceAttributeMultiprocessorCount, dev);
        if (hipFuncSetAttribute((const void*)fwd_megakernel, hipFuncAttributeMaxDynamicSharedMemorySize, LDS_BYTES) != hipSuccess) { fprintf(stderr, "kernel_launch: hipFuncSetAttribute failed\n"); grid = -1; return; }
        if (hipOccupancyMaxActiveBlocksPerMultiprocessor(&per_cu, (const void*)fwd_megakernel, NTHREADS, LDS_BYTES) != hipSuccess || per_cu < 1) { fprintf(stderr, "kernel_launch: occupancy query says %d\n", per_cu); per_cu = 1; }
        (void)hipGetLastError();
        grid = cus * 1;
        if (grid <= 0) grid = 256;
    }
    if (grid < 0) return;
    Params p{};
    p.x = (const float*)d_in[0]; p.meta = (const float*)d_in[1]; p.mix_norm = (const float*)d_in[2]; p.ffn_norm = (const float*)d_in[3];
    p.ffn_up = (const float*)d_in[4]; p.ffn_conv = (const float*)d_in[5]; p.ffn_conv_b = (const float*)d_in[6]; p.ffn_down = (const float*)d_in[7];
    p.ab_w_in = (const float*)d_in[8]; p.ab_ret_norm = (const float*)d_in[9]; p.ab_diff_norm = (const float*)d_in[10];
    p.lq1 = (const float*)d_in[11]; p.lk1 = (const float*)d_in[12]; p.lq2 = (const float*)d_in[13]; p.lk2 = (const float*)d_in[14]; p.ab_w_out = (const float*)d_in[15];
    p.c_w_in = (const float*)d_in[16]; p.c_w_out = (const float*)d_in[17]; p.final_norm = (const float*)d_in[18];
    p.out = (float*)d_out; p.ws = (unsigned char*)d_ws;
#if MK_ONE_LAUNCH
    p.ph_lo = 0; p.ph_hi = NPHASES;
    void* args[] = {&p};
    hipError_t e = hipLaunchCooperativeKernel((const void*)fwd_megakernel, dim3(grid), dim3(NTHREADS), args, LDS_BYTES, stream);
    if (e != hipSuccess) fprintf(stderr, "cooperative launch failed: %s (grid %d)\n", hipGetErrorString(e), grid);
#else
    for (int ph = 0; ph < NPHASES; ++ph) {
        p.ph_lo = ph; p.ph_hi = ph + 1;
        hipLaunchKernelGGL(fwd_megakernel, dim3(grid), dim3(NTHREADS), LDS_BYTES, stream, p);
    }
#endif
}
```

```cpp
#include <hip/hip_runtime.h>
#include <hip/hip_cooperative_groups.h>
#include <cstdio>
#include <cstdint>
namespace cg = cooperative_groups;

#define LAS __attribute__((address_space(3)))
#define DI __device__ __forceinline__
typedef unsigned short bf16_t;
typedef short bf16x8 __attribute__((ext_vector_type(8)));
typedef short s16x4 __attribute__((ext_vector_type(4)));
typedef float f32x2 __attribute__((ext_vector_type(2)));
typedef float f32x4 __attribute__((ext_vector_type(4)));
typedef float f32x16 __attribute__((ext_vector_type(16)));
typedef unsigned u32x2 __attribute__((ext_vector_type(2)));
typedef unsigned u32x4 __attribute__((ext_vector_type(4)));
typedef __bf16 bf16x2_t __attribute__((ext_vector_type(2)));

constexpr int BATCH = 8, SEQ = 8192, DM = 1024, BLK = 128, NMETA = 16;
constexpr int PP = SEQ + BLK;
constexpr int MROWS = BATCH * PP;
constexpr int NVALID0 = BLK - NMETA;
constexpr int DFF = 2816;
constexpr int AB_IN = 3584, C_IN = 3072;
constexpr float EPS = 1e-6f;
constexpr float LOG2E = 1.4426950408889634f;
constexpr int NTHREADS = 512;

constexpr size_t MiB = 1u << 20;
constexpr size_t WS_CTL = 0;
constexpr size_t WS_WIN0 = 1 * MiB, WS_WOUT0 = 8 * MiB, WS_WUP0 = 10 * MiB, WS_WDN0 = 21 * MiB;
constexpr size_t WS_WIN1 = 27 * MiB, WS_WOUT1 = 33 * MiB, WS_WUP1 = 35 * MiB, WS_WDN1 = 46 * MiB;
constexpr size_t WS_YPAD = 52 * MiB;
constexpr size_t WS_Y = WS_YPAD + 2 * 2048;
constexpr size_t WS_H = 184 * MiB;
constexpr size_t WS_BIG = 444 * MiB;
constexpr size_t WS_RSQ = 899 * MiB;
constexpr size_t WS_END = 901 * MiB;

struct Params {
    const float* x; const float* meta; const float* mix_norm; const float* ffn_norm;
    const float* ffn_up; const float* ffn_conv; const float* ffn_conv_b; const float* ffn_down;
    const float* ab_w_in; const float* ab_ret_norm; const float* ab_diff_norm;
    const float* lq1; const float* lk1; const float* lq2; const float* lk2; const float* ab_w_out;
    const float* c_w_in; const float* c_w_out; const float* final_norm;
    float* out; unsigned char* ws; int ph_lo, ph_hi;
};

DI unsigned cvtpk(float lo, float hi) { f32x2 v = {lo, hi}; bf16x2_t b = __builtin_convertvector(v, bf16x2_t); return __builtin_bit_cast(unsigned, b); }
DI float bf2f(unsigned short u) { return __uint_as_float(((unsigned)u) << 16); }
DI bf16x8 pack8(float a0, float a1, float a2, float a3, float a4, float a5, float a6, float a7) {
    u32x4 p; p.x = cvtpk(a0, a1); p.y = cvtpk(a2, a3); p.z = cvtpk(a4, a5); p.w = cvtpk(a6, a7); return __builtin_bit_cast(bf16x8, p);
}
#define MFMA32(a, b, c) __builtin_amdgcn_mfma_f32_32x32x16_bf16((a), (b), (c), 0, 0, 0)
DI float wave_sum(float v) {
#pragma unroll
    for (int o = 1; o < 64; o <<= 1) v += __shfl_xor(v, o);
    return v;
}
DI unsigned off_b(unsigned row, unsigned ch) { return 256u * row + 16u * (ch ^ (((row & 3u) << 2) | ((row >> 2) & 3u))); }
typedef short v4i16_t __attribute__((ext_vector_type(4)));
DI s16x4 trread(LAS const unsigned char* p) { return __builtin_bit_cast(s16x4, __builtin_amdgcn_ds_read_tr16_b64_v4i16((LAS v4i16_t*)p)); }
DI bf16x8 tr_nat(LAS const unsigned char* img, unsigned row16, unsigned c, unsigned lane) {
    const unsigned h = lane >> 5, blk = (lane >> 4) & 1, q = (lane & 15) >> 2, p = lane & 3;
    const s16x4 lo = trread(img + off_b(row16 + 8 * h + q, 4 * c + 2 * blk + (p >> 1)) + 8 * (p & 1));
    const s16x4 hi = trread(img + off_b(row16 + 8 * h + 4 + q, 4 * c + 2 * blk + (p >> 1)) + 8 * (p & 1));
    return __builtin_shufflevector(lo, hi, 0, 1, 2, 3, 4, 5, 6, 7);
}
DI bf16x8 tr_perm(LAS const unsigned char* img, unsigned row16, unsigned c, unsigned lane) {
    const unsigned h = lane >> 5, blk = (lane >> 4) & 1, q = (lane & 15) >> 2, p = lane & 3;
    const s16x4 lo = trread(img + off_b(row16 + 4 * h + q, 4 * c + 2 * blk + (p >> 1)) + 8 * (p & 1));
    const s16x4 hi = trread(img + off_b(row16 + 8 + 4 * h + q, 4 * c + 2 * blk + (p >> 1)) + 8 * (p & 1));
    return __builtin_shufflevector(lo, hi, 0, 1, 2, 3, 4, 5, 6, 7);
}
DI void tr_perm_offs(unsigned c, unsigned lane, unsigned& lo, unsigned& hi) {
    const unsigned h = lane >> 5, blk = (lane >> 4) & 1, q = (lane & 15) >> 2, p = lane & 3;
    lo = off_b(4 * h + q, 4 * c + 2 * blk + (p >> 1)) + 8 * (p & 1);
    hi = off_b(8 + 4 * h + q, 4 * c + 2 * blk + (p >> 1)) + 8 * (p & 1);
}
DI bf16x8 tr_at(LAS const unsigned char* img, unsigned lo, unsigned hi, unsigned byteoff) {
    const s16x4 a = trread(img + lo + byteoff), b = trread(img + hi + byteoff);
    return __builtin_shufflevector(a, b, 0, 1, 2, 3, 4, 5, 6, 7);
}
DI bf16x8 row_frag(LAS const unsigned char* img, unsigned row, unsigned ch) { return *(LAS const bf16x8*)(img + off_b(row, ch)); }
#define CROWC(i) (((i) & 3) + 8 * ((i) >> 2))

namespace pg8 {
constexpr int BM = 256, BK = 64, HALF = 128, HTB = HALF * BK * 2, STAGE_BYTES = 8 * HTB, NXCD = 8, WGM = 8;
DI int lds_byte(int r, int c) { const int st = (r >> 4) * 2 + (c >> 5), rr = r & 15, cc = c & 31, ob = rr * 64 + cc * 2; return st * 1024 + (ob ^ (((ob >> 9) & 1) << 5)); }
DI void stage_rc(int b, int& R, int& C) { const int st = b / 1024, sb = b % 1024, swz = sb ^ (((sb >> 9) & 1) << 5); R = (st >> 1) * 16 + swz / 64; C = (st & 1) * 32 + (swz % 64) / 2; }
DI int perm32(int rho) { const int n = rho >> 4, i = rho & 15; return 8 * (i >> 2) + 4 * n + (i & 3); }
struct Unit { int pm, pn; };
struct Gemm { const bf16_t* A; const bf16_t* Bt; int K; int a_rows; };
struct StaticOrder {
    int nM, nN, nwg, G, c;
    DI void init(int nM_, int nN_, int G_, int c_) { nM = nM_; nN = nN_; nwg = nM * nN; G = G_; c = c_; }
    DI bool next(int i, Unit& u) const {
        const long L = (long)i * G + c; if (L >= nwg) return false;
        int wgid = (int)L; { const int q = nwg / NXCD, r = nwg % NXCD, xcd = wgid % NXCD, off = wgid / NXCD; wgid = (xcd < r ? xcd * (q + 1) : r * (q + 1) + (xcd - r) * q) + off; }
        const int nig = WGM * nN, gid = wgid / nig, fm = gid * WGM, gsz = (nM - fm) < WGM ? (nM - fm) : WGM;
        u.pm = fm + ((wgid % nig) % gsz); u.pn = (wgid % nig) / gsz; return true;
    }
};

template <class Epi>
DI void gemm_phase(LAS unsigned char* lds, const Gemm g, const StaticOrder& S, const Epi& E) {
    const int tid = threadIdx.x, wid = __builtin_amdgcn_readfirstlane(tid >> 6), lane = tid & 63, wr = wid >> 2, wc = wid & 3, fr = lane & 15, fq = lane >> 4;
    const int K = g.K, nt = K / BK;
    unsigned voffA[2], voffB[2];
#pragma unroll
    for (int i = 0; i < 2; ++i) { int R, C; stage_rc(tid * 16 + i * 8192, R, C);
        const int Rb = Epi::BINTER ? (64 * (R >> 5) + perm32(R & 31)) : Epi::PERM ? ((R & ~31) + perm32(R & 31)) : R;
        voffA[i] = (unsigned)(R * K + C) * 2u; voffB[i] = (unsigned)(Rb * K + C) * 2u; }
    const size_t kstep = (size_t)(BK * 2);
    const size_t hstep = (size_t)HALF * K * 2;
    const size_t hstepB = Epi::BINTER ? (size_t)32 * K * 2 : hstep;
    const size_t tstepB = 2 * hstep;
    const size_t tstepA = (size_t)g.a_rows * K * 2;
    const unsigned ldsw = (unsigned)wid * 1024u;
    const int aoff = lds_byte(wr * 64 + fr, fq * 8), boff = lds_byte(wc * 32 + fr, fq * 8);
#define PG8_SA(b, h) (((b) * 2 + (h)) * HTB)
#define PG8_SB(b, h) ((4 + (b) * 2 + (h)) * HTB)
#define PG8_STAGE(bufoff, gbase, voff) do { _Pragma("unroll") for (int _i = 0; _i < 2; ++_i) \
        __builtin_amdgcn_global_load_lds((const unsigned*)((const char*)(gbase) + (voff)[_i]), (LAS unsigned*)(lds + (bufoff) + ldsw + _i * 8192), 16, 0, 0); } while (0)
#define PG8_LDA(dst, b, h) do { _Pragma("unroll") for (int m = 0; m < 4; ++m) _Pragma("unroll") for (int k = 0; k < 2; ++k) dst[m][k] = *(const LAS bf16x8*)(lds + PG8_SA(b, h) + aoff + m * 2048 + k * 1024); } while (0)
#define PG8_LDB(dst, b, h) do { _Pragma("unroll") for (int n = 0; n < 2; ++n) _Pragma("unroll") for (int k = 0; k < 2; ++k) dst[n][k] = *(const LAS bf16x8*)(lds + PG8_SB(b, h) + boff + n * 2048 + k * 1024); } while (0)
#define PG8_MMA(ai, bj, At, Bt) do { __builtin_amdgcn_s_setprio(1); _Pragma("unroll") for (int m = 0; m < 4; ++m) _Pragma("unroll") for (int n = 0; n < 2; ++n) _Pragma("unroll") for (int k = 0; k < 2; ++k) \
        acc[ai][bj][m][n] = __builtin_amdgcn_mfma_f32_16x16x32_bf16(Bt[n][k], At[m][k], acc[ai][bj][m][n], 0, 0, 0); __builtin_amdgcn_s_setprio(0); } while (0)
#define PG8_WAIT_V(n) asm volatile("s_waitcnt vmcnt(" #n ")" ::: "memory")
#define PG8_WAIT_L(n) asm volatile("s_waitcnt lgkmcnt(" #n ")" ::: "memory")
#define PG8_BAR __builtin_amdgcn_s_barrier()
#define PG8_SCHED __builtin_amdgcn_sched_barrier(0)
    Unit cur, nxt; int ui = 0;
    if (!S.next(0, cur)) return;
    f32x4 acc[2][2][4][2];
#pragma unroll
    for (int a = 0; a < 2; ++a)
#pragma unroll
        for (int b = 0; b < 2; ++b)
#pragma unroll
            for (int m = 0; m < 4; ++m)
#pragma unroll
                for (int n = 0; n < 2; ++n) acc[a][b][m][n] = (f32x4){0.f, 0.f, 0.f, 0.f};
    bf16x8 At[4][2], B0[2][2], B1[2][2];
    const char* cA = (const char*)g.A + (size_t)cur.pm * tstepA; const char* cB = (const char*)g.Bt + (size_t)cur.pn * tstepB;
    PG8_STAGE(PG8_SB(0, 0), cB, voffB); PG8_STAGE(PG8_SB(0, 1), cB + hstepB, voffB); PG8_STAGE(PG8_SA(0, 0), cA, voffA); PG8_STAGE(PG8_SA(0, 1), cA + hstep, voffA);
    if (wr == 1) PG8_BAR;
    PG8_WAIT_V(2); PG8_BAR;
    PG8_STAGE(PG8_SB(1, 0), cB + kstep, voffB); PG8_STAGE(PG8_SA(1, 0), cA + kstep, voffA); PG8_STAGE(PG8_SB(1, 1), cB + hstepB + kstep, voffB);
    PG8_WAIT_V(6); PG8_BAR;
    for (;;) {
        const bool has_next = S.next(ui + 1, nxt);
        const char* nA = has_next ? (const char*)g.A + (size_t)nxt.pm * tstepA : cA; const char* nB = has_next ? (const char*)g.Bt + (size_t)nxt.pn * tstepB : cB;
        for (int t = 0; t < nt; t += 2) {
            const bool last = (t == nt - 2);
            const char* a1 = cA + (size_t)(t + 1) * kstep;
            const char* a2 = last ? nA : cA + (size_t)(t + 2) * kstep; const char* b2 = last ? nB : cB + (size_t)(t + 2) * kstep;
            const char* a3 = a2 + kstep; const char* b3 = b2 + kstep;
            PG8_LDB(B0, 0, 0); PG8_LDB(B1, 0, 1); PG8_SCHED; PG8_LDA(At, 0, 0); PG8_STAGE(PG8_SA(1, 1), a1 + hstep, voffA);
            PG8_WAIT_V(8); PG8_WAIT_L(0); PG8_BAR; PG8_MMA(0, 0, At, B0); PG8_MMA(0, 1, At, B1); PG8_BAR; PG8_SCHED;
            PG8_LDA(At, 0, 1); PG8_STAGE(PG8_SB(0, 0), b2, voffB); PG8_STAGE(PG8_SB(0, 1), b2 + hstepB, voffB); PG8_STAGE(PG8_SA(0, 0), a2, voffA);
            PG8_WAIT_V(8); PG8_WAIT_L(0); PG8_BAR; PG8_MMA(1, 0, At, B0); PG8_MMA(1, 1, At, B1); PG8_BAR; PG8_SCHED;
            PG8_LDB(B0, 1, 0); PG8_LDB(B1, 1, 1); PG8_SCHED; PG8_LDA(At, 1, 0); PG8_STAGE(PG8_SA(0, 1), a2 + hstep, voffA);
            PG8_WAIT_V(8); PG8_WAIT_L(0); PG8_BAR; PG8_MMA(0, 0, At, B0); PG8_MMA(0, 1, At, B1); PG8_BAR; PG8_SCHED;
            PG8_LDA(At, 1, 1); PG8_STAGE(PG8_SB(1, 0), b3, voffB); PG8_STAGE(PG8_SB(1, 1), b3 + hstepB, voffB); PG8_STAGE(PG8_SA(1, 0), a3, voffA);
            PG8_WAIT_V(8); PG8_WAIT_L(0); PG8_BAR; PG8_MMA(1, 0, At, B0); PG8_MMA(1, 1, At, B1); PG8_BAR; PG8_SCHED;
        }
        if (wr == 0) PG8_BAR;
        E(acc, cur, wr, wc, fr, fq, lds);
        if (!has_next) break;
#pragma unroll
        for (int a = 0; a < 2; ++a)
#pragma unroll
            for (int b = 0; b < 2; ++b)
#pragma unroll
                for (int m = 0; m < 4; ++m)
#pragma unroll
                    for (int n = 0; n < 2; ++n) acc[a][b][m][n] = (f32x4){0.f, 0.f, 0.f, 0.f};
        cur = nxt; cA = nA; cB = nB; ++ui;
        if (wr == 1) PG8_BAR;
    }
    PG8_WAIT_V(0);
    PG8_BAR;
#undef PG8_SA
#undef PG8_SB
#undef PG8_STAGE
#undef PG8_LDA
#undef PG8_LDB
#undef PG8_MMA
#undef PG8_WAIT_V
#undef PG8_WAIT_L
#undef PG8_BAR
#undef PG8_SCHED
}
}

typedef f32x4 AccT[2][2][4][2];

template <int MODE> struct EpiProj {
    static constexpr bool PERM = true, BINTER = true;
    bf16_t* O; int ldc; const float* rsq; unsigned* kinf;
    DI void operator()(const AccT& acc, const pg8::Unit& u, int wr, int wc, int fr, int fq, LAS unsigned char*) const {
        const int row0 = u.pm * 256 + wr * 64 + fr;
        float rs[2][4];
#pragma unroll
        for (int ai = 0; ai < 2; ++ai)
#pragma unroll
            for (int m = 0; m < 4; ++m) rs[ai][m] = rsq ? __builtin_amdgcn_rsqf(rsq[row0 + ai * 128 + m * 16] * (1.0f / DM) + EPS) : 1.0f;
        const int seg = 2 * u.pn + (wc >> 1), type = seg >> 2, hd = seg & 3;
        const float lg = __builtin_log2f(1.0f - __builtin_exp2f(-5.0f - (float)hd));
        float amax = 0.f;
#pragma unroll
        for (int ai = 0; ai < 2; ++ai)
#pragma unroll
            for (int m = 0; m < 4; ++m) {
                const int row = row0 + ai * 128 + m * 16;
                float f = rs[ai][m];
                if (MODE == 1 && seg < 8) f *= 0.08838834764831845f * LOG2E;
                if (MODE == 0) {
                    const int p = row % PP, pc = p & 127; const bool valid = p >= NVALID0;
                    if (type == 0) f = __builtin_amdgcn_exp2f(lg * (float)pc);
                    else if (type == 1) f = valid ? 0.08838834764831845f * __builtin_amdgcn_exp2f(-lg * (float)pc) : 0.f;
                    else if (type == 2) f = valid ? 1.f : 0.f;
                    else if (type == 4) f = 0.125f * LOG2E;
                }
#pragma unroll
                for (int bj = 0; bj < 2; ++bj) {
                    const int col0 = u.pn * 256 + wc * 64 + bj * 32 + 8 * fq;
                    const f32x4 v0 = acc[ai][bj][m][0] * f, v1 = acc[ai][bj][m][1] * f;
                    u32x4 w; w.x = cvtpk(v0[0], v0[1]); w.y = cvtpk(v0[2], v0[3]); w.z = cvtpk(v1[0], v1[1]); w.w = cvtpk(v1[2], v1[3]);
                    *(u32x4*)(O + (size_t)row * ldc + col0) = w;
                    if (MODE == 0 && type == 5) amax = fmaxf(amax, fmaxf(fmaxf(fmaxf(fabsf(v0[0]), fabsf(v0[1])), fmaxf(fabsf(v0[2]), fabsf(v0[3]))), fmaxf(fmaxf(fabsf(v1[0]), fabsf(v1[1])), fmaxf(fabsf(v1[2]), fabsf(v1[3])))));
                }
            }
        if (MODE == 0 && type == 5) {
#pragma unroll
            for (int o = 1; o < 64; o <<= 1) amax = fmaxf(amax, __shfl_xor(amax, o));
            if ((threadIdx.x & 63) == 0) atomicMax(kinf + hd * 2 + (wc & 1), __float_as_uint(amax));
        }
    }
};

template <int MODE> struct EpiResidual {
    static constexpr bool PERM = true, BINTER = true;
    bf16_t* HB; float* H32; float* rowsq; const float* x0; const float* meta0;
    DI void operator()(const AccT& acc, const pg8::Unit& u, int wr, int wc, int fr, int fq, LAS unsigned char*) const {
        const int row0 = u.pm * 256 + wr * 64 + fr, col0 = u.pn * 256 + wc * 64 + 8 * fq;
#pragma unroll
        for (int ai = 0; ai < 2; ++ai)
#pragma unroll
            for (int m = 0; m < 4; ++m) {
                const int row = row0 + ai * 128 + m * 16;
                bf16_t* hp = HB + (size_t)row * DM + col0;
                const float* sp = nullptr;
                if (MODE == 0) { const int b = row / PP, p = row % PP; sp = (p < NVALID0) ? nullptr : (p < BLK) ? meta0 + (size_t)(p - NVALID0) * DM + col0 : x0 + ((size_t)b * SEQ + (p - BLK)) * DM + col0; }
                f32x4 v[2][2];
#pragma unroll
                for (int bj = 0; bj < 2; ++bj) {
                    if (MODE == 0) { v[bj][0] = sp ? *(const f32x4*)(sp + bj * 32) : (f32x4){0.f, 0.f, 0.f, 0.f}; v[bj][1] = sp ? *(const f32x4*)(sp + bj * 32 + 4) : (f32x4){0.f, 0.f, 0.f, 0.f}; }
                    else { const u32x4 q = *(const u32x4*)(hp + bj * 32);
                        v[bj][0] = (f32x4){__uint_as_float(q.x << 16), __uint_as_float(q.x & 0xffff0000u), __uint_as_float(q.y << 16), __uint_as_float(q.y & 0xffff0000u)};
                        v[bj][1] = (f32x4){__uint_as_float(q.z << 16), __uint_as_float(q.z & 0xffff0000u), __uint_as_float(q.w << 16), __uint_as_float(q.w & 0xffff0000u)}; }
                }
                float ss = 0.f;
#pragma unroll
                for (int bj = 0; bj < 2; ++bj) {
                    const f32x4 h0 = v[bj][0] + acc[ai][bj][m][0], h1 = v[bj][1] + acc[ai][bj][m][1];
                    ss += (h0[0] * h0[0] + h0[1] * h0[1]) + (h0[2] * h0[2] + h0[3] * h0[3]) + (h1[0] * h1[0] + h1[1] * h1[1]) + (h1[2] * h1[2] + h1[3] * h1[3]);
                    if (MODE == 2) { *(f32x4*)(H32 + (size_t)row * DM + col0 + bj * 32) = h0; *(f32x4*)(H32 + (size_t)row * DM + col0 + bj * 32 + 4) = h1; }
                    else { u32x4 w; w.x = cvtpk(h0[0], h0[1]); w.y = cvtpk(h0[2], h0[3]); w.z = cvtpk(h1[0], h1[1]); w.w = cvtpk(h1[2], h1[3]); *(u32x4*)(hp + bj * 32) = w; }
                }
                ss += __shfl_xor(ss, 16); ss += __shfl_xor(ss, 32);
                if (fq == 0) atomicAdd(rowsq + row, ss);
            }
    }
};

#define DPP_SHR1(old, src) __builtin_bit_cast(float, __builtin_amdgcn_update_dpp(__builtin_bit_cast(int, (old)), __builtin_bit_cast(int, (src)), 0x111, 0xF, 0xF, false))
#define DPP_SHR2(old, src) __builtin_bit_cast(float, __builtin_amdgcn_update_dpp(__builtin_bit_cast(int, (old)), __builtin_bit_cast(int, (src)), 0x112, 0xF, 0xF, false))
#define DPP_ROR1(src) __builtin_bit_cast(float, __builtin_amdgcn_update_dpp(0, __builtin_bit_cast(int, (src)), 0x121, 0xF, 0xF, false))
#define DPP_ROR2(src) __builtin_bit_cast(float, __builtin_amdgcn_update_dpp(0, __builtin_bit_cast(int, (src)), 0x122, 0xF, 0xF, false))
struct EpiFfnUp {
    static constexpr bool PERM = true, BINTER = false;
    bf16_t* ACT; const float* wconv; const float* bconv; const float* rsq;
    DI void operator()(const AccT& acc, const pg8::Unit& u, int wr, int wc, int fr, int fq, LAS unsigned char* lds) const {
        LAS float* halo = (LAS float*)(lds + 131072);
        const int vbase = 254 * u.pm - 2;
        const int cl = wc * 32 + 8 * fq;
        const int cg0 = u.pn * 128 + cl;
        float rv[2][4], rg[2][4];
#pragma unroll
        for (int ai = 0; ai < 2; ++ai)
#pragma unroll
            for (int m = 0; m < 4; ++m) { const int v = vbase + ai * 128 + wr * 64 + m * 16 + fr; const bool inr = v >= 0 && v < MROWS;
                const float r = inr ? __builtin_amdgcn_rsqf(rsq[inr ? v : 0] * (1.0f / DM) + EPS) : 0.f;
                rv[ai][m] = r * -0.6931471805599453f; rg[ai][m] = (inr && (v % PP) >= NVALID0) ? r : 0.f; }
        f32x4 w0[2], w1[2], w2[2], bb[2];
#pragma unroll
        for (int n = 0; n < 2; ++n) {
            w0[n] = *(const f32x4*)(wconv + cg0 + 4 * n) * -LOG2E; w1[n] = *(const f32x4*)(wconv + DFF + cg0 + 4 * n) * -LOG2E; w2[n] = *(const f32x4*)(wconv + 2 * DFF + cg0 + 4 * n) * -LOG2E; bb[n] = *(const f32x4*)(bconv + cg0 + 4 * n) * -LOG2E; }
        if (fr >= 14) {
#pragma unroll
            for (int ai = 0; ai < 2; ++ai)
#pragma unroll
                for (int n = 0; n < 2; ++n) *(LAS f32x4*)(halo + ((2 * ai + wr) * 2 + (fr - 14)) * 128 + cl + 4 * n) = acc[ai][0][3][n] * rg[ai][3];
        }
        asm volatile("s_waitcnt lgkmcnt(0)" ::: "memory"); __builtin_amdgcn_s_barrier(); asm volatile("" ::: "memory");
#pragma unroll
        for (int ai = 0; ai < 2; ++ai) {
            const int grp = 2 * ai + wr;
            f32x4 pa[2], pb[2];
#pragma unroll
            for (int n = 0; n < 2; ++n) {
                if (grp > 0) {
                    const f32x4 h0 = *(LAS const f32x4*)(halo + ((grp - 1) * 2 + 0) * 128 + cl + 4 * n);
                    const f32x4 h1 = *(LAS const f32x4*)(halo + ((grp - 1) * 2 + 1) * 128 + cl + 4 * n);
                    pa[n] = h1; pb[n] = (fr == 0) ? h0 : h1;
                } else { pa[n] = (f32x4){0.f, 0.f, 0.f, 0.f}; pb[n] = pa[n]; }
            }
#pragma unroll
            for (int m = 0; m < 4; ++m) {
                const int lr = ai * 128 + wr * 64 + m * 16 + fr; const int v = vbase + lr;
                u32x4 w;
#pragma unroll
                for (int n = 0; n < 2; ++n) {
                    const f32x4 gv = acc[ai][0][m][n] * rg[ai][m];
                    f32x4 g1, g2;
#pragma unroll
                    for (int j = 0; j < 4; ++j) { float t = gv[j]; asm volatile("" : "+v"(t));
                        const float r1 = DPP_ROR1(t), r2 = DPP_ROR2(t); g1[j] = (fr >= 1) ? r1 : pa[n][j]; g2[j] = (fr >= 2) ? r2 : pb[n][j]; pa[n][j] = r1; pb[n][j] = r2; }
                    const f32x4 cv = bb[n] + w0[n] * g2 + w1[n] * g1 + w2[n] * gv;
                    const f32x4 vv = acc[ai][1][m][n] * rv[ai][m];
                    f32x4 o;
#pragma unroll
                    for (int j = 0; j < 4; ++j) o[j] = cv[j] * __builtin_amdgcn_rcpf(1.0f + __builtin_amdgcn_exp2f(cv[j])) * vv[j];
                    if (n == 0) { w.x = cvtpk(o[0], o[1]); w.y = cvtpk(o[2], o[3]); } else { w.z = cvtpk(o[0], o[1]); w.w = cvtpk(o[2], o[3]); }
                }
                if (lr >= 2 && v < MROWS) *(u32x4*)(ACT + (size_t)v * DFF + cg0) = w;
            }
        }
    }
};

template <int NCH> DI void tile_load(const bf16_t* src, int ld, u32x4 (&v)[NCH], int tid) {
#pragma unroll
    for (int i = 0; i < NCH; ++i) { const int c = tid + NTHREADS * i, row = c >> 4, ch = c & 15; v[i] = *(const u32x4*)(src + (size_t)row * ld + ch * 8); }
}
template <int NCH> DI void tile_store(LAS unsigned char* img, const u32x4 (&v)[NCH], int tid) {
#pragma unroll
    for (int i = 0; i < NCH; ++i) { const int c = tid + NTHREADS * i, row = c >> 4, ch = c & 15; *(LAS u32x4*)(img + off_b(row, ch)) = v[i]; }
}

DI void tile_dma64(const bf16_t* src, int ld, LAS unsigned char* img, int wave, int lane) {
#pragma unroll
    for (int i = 0; i < 2; ++i) {
        const unsigned L = (unsigned)((wave * 2 + i) * 64 + lane), row = L >> 4, cpos = L & 15;
        const unsigned ch = cpos ^ (((row & 3u) << 2) | ((row >> 2) & 3u));
        __builtin_amdgcn_global_load_lds((const unsigned*)(src + (size_t)row * ld + ch * 8), (LAS unsigned*)(img + (wave * 2 + i) * 1024), 16, 0, 0);
    }
}
DI void glds16(const void* gsrc, unsigned lds_dst) { unsigned keep;
    asm volatile("s_mov_b32 %0, m0\n\ts_mov_b32 m0, %2\n\ts_nop 0\n\tglobal_load_lds_dwordx4 %1, off\n\ts_mov_b32 m0, %0" : "=&s"(keep) : "v"(gsrc), "s"(lds_dst) : "memory"); }
DI void tile_dma64_asm(const bf16_t* src, int ld, LAS unsigned char* img, int wave, int lane) {
#pragma unroll
    for (int i = 0; i < 2; ++i) {
        const unsigned L = (unsigned)((wave * 2 + i) * 64 + lane), row = L >> 4, cpos = L & 15;
        const unsigned ch = cpos ^ (((row & 3u) << 2) | ((row >> 2) & 3u));
        glds16(src + (size_t)row * ld + ch * 8, (unsigned)__builtin_amdgcn_readfirstlane((int)((unsigned)(uintptr_t)img + (unsigned)(wave * 2 + i) * 1024u)));
    }
}

DI void retention_item(const Params& P, LAS unsigned char* lds, int b, int hd, int nfull0, int nend) {
    const int tid = threadIdx.x, lane = tid & 63, w = __builtin_amdgcn_readfirstlane(tid >> 6), r = lane & 31, h = lane >> 5, ib = w & 3, eh = w >> 2;
    LAS unsigned char* Qimg = lds; LAS unsigned char* Kimg = lds + 32768; LAS unsigned char* Vimg = lds + 65536; LAS unsigned char* Timg = lds + 98304;
    LAS f32x2* X = (LAS f32x2*)(lds + 131072);
    const bf16_t* proj = (const bf16_t*)(P.ws + WS_BIG) + (size_t)(b * PP) * AB_IN;
    bf16_t* MIX = (bf16_t*)P.out;
    const float lg = __builtin_log2f(1.0f - __builtin_exp2f(-5.0f - (float)hd));
    const float g128 = __builtin_exp2f(128.0f * lg);
    __syncthreads();
    for (int i = tid; i < 2048; i += NTHREADS) ((LAS u32x4*)Timg)[i] = (u32x4){0u, 0u, 0u, 0u};
    f32x16 st[2];
#pragma unroll
    for (int i = 0; i < 16; ++i) { st[0][i] = 0.f; st[1][i] = 0.f; }
    u32x4 pq[4], pk[4], pv[4];
    if (nfull0 == 0) tile_load<4>(proj + hd * 128, AB_IN, pq, tid);
    tile_load<4>(proj + 512 + hd * 128, AB_IN, pk, tid); tile_load<4>(proj + 1024 + hd * 128, AB_IN, pv, tid);
    const float* rn = P.ab_ret_norm + hd * 128;
    for (int n = 0; n < nend; ++n) {
        const bool full = n >= nfull0;
        __syncthreads();
        if (full) tile_store<4>(Qimg, pq, tid);
        tile_store<4>(Kimg, pk, tid); tile_store<4>(Vimg, pv, tid);
        __syncthreads();
        if (n + 1 < nend) { const bf16_t* s = proj + (size_t)(n + 1) * 128 * AB_IN;
            if (n + 1 >= nfull0) tile_load<4>(s + hd * 128, AB_IN, pq, tid);
            tile_load<4>(s + 512 + hd * 128, AB_IN, pk, tid); tile_load<4>(s + 1024 + hd * 128, AB_IN, pv, tid); }
        f32x16 o[2];
#pragma unroll
        for (int i = 0; i < 16; ++i) { o[0][i] = 0.f; o[1][i] = 0.f; }
        if (full) {
#pragma unroll 2
        for (int s = 0; s < 8; ++s) { const bf16x8 qv = row_frag(Qimg, 32 * ib + r, 2 * s + h);
#pragma unroll
            for (int ec = 0; ec < 2; ++ec) { const bf16x8 a = tr_nat(Timg, 16 * s, 2 * eh + ec, lane); o[ec] = MFMA32(a, qv, o[ec]); } }
        for (int jb = 0; jb <= ib; ++jb) {
            f32x16 S;
#pragma unroll
            for (int i = 0; i < 16; ++i) S[i] = 0.f;
#pragma unroll 1
            for (int s = 0; s < 8; ++s) { const bf16x8 a = row_frag(Kimg, 32 * jb + r, 2 * s + h); const bf16x8 qv = row_frag(Qimg, 32 * ib + r, 2 * s + h); S = MFMA32(a, qv, S); }
            if (jb == ib) {
#pragma unroll
                for (int i = 0; i < 16; ++i) if (CROWC(i) + 4 * h > r) S[i] = 0.f;
            }
            const bf16x8 p0 = pack8(S[0], S[1], S[2], S[3], S[4], S[5], S[6], S[7]), p1 = pack8(S[8], S[9], S[10], S[11], S[12], S[13], S[14], S[15]);
#pragma unroll
            for (int ec = 0; ec < 2; ++ec) {
                const bf16x8 a0 = tr_perm(Vimg, 32 * jb, 2 * eh + ec, lane); o[ec] = MFMA32(a0, p0, o[ec]);
                const bf16x8 a1 = tr_perm(Vimg, 32 * jb + 16, 2 * eh + ec, lane); o[ec] = MFMA32(a1, p1, o[ec]);
            }
        }
        }
#pragma unroll 1
        for (int s = 0; s < 8; ++s) {
            const bf16x8 bk = tr_nat(Kimg, 16 * s, ib, lane);
#pragma unroll
            for (int ec = 0; ec < 2; ++ec) { const bf16x8 av = tr_nat(Vimg, 16 * s, 2 * eh + ec, lane); st[ec] = MFMA32(av, bk, st[ec]); }
        }
#pragma unroll
        for (int i = 0; i < 16; ++i) { st[0][i] *= g128; st[1][i] *= g128; }
        float s1 = 0.f, s2 = 0.f;
#pragma unroll
        for (int ec = 0; ec < 2; ++ec)
#pragma unroll
            for (int i = 0; i < 16; ++i) { s1 += o[ec][i]; s2 += o[ec][i] * o[ec][i]; }
        s1 += __shfl_xor(s1, 32); s2 += __shfl_xor(s2, 32);
        if (h == 0) X[(eh * 4 + ib) * 32 + r] = (f32x2){s1, s2};
        __syncthreads();
#pragma unroll
        for (int ec = 0; ec < 2; ++ec)
#pragma unroll
            for (int g = 0; g < 4; ++g) { u32x2 wv; wv.x = cvtpk(st[ec][4 * g], st[ec][4 * g + 1]); wv.y = cvtpk(st[ec][4 * g + 2], st[ec][4 * g + 3]);
                *(LAS u32x2*)(Timg + off_b(32 * ib + r, 4 * (2 * eh + ec) + g) + 8 * h) = wv; }
        if (!full) continue;
        const f32x2 xo = X[((1 - eh) * 4 + ib) * 32 + r];
        const float mean = (s1 + xo.x) * (1.0f / 128.0f);
        const float var = (s2 + xo.y) * (1.0f / 128.0f) - mean * mean;
        const float rstd = __builtin_amdgcn_rsqf(fmaxf(var, 0.f) + EPS);
        const size_t m = (size_t)(b * PP) + n * 128 + 32 * ib + r;
        const bf16_t* rg = (const bf16_t*)(P.ws + WS_BIG) + m * AB_IN + 1536 + hd * 128;
        bf16_t* op = MIX + m * DM + hd * 128;
#pragma unroll
        for (int ec = 0; ec < 2; ++ec)
#pragma unroll
            for (int g = 0; g < 4; ++g) {
                const int e = 32 * (2 * eh + ec) + 8 * g + 4 * h;
                const u32x2 gr = *(const u32x2*)(rg + e);
                const f32x4 nw = *(const f32x4*)(rn + e);
                float gate[4] = {__uint_as_float(gr.x << 16), __uint_as_float(gr.x & 0xffff0000u), __uint_as_float(gr.y << 16), __uint_as_float(gr.y & 0xffff0000u)};
                float y[4];
#pragma unroll
                for (int j = 0; j < 4; ++j) { const float sg = gate[j] * __builtin_amdgcn_rcpf(1.0f + __builtin_amdgcn_exp2f(-LOG2E * gate[j])); y[j] = (o[ec][4 * g + j] - mean) * rstd * nw[j] * sg; }
                u32x2 wv; wv.x = cvtpk(y[0], y[1]); wv.y = cvtpk(y[2], y[3]);
                *(u32x2*)(op + e) = wv;
            }
    }
}

DI void diffattn_item(const Params& P, LAS unsigned char* lds, int b, int hd, int qb, float lam, const float* kinf) {
    const int tid = threadIdx.x, lane = tid & 63, w = __builtin_amdgcn_readfirstlane(tid >> 6), r = lane & 31, h = lane >> 5, wq = w & 3, mp = w >> 2;
    LAS float* XO = (LAS float*)lds;
    LAS unsigned* flags = (LAS unsigned*)(lds + 131072);
    const bf16_t* proj = (const bf16_t*)(P.ws + WS_BIG) + (size_t)(b * PP) * AB_IN;
    bf16_t* MIX = (bf16_t*)P.out;
    const int qpos = 128 * qb + 32 * wq + r;
    const float slope = __builtin_exp2f(-2.0f * (float)(hd + 1));
    const float c2 = slope * LOG2E;
    bf16x8 qf[4];
    float q1 = 0.f;
    { const bf16_t* qp = proj + (size_t)qpos * AB_IN + 2048 + hd * 128 + mp * 64 + 8 * h;
#pragma unroll
      for (int s = 0; s < 4; ++s) { qf[s] = *(const bf16x8*)(qp + 16 * s);
#pragma unroll
          for (int j = 0; j < 8; ++j) q1 += fabsf(bf2f((unsigned short)qf[s][j])); } }
    q1 += __shfl_xor(q1, 32);
    const float sbound = q1 * kinf[hd * 2 + mp] * 1.01f + 1.0f;
    f32x16 O[4];
#pragma unroll
    for (int c = 0; c < 4; ++c)
#pragma unroll
        for (int i = 0; i < 16; ++i) O[c][i] = 0.f;
    float mrun = -1e30f, lrun = 0.f;
    const int ktop = 2 * qb + 1;
    unsigned vlo0, vhi0; tr_perm_offs(0, lane, vlo0, vhi0);
    const unsigned kof0 = off_b(r, 8 * mp + h);
#define DF_DMA(kt_, slot_) do { LAS unsigned char* nb_ = lds + (slot_) * 32768; \
        tile_dma64_asm(proj + (size_t)(64 * (kt_)) * AB_IN + 2560 + hd * 128, AB_IN, nb_, w, lane); \
        tile_dma64_asm(proj + (size_t)(64 * (kt_)) * AB_IN + 3072 + hd * 128, AB_IN, nb_ + 16384, w, lane); } while (0)
#define DF_QK(Sa, Sb, slot_) do { LAS unsigned char* kb_ = lds + (slot_) * 32768; \
        _Pragma("unroll") for (int i = 0; i < 16; ++i) { Sa[i] = 0.f; Sb[i] = 0.f; } \
        bf16x8 ka_[8]; \
        _Pragma("unroll") for (int s = 0; s < 4; ++s) { ka_[2 * s] = *(LAS const bf16x8*)(kb_ + (kof0 ^ (32u * s))); ka_[2 * s + 1] = *(LAS const bf16x8*)(kb_ + (kof0 ^ (32u * s)) + 8192); } \
        __builtin_amdgcn_sched_barrier(0); \
        _Pragma("unroll") for (int s = 0; s < 4; ++s) { Sa = MFMA32(ka_[2 * s], qf[s], Sa); Sb = MFMA32(ka_[2 * s + 1], qf[s], Sb); } } while (0)
    __syncthreads();
    DF_DMA(ktop, 0); DF_DMA(ktop - 1, 1);
    if (tid < 16) flags[tid] = 0u;
    asm volatile("s_waitcnt vmcnt(0)" ::: "memory");
    __syncthreads();
    f32x16 S0, S1;
    DF_QK(S0, S1, 0);
    int slot = 0;
    bf16x8 pp0 = {0, 0, 0, 0, 0, 0, 0, 0}, pp1 = pp0, pp2 = pp0, pp3 = pp0;
    LAS unsigned char* vprev = lds + 16384;
#define DF_LDV(c_, dst_, Vimg_) do { const unsigned vl_ = vlo0 ^ (64u * (c_)), vh_ = vhi0 ^ (64u * (c_)); \
        dst_[0] = tr_at(Vimg_, vl_, vh_, 0); dst_[1] = tr_at(Vimg_, vl_, vh_, 4096); dst_[2] = tr_at(Vimg_, vl_, vh_, 8192); dst_[3] = tr_at(Vimg_, vl_, vh_, 12288); } while (0)
#define DF_EXP4(S_, b_) do { _Pragma("unroll") for (int i_ = 0; i_ < 4; ++i_) { float e_ = __builtin_amdgcn_exp2f(S_[(b_) + i_] + dl); asm volatile("" : "+v"(e_));   S_[(b_) + i_] = e_; ps += e_; } } while (0)
    for (int kt = ktop; kt >= 0; --kt) {
        asm volatile("s_waitcnt vmcnt(0) lgkmcnt(0)\n\ts_barrier" ::: "memory");
        { LAS const unsigned* fr_ = flags + ((kt + 1) & 1) * 8;
          const u32x4 f0 = *(LAS const u32x4*)fr_, f1 = *(LAS const u32x4*)(fr_ + 4);
          if ((f0.x & f0.y & f0.z & f0.w & f1.x & f1.y & f1.z & f1.w) != 0u) break; }
        const int slot1 = (slot + 1) & 3;
        if (kt >= 2) DF_DMA(kt - 2, (slot + 2) & 3);
        LAS unsigned char* Vimg = lds + slot * 32768 + 16384;
        const bool boundary = (kt >= 2 * qb) || (kt < 2);
        const int k0 = 64 * kt + 4 * h;
        const float u0 = c2 * (float)(k0 - qpos);
        float amax = -3.0e38f;
        if (boundary) {
#pragma unroll
            for (int i = 0; i < 16; ++i) {
                float t0 = fmaf(c2, (float)CROWC(i), S0[i]), t1 = fmaf(c2, (float)(32 + CROWC(i)), S1[i]);
                const int kp = k0 + CROWC(i); if (kp > qpos || kp < NVALID0) t0 = -1e30f; if (kp + 32 > qpos || kp + 32 < NVALID0) t1 = -1e30f;
                S0[i] = t0; S1[i] = t1; amax = fmaxf(amax, fmaxf(t0, t1));
            }
        } else {
#pragma unroll
            for (int i = 0; i < 16; ++i) {
                const float t0 = fmaf(c2, (float)CROWC(i), S0[i]), t1 = fmaf(c2, (float)(32 + CROWC(i)), S1[i]);
                S0[i] = t0; S1[i] = t1; amax = fmaxf(amax, fmaxf(t0, t1));
            }
        }
        amax = fmaxf(amax + u0, -1e30f);
        const float bmax = fmaxf(amax, __shfl_xor(amax, 32));
        const float mold = mrun;
        mrun = fmaxf(mrun, bmax);
        const float dl = u0 - mrun;
        float ps = 0.f;
        {
            bf16x8 va[2][4];
            DF_LDV(0, va[0], vprev);
            DF_LDV(1, va[1], vprev);
            __builtin_amdgcn_sched_barrier(0);
            O[0] = MFMA32(va[0][0], pp0, O[0]); O[0] = MFMA32(va[0][1], pp1, O[0]); O[0] = MFMA32(va[0][2], pp2, O[0]); O[0] = MFMA32(va[0][3], pp3, O[0]);
            DF_EXP4(S0, 0); DF_EXP4(S1, 0);
            __builtin_amdgcn_sched_barrier(0);
            DF_LDV(2, va[0], vprev);
            O[1] = MFMA32(va[1][0], pp0, O[1]); O[1] = MFMA32(va[1][1], pp1, O[1]); O[1] = MFMA32(va[1][2], pp2, O[1]); O[1] = MFMA32(va[1][3], pp3, O[1]);
            DF_EXP4(S0, 4); DF_EXP4(S1, 4);
            __builtin_amdgcn_sched_barrier(0);
            DF_LDV(3, va[1], vprev);
            O[2] = MFMA32(va[0][0], pp0, O[2]); O[2] = MFMA32(va[0][1], pp1, O[2]); O[2] = MFMA32(va[0][2], pp2, O[2]); O[2] = MFMA32(va[0][3], pp3, O[2]);
            DF_EXP4(S0, 8); DF_EXP4(S1, 8);
            __builtin_amdgcn_sched_barrier(0);
            O[3] = MFMA32(va[1][0], pp0, O[3]); O[3] = MFMA32(va[1][1], pp1, O[3]); O[3] = MFMA32(va[1][2], pp2, O[3]); O[3] = MFMA32(va[1][3], pp3, O[3]);
            DF_EXP4(S0, 12); DF_EXP4(S1, 12);
            __builtin_amdgcn_sched_barrier(0);
        }
        if (__any(mrun > mold)) {
            const float al = __builtin_amdgcn_exp2f(mold - mrun);
            lrun *= al;
#pragma unroll
            for (int c = 0; c < 4; ++c)
#pragma unroll
                for (int i = 0; i < 16; ++i) O[c][i] *= al;
        }
        lrun += ps;
        pp0 = pack8(S0[0], S0[1], S0[2], S0[3], S0[4], S0[5], S0[6], S0[7]); pp1 = pack8(S0[8], S0[9], S0[10], S0[11], S0[12], S0[13], S0[14], S0[15]);
        pp2 = pack8(S1[0], S1[1], S1[2], S1[3], S1[4], S1[5], S1[6], S1[7]); pp3 = pack8(S1[8], S1[9], S1[10], S1[11], S1[12], S1[13], S1[14], S1[15]);
        vprev = Vimg;
        const bool okw = __all(sbound + c2 * (float)(64 * kt - 1 - qpos) - mrun < -150.0f);
        if (lane == 0) flags[(kt & 1) * 8 + w] = okw ? 1u : 0u;
        if (kt >= 1) DF_QK(S0, S1, slot1);
        slot = slot1;
    }
    {
        bf16x8 va[2][4];
        DF_LDV(0, va[0], vprev);
#pragma unroll
        for (int c = 0; c < 4; ++c) { if (c < 3) DF_LDV(c + 1, va[(c + 1) & 1], vprev); __builtin_amdgcn_sched_barrier(0);
            O[c] = MFMA32(va[c & 1][0], pp0, O[c]); O[c] = MFMA32(va[c & 1][1], pp1, O[c]); O[c] = MFMA32(va[c & 1][2], pp2, O[c]); O[c] = MFMA32(va[c & 1][3], pp3, O[c]);
            __builtin_amdgcn_sched_barrier(0); }
    }
#undef DF_EXP4
#undef DF_LDV
#undef DF_DMA
#undef DF_QK
    asm volatile("s_waitcnt vmcnt(0)" ::: "memory");
    __syncthreads();
    lrun += __shfl_xor(lrun, 32);
    const float inv = 1.0f / lrun;
    if (mp == 1) {
#pragma unroll
        for (int c = 0; c < 4; ++c)
#pragma unroll
            for (int i = 0; i < 16; ++i) XO[(wq * 64 + c * 16 + i) * 64 + lane] = O[c][i] * inv;
    }
    __syncthreads();
    if (mp == 0) {
        float ss = 0.f;
#pragma unroll
        for (int c = 0; c < 4; ++c)
#pragma unroll
            for (int i = 0; i < 16; ++i) { const float d = O[c][i] * inv - lam * XO[(wq * 64 + c * 16 + i) * 64 + lane]; O[c][i] = d; ss += d * d; }
        ss += __shfl_xor(ss, 32);
        const float rs = __builtin_amdgcn_rsqf(ss * (1.0f / 128.0f) + EPS) * 0.8f;
        const float* dn = P.ab_diff_norm + hd * 128;
        bf16_t* op = MIX + (size_t)(b * PP + qpos) * DM + 512 + hd * 128;
#pragma unroll
        for (int c = 0; c < 4; ++c)
#pragma unroll
            for (int g = 0; g < 4; ++g) {
                const int e = 32 * c + 8 * g + 4 * h;
                const f32x4 nw = *(const f32x4*)(dn + e);
                u32x2 wv; wv.x = cvtpk(O[c][4 * g] * rs * nw[0], O[c][4 * g + 1] * rs * nw[1]); wv.y = cvtpk(O[c][4 * g + 2] * rs * nw[2], O[c][4 * g + 3] * rs * nw[3]);
                *(u32x2*)(op + e) = wv;
            }
    }
}

DI void sb_block(f32x16& S, float& C, int k0, int qpos, int h, bool boundary) {
    float L[16]; float seg[4];
#pragma unroll
    for (int g = 0; g < 4; ++g) seg[g] = 0.f;
#pragma unroll
    for (int i = 0; i < 16; ++i) {
        const float z = S[i];
        const float e = __builtin_amdgcn_exp2f(-fabsf(z));
        const float sp = fmaxf(z, 0.f) + __builtin_amdgcn_logf(1.0f + e);
        bool ok = true;
        if (boundary) { const int kp = k0 + CROWC(i); ok = (kp < qpos) && (kp >= NVALID0); }
        L[i] = ok ? -sp : 0.f;
        S[i] = ok ? (z - sp) : -1e30f;
        seg[i >> 2] += L[i];
    }
    float oseg[4];
#pragma unroll
    for (int g = 0; g < 4; ++g) oseg[g] = __shfl_xor(seg[g], 32);
    float R = 0.f;
#pragma unroll
    for (int gi = 0; gi < 4; ++gi) {
        const int g = 3 - gi;
        float lat = C + R + (h == 0 ? oseg[g] : 0.f);
        S[4 * g + 3] = __builtin_amdgcn_exp2f(S[4 * g + 3] + lat); lat += L[4 * g + 3];
        S[4 * g + 2] = __builtin_amdgcn_exp2f(S[4 * g + 2] + lat); lat += L[4 * g + 2];
        S[4 * g + 1] = __builtin_amdgcn_exp2f(S[4 * g + 1] + lat); lat += L[4 * g + 1];
        S[4 * g + 0] = __builtin_amdgcn_exp2f(S[4 * g + 0] + lat);
        R += seg[g] + oseg[g];
    }
    C += R;
}
DI void stickbreak_item(const Params& P, LAS unsigned char* lds, int b, int hp, int qb) {
    const int tid = threadIdx.x, lane = tid & 63, w = __builtin_amdgcn_readfirstlane(tid >> 6), r = lane & 31, h = lane >> 5, wq = w & 3, hs = w >> 2;
    const int hd = 2 * hp + hs;
    LAS unsigned* flags = (LAS unsigned*)(lds + 131072);
    const bf16_t* proj = (const bf16_t*)(P.ws + WS_BIG) + (size_t)(b * PP) * C_IN;
    bf16_t* MIX = (bf16_t*)P.out;
    const int qpos = 128 * qb + 32 * wq + r;
    bf16x8 qf[8];
    { const bf16_t* qp = proj + (size_t)qpos * C_IN + hd * 128 + 8 * h;
#pragma unroll
      for (int s = 0; s < 8; ++s) qf[s] = *(const bf16x8*)(qp + 16 * s); }
    f32x16 O[4];
#pragma unroll
    for (int c = 0; c < 4; ++c)
#pragma unroll
        for (int i = 0; i < 16; ++i) O[c][i] = 0.f;
    float C = 0.f;
    const int ktop = 2 * qb + 1;
    unsigned vlo0, vhi0; tr_perm_offs(0, lane, vlo0, vhi0);
    const unsigned kof0 = off_b(r, h);
    __syncthreads();
#define SB_DMA(kt_, base_) do { const bf16_t* s_ = proj + (size_t)(64 * (kt_)) * C_IN + hp * 256; \
        tile_dma64_asm(s_ + 1024, C_IN, (base_), w, lane); tile_dma64_asm(s_ + 1024 + 128, C_IN, (base_) + 16384, w, lane); \
        tile_dma64_asm(s_ + 2048, C_IN, (base_) + 32768, w, lane); tile_dma64_asm(s_ + 2048 + 128, C_IN, (base_) + 49152, w, lane); } while (0)
    SB_DMA(ktop, lds);
    if (tid < 16) flags[tid] = 0u;
    int cur = 0;
    for (int kt = ktop; kt >= 0; --kt) {
        asm volatile("s_waitcnt vmcnt(0)" ::: "memory");
        __syncthreads();
        { LAS const unsigned* fr_ = flags + ((kt + 1) & 1) * 8;
          const u32x4 f0 = *(LAS const u32x4*)fr_, f1 = *(LAS const u32x4*)(fr_ + 4);
          if ((f0.x & f0.y & f0.z & f0.w & f1.x & f1.y & f1.z & f1.w) != 0u) break; }
        LAS unsigned char* Kimg = lds + cur * 65536 + hs * 16384; LAS unsigned char* Vimg = Kimg + 32768;
        if (kt > 0) SB_DMA(kt - 1, lds + (cur ^ 1) * 65536);
        cur ^= 1;
        const bool boundary = (kt >= 2 * qb) || (kt < 2);
        const bool skip = (64 * kt >= 128 * qb + 32 * wq + 32);
        if (!skip) {
            f32x16 S0, S1;
#pragma unroll
            for (int i = 0; i < 16; ++i) { S0[i] = 0.f; S1[i] = 0.f; }
#pragma unroll
            for (int s = 0; s < 8; ++s) { const bf16x8 a0 = *(LAS const bf16x8*)(Kimg + (kof0 ^ (32u * s))), a1 = *(LAS const bf16x8*)(Kimg + (kof0 ^ (32u * s)) + 8192);
                S0 = MFMA32(a0, qf[s], S0); S1 = MFMA32(a1, qf[s], S1); }
            sb_block(S1, C, 64 * kt + 32 + 4 * h, qpos, h, boundary);
            sb_block(S0, C, 64 * kt + 4 * h, qpos, h, boundary);
            const bf16x8 p0 = pack8(S0[0], S0[1], S0[2], S0[3], S0[4], S0[5], S0[6], S0[7]), p1 = pack8(S0[8], S0[9], S0[10], S0[11], S0[12], S0[13], S0[14], S0[15]);
            const bf16x8 p2 = pack8(S1[0], S1[1], S1[2], S1[3], S1[4], S1[5], S1[6], S1[7]), p3 = pack8(S1[8], S1[9], S1[10], S1[11], S1[12], S1[13], S1[14], S1[15]);
#pragma unroll
            for (int c = 0; c < 4; ++c) {
                const unsigned vl = vlo0 ^ (64u * c), vh = vhi0 ^ (64u * c);
                const bf16x8 a0 = tr_at(Vimg, vl, vh, 0), a1 = tr_at(Vimg, vl, vh, 4096), a2 = tr_at(Vimg, vl, vh, 8192), a3 = tr_at(Vimg, vl, vh, 12288);
                O[c] = MFMA32(a0, p0, O[c]); O[c] = MFMA32(a1, p1, O[c]); O[c] = MFMA32(a2, p2, O[c]); O[c] = MFMA32(a3, p3, O[c]);
            }
        }
        const bool okw = __all(C < -160.0f);
        if (lane == 0) flags[(kt & 1) * 8 + w] = okw ? 1u : 0u;
    }
#undef SB_DMA
    bf16_t* op = MIX + (size_t)(b * PP + qpos) * DM + hd * 128;
#pragma unroll
    for (int c = 0; c < 4; ++c)
#pragma unroll
        for (int g = 0; g < 4; ++g) {
            const int e = 32 * c + 8 * g + 4 * h;
            u32x2 wv; wv.x = cvtpk(O[c][4 * g], O[c][4 * g + 1]); wv.y = cvtpk(O[c][4 * g + 2], O[c][4 * g + 3]);
            *(u32x2*)(op + e) = wv;
        }
}

DI unsigned f2bf(float f) { unsigned u = __builtin_bit_cast(unsigned, f); return (u + 0x7fffu + ((u >> 16) & 1u)) >> 16; }
DI unsigned pk2(float lo, float hi) { return f2bf(lo) | (f2bf(hi) << 16); }
DI void transpose_item(const float* W, int K, int N, bf16_t* WT, bool ffn_perm, LAS float* scr, int item, int lane, const float* kgain = nullptr) {
    const int nblk = N / 32, kb = item / nblk, nb = item % nblk, k0 = 64 * kb, n0 = 32 * nb;
#pragma unroll 8
    for (int i = 0; i < 32; ++i) { const int kk = 2 * i + (lane >> 5); const float gk = kgain ? kgain[k0 + kk] : 1.0f; scr[kk * 33 + (lane & 31)] = W[(size_t)(k0 + kk) * N + n0 + (lane & 31)] * gk; }
    asm volatile("s_waitcnt lgkmcnt(0)" ::: "memory");
    const int c = lane & 7;
#pragma unroll
    for (int j = 0; j < 4; ++j) { const int n = (lane >> 3) + 8 * j; const LAS float* s = scr + (8 * c) * 33 + n;
        u32x4 o; o.x = pk2(s[0 * 33], s[1 * 33]); o.y = pk2(s[2 * 33], s[3 * 33]); o.z = pk2(s[4 * 33], s[5 * 33]); o.w = pk2(s[6 * 33], s[7 * 33]);
        int col = n0 + n, drow = col;
        if (ffn_perm) { const int isval = col >= DFF; const int cc = isval ? col - DFF : col; drow = (cc >> 7) * 256 + isval * 128 + (cc & 127); }
        *(u32x4*)(WT + (size_t)drow * K + k0 + 8 * c) = o; }
    asm volatile("s_waitcnt lgkmcnt(0)" ::: "memory");
}
DI void norm_store_bf16(const f32x4 (&v)[4], const float* gain, bf16_t* orow, int lane) {
    float s = 0.f;
#pragma unroll
    for (int j = 0; j < 4; ++j) s += (v[j].x * v[j].x + v[j].y * v[j].y) + (v[j].z * v[j].z + v[j].w * v[j].w);
    const float rstd = __builtin_amdgcn_rsqf(wave_sum(s) * (1.0f / DM) + EPS);
#pragma unroll
    for (int jj = 0; jj < 2; ++jj) { const f32x4 g0 = *(const f32x4*)(gain + 8 * lane + 512 * jj), g1 = *(const f32x4*)(gain + 8 * lane + 512 * jj + 4);
        const f32x4 a = v[2 * jj] * rstd * g0, b = v[2 * jj + 1] * rstd * g1;
        u32x4 wv; wv.x = cvtpk(a.x, a.y); wv.y = cvtpk(a.z, a.w); wv.z = cvtpk(b.x, b.y); wv.w = cvtpk(b.z, b.w);
        *(u32x4*)(orow + 8 * lane + 512 * jj) = wv; }
}

#ifdef NO_RET
#define RET_CALL
#else
#define RET_CALL retention_item(P, lds, (it & 31) >> 2, it & 3, (it < 32) ? 36 : 0, (it < 32) ? 65 : 36);
#endif
#ifdef NO_DIFF
#define DIFF_CALL
#else
#define DIFF_CALL diffattn_item(P, lds, bh >> 2, bh & 3, 64 - (j >> 5), lam, (const float*)(ctl + 16));
#endif
#ifdef NO_SB
#define SB_CALL
#else
#define SB_CALL stickbreak_item(P, lds, bh >> 2, bh & 3, 64 - (it >> 5));
#endif
constexpr int I_OUT = (DM / 64) * (DM / 32), I_UP = (DM / 64) * (2 * DFF / 32), I_DN = (DFF / 64) * (DM / 32), I_IN1 = (DM / 64) * (C_IN / 32);
DI void deferred_convert(const Params& P, LAS unsigned char* lds, unsigned* ctr, int group, int wave, int lane) {
    LAS float* scr = (LAS float*)(lds + wave * 16384);
    const int total = group == 0 ? (I_OUT + I_UP + I_DN) : (I_IN1 + I_OUT + I_UP + I_DN);
    for (;;) {
        int it = 0; if (lane == 0) it = (int)atomicAdd(ctr, 1u);
        it = __builtin_amdgcn_readfirstlane(it);
        if (it >= total) break;
        int q = it;
        if (group == 0) {
            if (q < I_UP) { transpose_item(P.ffn_up, DM, 2 * DFF, (bf16_t*)(P.ws + WS_WUP0), true, scr, q, lane, P.ffn_norm); continue; } q -= I_UP;
            if (q < I_DN) { transpose_item(P.ffn_down, DFF, DM, (bf16_t*)(P.ws + WS_WDN0), false, scr, q, lane); continue; } q -= I_DN;
            transpose_item(P.ab_w_out, DM, DM, (bf16_t*)(P.ws + WS_WOUT0), false, scr, q, lane);
        } else {
            if (q < I_UP) { transpose_item(P.ffn_up + (size_t)DM * 2 * DFF, DM, 2 * DFF, (bf16_t*)(P.ws + WS_WUP1), true, scr, q, lane, P.ffn_norm + DM); continue; } q -= I_UP;
            if (q < I_DN) { transpose_item(P.ffn_down + (size_t)DFF * DM, DFF, DM, (bf16_t*)(P.ws + WS_WDN1), false, scr, q, lane); continue; } q -= I_DN;
            if (q < I_IN1) { transpose_item(P.c_w_in, DM, C_IN, (bf16_t*)(P.ws + WS_WIN1), false, scr, q, lane, P.mix_norm + DM); continue; } q -= I_IN1;
            transpose_item(P.c_w_out, DM, DM, (bf16_t*)(P.ws + WS_WOUT1), false, scr, q, lane);
        }
    }
}


#define XB_TMO      128
#define XB_XCNT(j)  (256  + 64 * (j))
#define XB_XSUB(j)  (1280 + 64 * (j))
#define XB_XGEN(j)  (2304 + 64 * (j))
#define XB_TOP      3328
#define XB_TOPGEN   3392
#define XCD_BAR_WORDS 3456
#define XB_SPIN_CAP (1u << 18)

__device__ __forceinline__ unsigned xb_ld(unsigned* p)              { return __hip_atomic_load(p, __ATOMIC_RELAXED, __HIP_MEMORY_SCOPE_AGENT); }
__device__ __forceinline__ unsigned xb_add(unsigned* p, unsigned v) { return __hip_atomic_fetch_add(p, v, __ATOMIC_RELAXED, __HIP_MEMORY_SCOPE_AGENT); }
__device__ __forceinline__ unsigned xb_xcc_id() { return (unsigned)__builtin_amdgcn_s_getreg((3 << 11) | 20) & 0xFu; }
#define XB_SPIN(cond, bar) do { unsigned _sp = 0; while (cond) { __builtin_amdgcn_s_sleep(1); \
    if ((++_sp & 255u) == 0u) { if (xb_ld(&(bar)[XB_TMO])) break; if (_sp > XB_SPIN_CAP) { atomicAdd(&(bar)[XB_TMO], 1u); break; } } } } while (0)

struct XcdBarrier {
    unsigned* bar; unsigned x;
    volatile LAS unsigned* st;
};

__device__ __forceinline__ XcdBarrier xcd_barrier_post(unsigned* bar, volatile LAS unsigned* st) {
    XcdBarrier b; b.bar = bar; b.x = xb_xcc_id(); b.st = st;
    if (threadIdx.x == 0) (void)xb_add(&bar[XB_XCNT(b.x)], 1u);
    return b;
}
__device__ __forceinline__ void xcd_barrier_complete(unsigned* bar, unsigned x, unsigned& nloc, unsigned& nx) {
    const unsigned G = gridDim.x * gridDim.y * gridDim.z;
    unsigned sum, cnt, mine, sp = 0u;
    for (;;) {
        sum = 0u; cnt = 0u; mine = 0u;
#pragma unroll
        for (unsigned j = 0; j < 16; ++j) { const unsigned c = xb_ld(&bar[XB_XCNT(j)]); sum += c; cnt += (c > 0u) ? 1u : 0u; mine = (j == x) ? c : mine; }
        if (sum == G) break;
        __builtin_amdgcn_s_sleep(1);
        if ((++sp & 255u) == 0u) { if (xb_ld(&bar[XB_TMO])) break; if (sp > XB_SPIN_CAP) { atomicAdd(&bar[XB_TMO], 1u); break; } }
    }
    nloc = mine > 0u ? mine : 1u; nx = cnt > 0u ? cnt : 1u;
}

__device__ __forceinline__ void xcd_barrier(const XcdBarrier& b) {
    asm volatile("s_waitcnt vmcnt(0)" ::: "memory");
    __syncthreads();
    if (threadIdx.x == 0) {
        unsigned* bar = b.bar;
        __builtin_amdgcn_s_waitcnt(0);
        unsigned nloc = b.st[0], nx = b.st[1];
        if (nloc == 0u) { xcd_barrier_complete(bar, b.x, nloc, nx); b.st[0] = nloc; b.st[1] = nx; }
        const unsigned old = xb_add(&bar[XB_XSUB(b.x)], 1u);
        const unsigned gen = old / nloc;
        if (old + 1u == (gen + 1u) * nloc) {
            __builtin_amdgcn_fence(__ATOMIC_RELEASE, "agent");
            asm volatile("s_waitcnt vmcnt(0)" ::: "memory");
            const unsigned og = xb_add(&bar[XB_TOP], 1u);
            const unsigned tg = og / nx;
            if (og + 1u == (tg + 1u) * nx) xb_add(&bar[XB_TOPGEN], 1u);
            else XB_SPIN(xb_ld(&bar[XB_TOPGEN]) == tg, bar);
            __builtin_amdgcn_fence(__ATOMIC_ACQUIRE, "agent");
            xb_add(&bar[XB_XGEN(b.x)], 1u);
            asm volatile("s_waitcnt vmcnt(0)" ::: "memory");
        } else {
            XB_SPIN(xb_ld(&bar[XB_XGEN(b.x)]) == gen, bar);
            __builtin_amdgcn_fence(__ATOMIC_ACQUIRE, "agent");
            asm volatile("s_waitcnt vmcnt(0)" ::: "memory");
        }
    }
    __syncthreads();
}


#ifndef DUP_MASK
#define DUP_MASK 0
#endif
#define NREP(k) (1 + ((DUP_MASK >> (k)) & 1))
constexpr int LDS_BYTES = 147456;
constexpr int NPHASES = 12;

__global__ void __launch_bounds__(NTHREADS, 2) fwd_megakernel(Params P) {
    extern __shared__ __attribute__((aligned(16))) unsigned char lds_raw[];
    LAS unsigned char* lds = (LAS unsigned char*)lds_raw;
    cg::grid_group grid = cg::this_grid();
    const int tid = threadIdx.x, lane = tid & 63, wave = __builtin_amdgcn_readfirstlane(tid >> 6);
    const int G = gridDim.x, gw = blockIdx.x * 8 + wave, NGW = G * 8;
    unsigned* ctl = (unsigned*)(P.ws + WS_CTL);
    bf16_t* Y = (bf16_t*)(P.ws + WS_Y);
    float* H = (float*)(P.ws + WS_H);
    bf16_t* BIG = (bf16_t*)(P.ws + WS_BIG);
    const int lo = P.ph_lo, hi = P.ph_hi;
#define IN(k) (lo <= (k) && (k) < hi)
#define SEAM(k) do { if (IN(k) && IN((k) + 1)) xcd_barrier(xbar); } while (0)

    if (IN(0)) {
        if (blockIdx.x == 0) { if (tid < 64) ctl[tid] = 0u; for (int i = tid; i < XCD_BAR_WORDS; i += NTHREADS) ctl[1024 + i] = 0u; }
        { float* rz = (float*)(P.ws + WS_RSQ); for (int i = blockIdx.x * NTHREADS + tid; i < 4 * MROWS; i += G * NTHREADS) rz[i] = 0.f; }
        LAS float* scr = (LAS float*)(lds + wave * 16384);
        constexpr int I_IN0 = (DM / 64) * (AB_IN / 32);
        for (int it = gw; it < I_IN0; it += NGW) transpose_item(P.ab_w_in, DM, AB_IN, (bf16_t*)(P.ws + WS_WIN0), false, scr, it, lane);
        for (int m = gw; m < MROWS; m += NGW) {
            const int b = m / PP, p = m % PP;
            f32x4 v[4];
            if (p < NVALID0) {
#pragma unroll
                for (int j = 0; j < 4; ++j) v[j] = (f32x4){0.f, 0.f, 0.f, 0.f};
            } else {
                const float* src = (p < BLK) ? P.meta + (size_t)(p - NVALID0) * DM : P.x + ((size_t)b * SEQ + (p - BLK)) * DM;
#pragma unroll
                for (int j = 0; j < 4; ++j) v[j] = *(const f32x4*)(src + 8 * lane + 512 * (j >> 1) + 4 * (j & 1));
            }
            norm_store_bf16(v, P.mix_norm, Y + (size_t)m * DM, lane);
        }
    }
    XcdBarrier xbar; xbar.bar = ctl + 1024; xbar.x = 0; xbar.st = (volatile LAS unsigned*)(lds + 147456 - 32);
    if (IN(0) && IN(1)) {
        grid.sync();
        if (tid == 0) { xbar.st[0] = 0u; xbar.st[1] = 0u; }
        __syncthreads();
        xbar = xcd_barrier_post(ctl + 1024, (volatile LAS unsigned*)(lds + 147456 - 32));
    }
    float* RSQ = (float*)(P.ws + WS_RSQ);
    bf16_t* MIXB = (bf16_t*)P.out;
    if (IN(1)) {
        pg8::Gemm g{Y, (const bf16_t*)(P.ws + WS_WIN0), DM, 256}; pg8::StaticOrder S; S.init(MROWS / 256, AB_IN / 256, G, (int)blockIdx.x);
        EpiProj<0> E{BIG, AB_IN, nullptr, ctl + 16};
        for (int rep = 0; rep < NREP(1); ++rep) pg8::gemm_phase(lds, g, S, E);
        deferred_convert(P, lds, ctl + 8, 0, wave, lane);
    }
    SEAM(1);
    if (IN(2)) {
        float d1 = 0.f, d2 = 0.f;
        for (int i = 0; i < 64; ++i) { d1 += P.lq1[i] * P.lk1[i]; d2 += P.lq2[i] * P.lk2[i]; }
        const float lam = __expf(d1) - __expf(d2) + 0.2f;
        LAS int* itm = (LAS int*)(lds + 147456 - 64);
        for (int rep = 0; rep < NREP(2); ++rep) {
#define FETCH_ITEM(dst) do { __syncthreads(); if (tid == 0) itm[0] = (int)atomicAdd(&ctl[0 + 4 * rep], 1u); __syncthreads(); dst = itm[0]; } while (0)
            int it; FETCH_ITEM(it);
#ifdef PROBE_P2
            while (it < 128) { const int itq = it; { const int it = itq & 63; RET_CALL } FETCH_ITEM(it); }
            while (it < 128 + 2 * 32 * 65) { const int j = (it - 128) % (32 * 65); const int bh = j & 31; DIFF_CALL FETCH_ITEM(it); }
#else
            while (it < 64) { RET_CALL FETCH_ITEM(it); }
            while (it < 64 + 32 * 65) { const int j = it - 64; const int bh = j & 31; DIFF_CALL FETCH_ITEM(it); }
#endif
#undef FETCH_ITEM
        }
    }
    SEAM(2);
    if (IN(3)) {
        pg8::Gemm g{MIXB, (const bf16_t*)(P.ws + WS_WOUT0), DM, 256}; pg8::StaticOrder S; S.init(MROWS / 256, DM / 256, G, (int)blockIdx.x);
        EpiResidual<0> E{Y, nullptr, RSQ, P.x, P.meta};
        pg8::gemm_phase(lds, g, S, E);
    }
    SEAM(3);
    if (IN(4)) {
        pg8::Gemm g{Y - 2 * DM, (const bf16_t*)(P.ws + WS_WUP0), DM, 254}; pg8::StaticOrder S; S.init((MROWS + 253) / 254, DFF / 128, G, (int)blockIdx.x);
        EpiFfnUp E{BIG, P.ffn_conv, P.ffn_conv_b, RSQ};
        for (int rep = 0; rep < NREP(4); ++rep) pg8::gemm_phase(lds, g, S, E);
    }
    SEAM(4);
    if (IN(5)) {
        pg8::Gemm g{BIG, (const bf16_t*)(P.ws + WS_WDN0), DFF, 256}; pg8::StaticOrder S; S.init(MROWS / 256, DM / 256, G, (int)blockIdx.x);
        EpiResidual<1> E{Y, nullptr, RSQ + MROWS, nullptr, nullptr};
        pg8::gemm_phase(lds, g, S, E);
        deferred_convert(P, lds, ctl + 9, 1, wave, lane);
    }
    SEAM(5);
    if (IN(6)) {
        pg8::Gemm g{Y, (const bf16_t*)(P.ws + WS_WIN1), DM, 256}; pg8::StaticOrder S; S.init(MROWS / 256, C_IN / 256, G, (int)blockIdx.x);
        EpiProj<1> E{BIG, C_IN, RSQ + MROWS, nullptr};
        pg8::gemm_phase(lds, g, S, E);
    }
    SEAM(6);
    if (IN(7)) {
        LAS int* itm = (LAS int*)(lds + 147456 - 64);
        for (int rep = 0; rep < NREP(7); ++rep)
        for (;;) {
            __syncthreads();
            if (tid == 0) itm[0] = (int)atomicAdd(&ctl[1 + 4 * rep], 1u);
            __syncthreads();
            const int it = itm[0];
            if (it >= 32 * 65) break;
            const int bh = it & 31;
            SB_CALL
        }
    }
    SEAM(7);
    if (IN(8)) {
        pg8::Gemm g{MIXB, (const bf16_t*)(P.ws + WS_WOUT1), DM, 256}; pg8::StaticOrder S; S.init(MROWS / 256, DM / 256, G, (int)blockIdx.x);
        EpiResidual<1> E{Y, nullptr, RSQ + 2 * MROWS, nullptr, nullptr};
        pg8::gemm_phase(lds, g, S, E);
    }
    SEAM(8);
    if (IN(9)) {
        pg8::Gemm g{Y - 2 * DM, (const bf16_t*)(P.ws + WS_WUP1), DM, 254}; pg8::StaticOrder S; S.init((MROWS + 253) / 254, DFF / 128, G, (int)blockIdx.x);
        EpiFfnUp E{BIG, P.ffn_conv + 3 * DFF, P.ffn_conv_b + DFF, RSQ + 2 * MROWS};
        pg8::gemm_phase(lds, g, S, E);
    }
    SEAM(9);
    if (IN(10)) {
        pg8::Gemm g{BIG, (const bf16_t*)(P.ws + WS_WDN1), DFF, 256}; pg8::StaticOrder S; S.init(MROWS / 256, DM / 256, G, (int)blockIdx.x);
        EpiResidual<1> E{Y, nullptr, RSQ + 3 * MROWS, nullptr, nullptr};
        pg8::gemm_phase(lds, g, S, E);
    }
    SEAM(10);
    if (IN(11)) {
        for (int mo = gw; mo < BATCH * SEQ; mo += NGW) {
            const int b = mo / SEQ, sq = mo % SEQ; const size_t m = (size_t)b * PP + BLK + sq;
            const float rstd = __builtin_amdgcn_rsqf(RSQ[3 * MROWS + m] * (1.0f / DM) + EPS);
#pragma unroll
            for (int j = 0; j < 2; ++j) {
                const u32x4 q = *(const u32x4*)(Y + m * DM + 8 * lane + 512 * j);
                const f32x4 g0 = *(const f32x4*)(P.final_norm + 8 * lane + 512 * j), g1 = *(const f32x4*)(P.final_norm + 8 * lane + 512 * j + 4);
                const f32x4 v0 = (f32x4){__uint_as_float(q.x << 16), __uint_as_float(q.x & 0xffff0000u), __uint_as_float(q.y << 16), __uint_as_float(q.y & 0xffff0000u)};
                const f32x4 v1 = (f32x4){__uint_as_float(q.z << 16), __uint_as_float(q.z & 0xffff0000u), __uint_as_float(q.w << 16), __uint_as_float(q.w & 0xffff0000u)};
                *(f32x4*)(P.out + (size_t)mo * DM + 8 * lane + 512 * j) = v0 * rstd * g0;
                *(f32x4*)(P.out + (size_t)mo * DM + 8 * lane + 512 * j + 4) = v1 * rstd * g1; }
        }
    }
#undef IN
#undef SEAM
#undef NORM_PHASE
}

#ifndef MK_ONE_LAUNCH
#define MK_ONE_LAUNCH 1
#endif
extern "C" void kernel_launch(void* const* d_in, const int* in_sizes, int n_in, void* d_out, int out_size, void* d_ws, size_t ws_size, hipStream_t stream) {
    static int grid = 0;
    if (grid == 0) {
        if (n_in != 19 || ws_size < WS_END) { fprintf(stderr, "kernel_launch: unexpected n_in %d or ws_size %zu (need %zu)\n", n_in, ws_size, (size_t)WS_END); grid = -1; return; }
        int dev = 0, cus = 0, per_cu = 0;
        hipGetDevice(&dev); hipDeviceGetAttribute(&cus, hipDeviceAttributeMultiprocessorCount, dev);
        if (hipFuncSetAttribute((const void*)fwd_megakernel, hipFuncAttributeMaxDynamicSharedMemorySize, LDS_BYTES) != hipSuccess) { fprintf(stderr, "kernel_launch: hipFuncSetAttribute failed\n"); grid = -1; return; }
        if (hipOccupancyMaxActiveBlocksPerMultiprocessor(&per_cu, (const void*)fwd_megakernel, NTHREADS, LDS_BYTES) != hipSuccess || per_cu < 1) { fprintf(stderr, "kernel_launch: occupancy query says %d\n", per_cu); per_cu = 1; }
        (void)hipGetLastError();
        grid = cus * 1;
        if (grid <= 0) grid = 256;
    }
    if (grid < 0) return;
    Params p{};
    p.x = (const float*)d_in[0]; p.meta = (const float*)d_in[1]; p.mix_norm = (const float*)d_in[2]; p.ffn_norm = (const float*)d_in[3];
    p.ffn_up = (const float*)d_in[4]; p.ffn_conv = (const float*)d_in[5]; p.ffn_conv_b = (const float*)d_in[6]; p.ffn_down = (const float*)d_in[7];
    p.ab_w_in = (const float*)d_in[8]; p.ab_ret_norm = (const float*)d_in[9]; p.ab_diff_norm = (const float*)d_in[10];
    p.lq1 = (const float*)d_in[11]; p.lk1 = (const float*)d_in[12]; p.lq2 = (const float*)d_in[13]; p.lk2 = (const float*)d_in[14]; p.ab_w_out = (const float*)d_in[15];
    p.c_w_in = (const float*)d_in[16]; p.c_w_out = (const float*)d_in[17]; p.final_norm = (const float*)d_in[18];
    p.out = (float*)d_out; p.ws = (unsigned char*)d_ws;
#if MK_ONE_LAUNCH
    p.ph_lo = 0; p.ph_hi = NPHASES;
    void* args[] = {&p};
    hipError_t e = hipLaunchCooperativeKernel((const void*)fwd_megakernel, dim3(grid), dim3(NTHREADS), args, LDS_BYTES, stream);
    if (e != hipSuccess) fprintf(stderr, "cooperative launch failed: %s (grid %d)\n", hipGetErrorString(e), grid);
#else
    for (int ph = 0; ph < NPHASES; ++ph) {
        p.ph_lo = ph; p.ph_hi = ph + 1;
        hipLaunchKernelGGL(fwd_megakernel, dim3(grid), dim3(NTHREADS), LDS_BYTES, stream, p);
    }
#endif
}
```
